# Optimizing an MI355X kernel written in HIP

```python
import math
import jax
import jax.numpy as jnp
from jax import lax
import numpy as np

D_MODEL = 4096
BATCH = 1
SEQ = 8192
DEPTH = 1

HEAD_DIM = 128
MOBA_HEADS = 16
MOBA_WIDTH = MOBA_HEADS * HEAD_DIM
MOBA_BLOCK = 256
MOBA_TOPK = 3
MOBA_Q_CHUNK = 32
DIFF_HEADS = 8
DIFF_QK_WIDTH = DIFF_HEADS * 2 * HEAD_DIM
DIFF_V_DIM = 2 * HEAD_DIM
DIFF_V_WIDTH = DIFF_HEADS * DIFF_V_DIM
DIFF_Q_BLOCK = 128
N_BUCKETS = 32
MAX_DISTANCE = 128
N_BIAS_HEADS = MOBA_HEADS + DIFF_HEADS
IN_SPLITS = (MOBA_WIDTH, MOBA_WIDTH, MOBA_WIDTH, DIFF_QK_WIDTH, DIFF_QK_WIDTH, DIFF_V_WIDTH, D_MODEL, D_MODEL)
IN_WIDTH = sum(IN_SPLITS)
PEER_HEADS = 8
PEER_N_KEYS = 128
PEER_N_EXPERTS = PEER_N_KEYS * PEER_N_KEYS
PEER_HALF = 128
PEER_QUERY_DIM = 2 * PEER_HALF
PEER_TOPK = 16
PEER_TOKEN_CHUNK = 64
DEEPNORM_ALPHA = (2.0 * DEPTH) ** 0.25
DEEPNORM_BETA = (8.0 * DEPTH) ** -0.25
LN_EPS = 1e-5
NEG_INF = -1e30

kernel_name = 'hybrid_moba_diffattn_peer_block'


def layer_norm(x, g, b):
    xf = x.astype(jnp.float32)
    mu = jnp.mean(xf, axis=-1, keepdims=True)
    var = jnp.mean(jnp.square(xf - mu), axis=-1, keepdims=True)
    y = (xf - mu) * lax.rsqrt(var + LN_EPS) * g.astype(jnp.float32) + b.astype(jnp.float32)
    return y.astype(x.dtype)


def rms_norm(x, g):
    xf = x.astype(jnp.float32)
    y = xf * lax.rsqrt(jnp.mean(jnp.square(xf), axis=-1, keepdims=True) + LN_EPS) * g.astype(jnp.float32)
    return y.astype(x.dtype)


def t5_bucket(dist):
    n = jnp.maximum(dist, 0)
    max_exact = N_BUCKETS // 2
    nf = jnp.maximum(n, 1).astype(jnp.float32)
    large = max_exact + (jnp.log(nf / max_exact) / math.log(MAX_DISTANCE / max_exact)
                         * (N_BUCKETS - max_exact)).astype(jnp.int32)
    large = jnp.minimum(large, N_BUCKETS - 1)
    return jnp.where(n < max_exact, n, large)


def split_heads(t, n, d):
    b, s = t.shape[:2]
    return t.reshape(b, s, n, d).transpose(0, 2, 1, 3)


def merge_heads(o):
    b, h, s, d = o.shape
    return o.transpose(0, 2, 1, 3).reshape(b, s, h * d)


def seq_chunks(a, n_chunks):
    b, h, s = a.shape[:3]
    a = a.reshape(b, h, n_chunks, s // n_chunks, *a.shape[3:])
    return jnp.moveaxis(a, 2, 0)


def moba_attention(q, k, v, bias_tab):
    B, H, S, dh = q.shape
    nb = -(-S // MOBA_BLOCK)
    pad = nb * MOBA_BLOCK - S
    kp = jnp.pad(k, ((0, 0), (0, 0), (0, pad), (0, 0))).reshape(B, H, nb, MOBA_BLOCK, dh)
    vp = jnp.pad(v, ((0, 0), (0, 0), (0, pad), (0, 0))).reshape(B, H, nb, MOBA_BLOCK, dh)
    k_mean = jnp.mean(kp.astype(jnp.float32), axis=3)
    pos = jnp.arange(S, dtype=jnp.int32)
    q_blk = pos // MOBA_BLOCK
    gate = jnp.einsum('bhsd,bhnd->bhsn', q.astype(jnp.float32), k_mean)
    past = jnp.arange(nb, dtype=jnp.int32)[None, :] < q_blk[:, None]
    gate = jnp.where(past, gate, NEG_INF)
    _, sel = lax.top_k(gate, min(MOBA_TOPK, nb))
    sel = sel.astype(jnp.int32)
    sel_ok = sel < q_blk[:, None]
    own = jnp.broadcast_to(q_blk[None, None, :, None], (B, H, S, 1))
    blocks = jnp.concatenate([sel, own], axis=-1)
    valid = jnp.concatenate([sel_ok, jnp.ones((B, H, S, 1), dtype=bool)], axis=-1)
    n_chunks = S // MOBA_Q_CHUNK
    b_idx = jnp.arange(B)[:, None, None, None]
    h_idx = jnp.arange(H)[None, :, None, None]
    offs = jnp.arange(MOBA_BLOCK, dtype=jnp.int32)
    scale = HEAD_DIM ** -0.5

    def step(args):
        qc, blk, ok, qpos = args
        kg = kp[b_idx, h_idx, blk]
        vg = vp[b_idx, h_idx, blk]
        kpos = blk[..., None] * MOBA_BLOCK + offs
        dist = qpos[None, None, :, None, None] - kpos
        mask = ok[..., None] & (dist >= 0)
        bias = bias_tab[h_idx[..., None], t5_bucket(dist)].astype(jnp.float32)
        s = jnp.einsum('bhcd,bhcrld->bhcrl', qc, kg).astype(jnp.float32) * scale + bias
        s = jnp.where(mask, s, NEG_INF)
        p = jax.nn.softmax(s.reshape(s.shape[:3] + (-1,)), axis=-1).reshape(s.shape)
        return jnp.einsum('bhcrl,bhcrld->bhcd', p.astype(vg.dtype), vg)

    out = lax.map(step, (seq_chunks(q, n_chunks), seq_chunks(blocks, n_chunks),
                         seq_chunks(valid, n_chunks), pos.reshape(n_chunks, MOBA_Q_CHUNK)))
    return jnp.moveaxis(out, 0, 2).reshape(B, H, S, dh)


def diff_attention(q1, q2, k1, k2, v, lam, bias_tab):
    B, H, S, dh = q1.shape
    n_blocks = S // DIFF_Q_BLOCK
    kpos = jnp.arange(S, dtype=jnp.int32)
    scale = HEAD_DIM ** -0.5

    def step(args):
        a1, a2, qpos = args
        dist = qpos[:, None] - kpos[None, :]
        mask = dist >= 0
        bias = bias_tab[:, t5_bucket(dist)].astype(jnp.float32)

        def probs(qq, kk):
            s = jnp.einsum('bhqd,bhkd->bhqk', qq, kk).astype(jnp.float32) * scale + bias
            return jax.nn.softmax(jnp.where(mask, s, NEG_INF), axis=-1)

        a = probs(a1, k1) - lam * probs(a2, k2)
        return jnp.einsum('bhqk,bhkd->bhqd', a.astype(v.dtype), v)

    out = lax.map(step, (seq_chunks(q1, n_blocks), seq_chunks(q2, n_blocks),
                         kpos.reshape(n_blocks, DIFF_Q_BLOCK)))
    return jnp.moveaxis(out, 0, 2).reshape(B, H, S, 2 * dh)


def mixer_sublayer(x, w_in, gate_b, rel_bias, lq1, lk1, lq2, lk2, subln_g,
                   w_o_moba, w_o_diff, w_out, lambda_init):
    B, S, _ = x.shape
    proj = x @ w_in
    cuts = np.cumsum(IN_SPLITS)[:-1].tolist()
    mq, mk, mv, dq, dk, dv, ga, gb = jnp.split(proj, cuts, axis=-1)
    y_a = moba_attention(split_heads(mq, MOBA_HEADS, HEAD_DIM), split_heads(mk, MOBA_HEADS, HEAD_DIM),
                         split_heads(mv, MOBA_HEADS, HEAD_DIM), rel_bias[:, :MOBA_HEADS].T)
    dq = dq.reshape(B, S, DIFF_HEADS, 2, HEAD_DIM).transpose(0, 2, 3, 1, 4)
    dk = dk.reshape(B, S, DIFF_HEADS, 2, HEAD_DIM).transpose(0, 2, 3, 1, 4)
    lam = (jnp.exp(jnp.sum(lq1.astype(jnp.float32) * lk1.astype(jnp.float32)))
           - jnp.exp(jnp.sum(lq2.astype(jnp.float32) * lk2.astype(jnp.float32))) + lambda_init)
    y_b = diff_attention(dq[:, :, 0], dq[:, :, 1], dk[:, :, 0], dk[:, :, 1],
                         split_heads(dv, DIFF_HEADS, DIFF_V_DIM), lam, rel_bias[:, MOBA_HEADS:].T)
    y_b = rms_norm(y_b, subln_g) * (1.0 - lambda_init)
    g_a = jax.nn.sigmoid(ga + gate_b[:D_MODEL])
    g_b = jax.nn.sigmoid(gb + gate_b[D_MODEL:])
    merged = g_a * (merge_heads(y_a) @ w_o_moba) + g_b * (merge_heads(y_b) @ w_o_diff)
    return merged @ w_out


def peer_ffn(x, w_q, keys1, keys2, u_tab, v_tab):
    B, S, D = x.shape
    T = B * S
    xt = x.reshape(T, D)
    q = (xt @ w_q).reshape(T, PEER_HEADS, 2, PEER_HALF)
    s1 = jnp.einsum('thd,kd->thk', q[:, :, 0], keys1).astype(jnp.float32)
    s2 = jnp.einsum('thd,kd->thk', q[:, :, 1], keys2).astype(jnp.float32)
    v1, i1 = lax.top_k(s1, PEER_TOPK)
    v2, i2 = lax.top_k(s2, PEER_TOPK)
    cand = (v1[..., :, None] + v2[..., None, :]).reshape(T, PEER_HEADS, PEER_TOPK * PEER_TOPK)
    cidx = (i1[..., :, None] * PEER_N_KEYS + i2[..., None, :]).reshape(T, PEER_HEADS, PEER_TOPK * PEER_TOPK)
    top_s, top_pos = lax.top_k(cand, PEER_TOPK)
    eidx = jnp.take_along_axis(cidx, top_pos, axis=-1).reshape(T, PEER_HEADS * PEER_TOPK)
    gates = jax.nn.softmax(top_s, axis=-1).reshape(T, PEER_HEADS * PEER_TOPK)
    n_chunks = T // PEER_TOKEN_CHUNK

    def step(args):
        xc, ec, gc = args
        u = u_tab[ec]
        act = jax.nn.gelu(jnp.einsum('cd,ced->ce', xc, u).astype(jnp.float32), approximate=False)
        w = (gc * act).astype(v_tab.dtype)
        return jnp.einsum('ce,ced->cd', w, v_tab[ec])

    out = lax.map(step, (xt.reshape(n_chunks, PEER_TOKEN_CHUNK, D),
                         eidx.reshape(n_chunks, PEER_TOKEN_CHUNK, -1),
                         gates.reshape(n_chunks, PEER_TOKEN_CHUNK, -1)))
    return out.reshape(B, S, D).astype(x.dtype)


def setup_inputs(seed: int = 0) -> dict:
    key = jax.random.key(seed)
    ks = jax.random.split(key, 24)
    f32 = jnp.float32
    col_scale = jnp.concatenate([
        jnp.ones((2 * MOBA_WIDTH,), f32), jnp.full((MOBA_WIDTH,), DEEPNORM_BETA, f32),
        jnp.ones((2 * DIFF_QK_WIDTH,), f32), jnp.full((DIFF_V_WIDTH,), DEEPNORM_BETA, f32),
        jnp.ones((2 * D_MODEL,), f32)])
    d_is = D_MODEL ** -0.5
    return {
        'x': jax.random.normal(ks[0], (BATCH, SEQ, D_MODEL), f32),
        'w_in': jax.random.normal(ks[1], (DEPTH, D_MODEL, IN_WIDTH), f32) * d_is * col_scale,
        'gate_b': jax.random.normal(ks[2], (DEPTH, 2 * D_MODEL), f32) * 0.02,
        'rel_bias': jax.random.normal(ks[3], (N_BUCKETS, N_BIAS_HEADS), f32) * 0.5,
        'lambda_q1': jax.random.normal(ks[4], (DEPTH, HEAD_DIM), f32) * 0.1,
        'lambda_k1': jax.random.normal(ks[5], (DEPTH, HEAD_DIM), f32) * 0.1,
        'lambda_q2': jax.random.normal(ks[6], (DEPTH, HEAD_DIM), f32) * 0.1,
        'lambda_k2': jax.random.normal(ks[7], (DEPTH, HEAD_DIM), f32) * 0.1,
        'subln_g': 1.0 + 0.02 * jax.random.normal(ks[8], (DEPTH, DIFF_V_DIM), f32),
        'w_o_moba': jax.random.normal(ks[9], (DEPTH, MOBA_WIDTH, D_MODEL), f32) * (MOBA_WIDTH ** -0.5) * DEEPNORM_BETA,
        'w_o_diff': jax.random.normal(ks[10], (DEPTH, DIFF_V_WIDTH, D_MODEL), f32) * (DIFF_V_WIDTH ** -0.5) * DEEPNORM_BETA,
        'w_out': jax.random.normal(ks[11], (DEPTH, D_MODEL, D_MODEL), f32) * d_is * DEEPNORM_BETA,
        'ln1_g': 1.0 + 0.02 * jax.random.normal(ks[12], (DEPTH, D_MODEL), f32),
        'ln1_b': 0.02 * jax.random.normal(ks[13], (DEPTH, D_MODEL), f32),
        'peer_wq': jax.random.normal(ks[14], (DEPTH, D_MODEL, PEER_HEADS * PEER_QUERY_DIM), f32) * d_is,
        'peer_keys1': jax.random.normal(ks[15], (DEPTH, PEER_N_KEYS, PEER_HALF), f32) * (PEER_HALF ** -0.5),
        'peer_keys2': jax.random.normal(ks[16], (DEPTH, PEER_N_KEYS, PEER_HALF), f32) * (PEER_HALF ** -0.5),
        'peer_u': jax.random.normal(ks[17], (DEPTH, PEER_N_EXPERTS, D_MODEL), f32) * d_is,
        'peer_v': jax.random.normal(ks[18], (DEPTH, PEER_N_EXPERTS, D_MODEL), f32) * DEEPNORM_BETA,
        'ln2_g': 1.0 + 0.02 * jax.random.normal(ks[19], (DEPTH, D_MODEL), f32),
        'ln2_b': 0.02 * jax.random.normal(ks[20], (DEPTH, D_MODEL), f32),
    }


def reference(x, w_in, gate_b, rel_bias, lambda_q1, lambda_k1, lambda_q2, lambda_k2, subln_g,
              w_o_moba, w_o_diff, w_out, ln1_g, ln1_b, peer_wq, peer_keys1, peer_keys2,
              peer_u, peer_v, ln2_g, ln2_b):
    for layer in range(DEPTH):
        lambda_init = 0.8 - 0.6 * math.exp(-0.3 * layer)
        h = mixer_sublayer(x, w_in[layer], gate_b[layer], rel_bias, lambda_q1[layer], lambda_k1[layer],
                           lambda_q2[layer], lambda_k2[layer], subln_g[layer], w_o_moba[layer],
                           w_o_diff[layer], w_out[layer], lambda_init)
        x = layer_norm(DEEPNORM_ALPHA * x + h, ln1_g[layer], ln1_b[layer])
        h = peer_ffn(x, peer_wq[layer], peer_keys1[layer], peer_keys2[layer], peer_u[layer], peer_v[layer])
        x = layer_norm(DEEPNORM_ALPHA * x + h, ln2_g[layer], ln2_b[layer])
    return x
```

```cpp
#include <hip/hip_runtime.h>
#include <math.h>

namespace {
constexpr int S = 8192, DM = 4096, INW = 20480;
constexpr float SCALE = 0.08838834764831845f;
constexpr float ALPHA = 1.189207115002721f;
constexpr float LN_EPS = 1e-5f;
constexpr float LAMBDA_INIT = 0.2f;
typedef float f32x16 __attribute__((ext_vector_type(16)));

__device__ __forceinline__ int t5_bucket(int n) {
    if (n < 16) return n;
    int b = 16;
    b += (n >= 19); b += (n >= 21); b += (n >= 24); b += (n >= 27); b += (n >= 31); b += (n >= 35); b += (n >= 40); b += (n >= 46);
    b += (n >= 52); b += (n >= 59); b += (n >= 67); b += (n >= 77); b += (n >= 87); b += (n >= 99); b += (n >= 113);
    return b;
}

__global__ void __launch_bounds__(256) gemm_f32(const float* __restrict__ A, int lda, const float* __restrict__ B, int ldb, float* __restrict__ C, int ldc, int K,
                                                const float* __restrict__ R, int ldr, float alpha) {
    __shared__ float As[16][132];
    __shared__ float Bs[16][132];
    const int tid = threadIdx.x, lane = tid & 63, wid = tid >> 6, wm = wid >> 1, wn = wid & 1;
    const int m0 = blockIdx.y * 128, n0 = blockIdx.x * 128;
    f32x16 acc[2][2];
    for (int i = 0; i < 2; ++i) for (int j = 0; j < 2; ++j) for (int r = 0; r < 16; ++r) acc[i][j][r] = 0.f;
    for (int k0 = 0; k0 < K; k0 += 16) {
        for (int i = 0; i < 2; ++i) {
            const int idx = tid + i * 256;
            const int r = idx >> 2, c4 = idx & 3;
            const float4 v = *(const float4*)(A + (size_t)(m0 + r) * lda + k0 + c4 * 4);
            As[c4 * 4 + 0][r] = v.x; As[c4 * 4 + 1][r] = v.y; As[c4 * 4 + 2][r] = v.z; As[c4 * 4 + 3][r] = v.w;
            const int kr = idx >> 5, cb = idx & 31;
            const float4 w = *(const float4*)(B + (size_t)(k0 + kr) * ldb + n0 + cb * 4);
            *(float4*)&Bs[kr][cb * 4] = w;
        }
        __syncthreads();
        for (int kk = 0; kk < 16; kk += 2) {
            float a[2], b[2];
            for (int i = 0; i < 2; ++i) a[i] = As[kk + (lane >> 5)][wm * 64 + i * 32 + (lane & 31)];
            for (int j = 0; j < 2; ++j) b[j] = Bs[kk + (lane >> 5)][wn * 64 + j * 32 + (lane & 31)];
            for (int i = 0; i < 2; ++i) for (int j = 0; j < 2; ++j) acc[i][j] = __builtin_amdgcn_mfma_f32_32x32x2f32(a[i], b[j], acc[i][j], 0, 0, 0);
        }
        __syncthreads();
    }
    for (int i = 0; i < 2; ++i) for (int j = 0; j < 2; ++j) for (int r = 0; r < 16; ++r) {
        const int row = m0 + wm * 64 + i * 32 + (r & 3) + 8 * (r >> 2) + 4 * (lane >> 5);
        const int col = n0 + wn * 64 + j * 32 + (lane & 31);
        float v = acc[i][j][r];
        if (R) v += alpha * R[(size_t)row * ldr + col];
        C[(size_t)row * ldc + col] = v;
    }
}

__global__ void transpose_f32(const float* __restrict__ in, int ld_in, float* __restrict__ out, int ld_out) {
    __shared__ float tile[32][33];
    const int tx = threadIdx.x & 31, ty = threadIdx.x >> 5;
    const int r0 = blockIdx.y * 32, c0 = blockIdx.x * 32;
    for (int i = ty; i < 32; i += 8) tile[i][tx] = in[(size_t)(r0 + i) * ld_in + c0 + tx];
    __syncthreads();
    for (int i = ty; i < 32; i += 8) out[(size_t)(c0 + i) * ld_out + r0 + tx] = tile[tx][i];
}

__global__ void kmean_kernel(const float* __restrict__ mk, float* __restrict__ kmean) {
    const int j = blockIdx.x, h = blockIdx.y, d = threadIdx.x;
    float s = 0.f;
    for (int i = 0; i < 256; ++i) s += mk[(size_t)(j * 256 + i) * 2048 + h * 128 + d];
    kmean[(h * 32 + j) * 128 + d] = s * (1.0f / 256.0f);
}

__device__ __forceinline__ float block_reduce(float v, float* red, bool is_max) {
    const int t = threadIdx.x;
    for (int o = 32; o >= 1; o >>= 1) { const float w = __shfl_xor(v, o); v = is_max ? fmaxf(v, w) : v + w; }
    __syncthreads();
    if ((t & 63) == 0) red[t >> 6] = v;
    __syncthreads();
    float r = red[0];
    for (int i = 1; i < (int)(blockDim.x >> 6); ++i) r = is_max ? fmaxf(r, red[i]) : r + red[i];
    __syncthreads();
    return r;
}

__global__ void __launch_bounds__(256) moba_naive(const float* __restrict__ mq, const float* __restrict__ mkT, const float* __restrict__ mv, const float* __restrict__ kmean,
                                                  const float* __restrict__ rel_bias, float* __restrict__ ya) {
    const int q = blockIdx.x, h = blockIdx.y, t = threadIdx.x;
    __shared__ float qs[128]; __shared__ float gate[32]; __shared__ int blk[4]; __shared__ int okf[4]; __shared__ float sc[1024]; __shared__ float red[8]; __shared__ float biasl[32];
    __shared__ float part[256];
    if (t < 128) qs[t] = mq[(size_t)q * 2048 + h * 128 + t];
    if (t < 32) biasl[t] = rel_bias[t * 24 + h];
    __syncthreads();
    const int qb = q >> 8;
    if (t < 32) { float g = -1e30f; if (t < qb) { g = 0.f; const float* km = kmean + (h * 32 + t) * 128; for (int d = 0; d < 128; ++d) g += qs[d] * km[d]; } gate[t] = g; }
    __syncthreads();
    if (t == 0) {
        unsigned used = 0;
        for (int r = 0; r < 3; ++r) { int best = -1; for (int j = 0; j < 32; ++j) if (!((used >> j) & 1u) && (best < 0 || gate[j] > gate[best])) best = j;
            used |= 1u << best; blk[r] = best; okf[r] = best < qb ? 1 : 0; }
        blk[3] = qb; okf[3] = 1;
    }
    __syncthreads();
    float lmax = -1e30f;
    for (int r = 0; r < 4; ++r) {
        const int kpos = blk[r] * 256 + t, dist = q - kpos; float s = -1e30f;
        if (okf[r] && dist >= 0) { float dot = 0.f; const float* kp = mkT + (size_t)(h * 128) * S + kpos; for (int d = 0; d < 128; ++d) dot += qs[d] * kp[(size_t)d * S];
            s = dot * SCALE + biasl[t5_bucket(dist)]; }
        sc[r * 256 + t] = s; lmax = fmaxf(lmax, s);
    }
    const float mx = block_reduce(lmax, red, true);
    float lsum = 0.f;
    for (int r = 0; r < 4; ++r) { const float e = expf(sc[r * 256 + t] - mx); sc[r * 256 + t] = e; lsum += e; }
    const float sum = block_reduce(lsum, red, false);
    const int d = t & 127, half = t >> 7; float a = 0.f;
    for (int i = half * 512; i < half * 512 + 512; ++i) { const float p = sc[i]; if (p != 0.f) { const int kpos = blk[i >> 8] * 256 + (i & 255); a += p * mv[(size_t)kpos * 2048 + h * 128 + d]; } }
    part[t] = a; __syncthreads();
    if (t < 128) ya[(size_t)q * 2048 + h * 128 + t] = (part[t] + part[t + 128]) / sum;
}

__global__ void __launch_bounds__(256) diff_naive(const float* __restrict__ dq, const float* __restrict__ dkT, const float* __restrict__ dv, const float* __restrict__ rel_bias,
                                                  const float* __restrict__ lq1, const float* __restrict__ lk1, const float* __restrict__ lq2, const float* __restrict__ lk2,
                                                  const float* __restrict__ subln_g, float* __restrict__ yb) {
    __shared__ float sc[S];
    __shared__ float qs[256]; __shared__ float red[8]; __shared__ float biasl[32]; __shared__ float lamsh;
    const int q = blockIdx.x, h = blockIdx.y, t = threadIdx.x;
    qs[t] = dq[(size_t)q * 2048 + h * 256 + t];
    if (t < 32) biasl[t] = rel_bias[t * 24 + 16 + h];
    if (t == 0) { float a = 0.f, b = 0.f; for (int d = 0; d < 128; ++d) { a += lq1[d] * lk1[d]; b += lq2[d] * lk2[d]; } lamsh = expf(a) - expf(b) + LAMBDA_INIT; }
    __syncthreads();
    const float lam = lamsh; const int nk = q + 1;
    float acc = 0.f;
    for (int mp = 0; mp < 2; ++mp) {
        float lmax = -1e30f;
        for (int kpos = t; kpos < nk; kpos += 256) { float dot = 0.f; const float* kp = dkT + (size_t)(h * 256 + mp * 128) * S + kpos;
            for (int d = 0; d < 128; ++d) dot += qs[mp * 128 + d] * kp[(size_t)d * S];
            const float s = dot * SCALE + biasl[t5_bucket(q - kpos)]; sc[kpos] = s; lmax = fmaxf(lmax, s); }
        const float mx = block_reduce(lmax, red, true);
        float lsum = 0.f;
        for (int kpos = t; kpos < nk; kpos += 256) { const float e = expf(sc[kpos] - mx); sc[kpos] = e; lsum += e; }
        const float inv = 1.0f / block_reduce(lsum, red, false);
        float a = 0.f;
        for (int i = 0; i < nk; ++i) a += sc[i] * dv[(size_t)i * 2048 + h * 256 + t];
        acc += (mp == 0 ? inv : -lam * inv) * a;
        __syncthreads();
    }
    const float ss = block_reduce(acc * acc, red, false);
    yb[(size_t)q * 2048 + h * 256 + t] = acc * rsqrtf(ss * (1.0f / 256.0f) + LN_EPS) * subln_g[t] * (1.0f - LAMBDA_INIT);
}

__global__ void merge_kernel(const float* __restrict__ ga, const float* __restrict__ gb, const float* __restrict__ gate_b, const float* __restrict__ ta, const float* __restrict__ tb, float* __restrict__ merged) {
    const size_t i = (size_t)blockIdx.x * blockDim.x + threadIdx.x; const int c = (int)(i & (DM - 1));
    const float a = 1.0f / (1.0f + expf(-(ga[i] + gate_b[c]))), b = 1.0f / (1.0f + expf(-(gb[i] + gate_b[DM + c])));
    merged[i] = a * ta[i] + b * tb[i];
}

__global__ void __launch_bounds__(256) ln_kernel(const float* __restrict__ in, const float* __restrict__ g, const float* __restrict__ b, float* __restrict__ out) {
    __shared__ float red[8];
    const int row = blockIdx.x, t = threadIdx.x; float v[16]; float s = 0.f;
    for (int i = 0; i < 16; ++i) { v[i] = in[(size_t)row * DM + i * 256 + t]; s += v[i]; }
    const float mu = block_reduce(s, red, false) * (1.0f / DM); float q = 0.f;
    for (int i = 0; i < 16; ++i) { v[i] -= mu; q += v[i] * v[i]; }
    const float rstd = rsqrtf(block_reduce(q, red, false) * (1.0f / DM) + LN_EPS);
    for (int i = 0; i < 16; ++i) out[(size_t)row * DM + i * 256 + t] = v[i] * rstd * g[i * 256 + t] + b[i * 256 + t];
}

__global__ void __launch_bounds__(256) peer_route_naive(const float* __restrict__ pq, const float* __restrict__ keys1, const float* __restrict__ keys2, int* __restrict__ eidx, float* __restrict__ gates) {
    __shared__ float qh[256]; __shared__ float sc[2][128]; __shared__ float tv[2][16]; __shared__ int ti[2][16];
    const int tok = blockIdx.x, t = threadIdx.x;
    for (int h = 0; h < 8; ++h) {
        qh[t] = pq[(size_t)tok * 2048 + h * 256 + t];
        __syncthreads();
        { const int side = t >> 7, k = t & 127; const float* kr = (side ? keys2 : keys1) + k * 128; float d = 0.f; for (int i = 0; i < 128; ++i) d += qh[side * 128 + i] * kr[i]; sc[side][k] = d; }
        __syncthreads();
        if (t == 0 || t == 128) { const int side = t >> 7; unsigned used[4] = {0, 0, 0, 0};
            for (int r = 0; r < 16; ++r) { int best = -1; for (int j = 0; j < 128; ++j) if (!((used[j >> 5] >> (j & 31)) & 1u) && (best < 0 || sc[side][j] > sc[side][best])) best = j;
                used[best >> 5] |= 1u << (best & 31); tv[side][r] = sc[side][best]; ti[side][r] = best; } }
        __syncthreads();
        if (t == 0) { unsigned used[8] = {0, 0, 0, 0, 0, 0, 0, 0}; float ts[16]; int tp[16];
            for (int r = 0; r < 16; ++r) { int best = -1; float bv = 0.f; for (int j = 0; j < 256; ++j) { if ((used[j >> 5] >> (j & 31)) & 1u) continue; const float c = tv[0][j >> 4] + tv[1][j & 15]; if (best < 0 || c > bv) { best = j; bv = c; } }
                used[best >> 5] |= 1u << (best & 31); ts[r] = bv; tp[r] = best; }
            float sum = 0.f; const float tmax = ts[0]; for (int r = 0; r < 16; ++r) { ts[r] = expf(ts[r] - tmax); sum += ts[r]; }
            for (int r = 0; r < 16; ++r) { eidx[(size_t)tok * 128 + h * 16 + r] = ti[0][tp[r] >> 4] * 128 + ti[1][tp[r] & 15]; gates[(size_t)tok * 128 + h * 16 + r] = ts[r] / sum; } }
        __syncthreads();
    }
}

__global__ void __launch_bounds__(256) peer_expert_naive(const float* __restrict__ x1, const int* __restrict__ eidx, const float* __restrict__ gates, const float* __restrict__ U, const float* __restrict__ V,
                                                         const float* __restrict__ g2, const float* __restrict__ b2, float* __restrict__ out) {
    __shared__ float xs[DM]; __shared__ float wts[128]; __shared__ int es[128]; __shared__ float red[8];
    const int tok = blockIdx.x, t = threadIdx.x, lane = t & 63, wid = t >> 6;
    for (int i = t; i < DM; i += 256) xs[i] = x1[(size_t)tok * DM + i];
    if (t < 128) es[t] = eidx[(size_t)tok * 128 + t];
    __syncthreads();
    for (int e = wid; e < 128; e += 4) { const float* u = U + (size_t)es[e] * DM; float d = 0.f;
        for (int j = 0; j < 16; ++j) { const float4 w = *(const float4*)(u + j * 256 + lane * 4); const float* xp = xs + j * 256 + lane * 4; d += w.x * xp[0] + w.y * xp[1] + w.z * xp[2] + w.w * xp[3]; }
        for (int o = 32; o >= 1; o >>= 1) d += __shfl_xor(d, o);
        if (lane == 0) wts[e] = gates[(size_t)tok * 128 + e] * 0.5f * d * (1.0f + erff(d * 0.7071067811865476f)); }
    __syncthreads();
    float acc[16];
    for (int i = 0; i < 16; ++i) acc[i] = 0.f;
    for (int e = 0; e < 128; ++e) { const float w = wts[e]; const float* v = V + (size_t)es[e] * DM; for (int i = 0; i < 16; ++i) acc[i] += w * v[i * 256 + t]; }
    float s = 0.f;
    for (int i = 0; i < 16; ++i) { acc[i] += ALPHA * xs[i * 256 + t]; s += acc[i]; }
    const float mu = block_reduce(s, red, false) * (1.0f / DM); float qq = 0.f;
    for (int i = 0; i < 16; ++i) { acc[i] -= mu; qq += acc[i] * acc[i]; }
    const float rstd = rsqrtf(block_reduce(qq, red, false) * (1.0f / DM) + LN_EPS);
    for (int i = 0; i < 16; ++i) out[(size_t)tok * DM + i * 256 + t] = acc[i] * rstd * g2[i * 256 + t] + b2[i * 256 + t];
}

void gemm(hipStream_t st, const float* A, int lda, const float* B, int ldb, float* C, int ldc, int M, int N, int K, const float* R = nullptr, int ldr = 0, float alpha = 0.f) {
    hipLaunchKernelGGL(gemm_f32, dim3(N / 128, M / 128), dim3(256), 0, st, A, lda, B, ldb, C, ldc, K, R, ldr, alpha);
}
}

extern "C" void kernel_launch(void* const* d_in, const int* in_sizes, int n_in, void* d_out, int out_size, void* d_ws, size_t ws_size, hipStream_t stream) {
    const float* x = (const float*)d_in[0]; const float* w_in = (const float*)d_in[1]; const float* gate_b = (const float*)d_in[2]; const float* rel_bias = (const float*)d_in[3];
    const float* lq1 = (const float*)d_in[4]; const float* lk1 = (const float*)d_in[5]; const float* lq2 = (const float*)d_in[6]; const float* lk2 = (const float*)d_in[7];
    const float* subln_g = (const float*)d_in[8]; const float* w_o_moba = (const float*)d_in[9]; const float* w_o_diff = (const float*)d_in[10]; const float* w_out = (const float*)d_in[11];
    const float* ln1_g = (const float*)d_in[12]; const float* ln1_b = (const float*)d_in[13]; const float* peer_wq = (const float*)d_in[14]; const float* keys1 = (const float*)d_in[15];
    const float* keys2 = (const float*)d_in[16]; const float* peer_u = (const float*)d_in[17]; const float* peer_v = (const float*)d_in[18]; const float* ln2_g = (const float*)d_in[19]; const float* ln2_b = (const float*)d_in[20];
    float* out = (float*)d_out;
    const size_t U64 = (size_t)S * 2048;
    float* ws = (float*)d_ws;
    float *mq = ws + 0 * U64, *mk = ws + 1 * U64, *mv = ws + 2 * U64, *dq = ws + 3 * U64, *dk = ws + 4 * U64, *dv = ws + 5 * U64, *ga = ws + 6 * U64, *gb = ws + 8 * U64;
    float *ya = ws + 10 * U64, *yb = ws + 11 * U64, *mkT = ws + 12 * U64, *dkT = ws + 13 * U64, *x1 = ws + 14 * U64, *pq = ws + 16 * U64;
    float* gates = ws + 17 * U64; int* eidx = (int*)(ws + 17 * U64 + (size_t)S * 128); float* kmean = ws + 17 * U64 + (size_t)S * 256;
    float *ta = ws + 0 * U64, *tb = ws + 2 * U64, *merged = ws + 4 * U64;
    if (ws_size < 18 * U64 * sizeof(float)) return;
    gemm(stream, x, DM, w_in + 0, INW, mq, 2048, S, 2048, DM);
    gemm(stream, x, DM, w_in + 2048, INW, mk, 2048, S, 2048, DM);
    gemm(stream, x, DM, w_in + 4096, INW, mv, 2048, S, 2048, DM);
    gemm(stream, x, DM, w_in + 6144, INW, dq, 2048, S, 2048, DM);
    gemm(stream, x, DM, w_in + 8192, INW, dk, 2048, S, 2048, DM);
    gemm(stream, x, DM, w_in + 10240, INW, dv, 2048, S, 2048, DM);
    gemm(stream, x, DM, w_in + 12288, INW, ga, DM, S, DM, DM);
    gemm(stream, x, DM, w_in + 16384, INW, gb, DM, S, DM, DM);
    hipLaunchKernelGGL(transpose_f32, dim3(2048 / 32, S / 32), dim3(256), 0, stream, mk, 2048, mkT, S);
    hipLaunchKernelGGL(transpose_f32, dim3(2048 / 32, S / 32), dim3(256), 0, stream, dk, 2048, dkT, S);
    hipLaunchKernelGGL(kmean_kernel, dim3(32, 16), dim3(128), 0, stream, mk, kmean);
    hipLaunchKernelGGL(moba_naive, dim3(S, 16), dim3(256), 0, stream, mq, mkT, mv, kmean, rel_bias, ya);
    hipLaunchKernelGGL(diff_naive, dim3(S, 8), dim3(256), 0, stream, dq, dkT, dv, rel_bias, lq1, lk1, lq2, lk2, subln_g, yb);
    gemm(stream, ya, 2048, w_o_moba, DM, ta, DM, S, DM, 2048);
    gemm(stream, yb, 2048, w_o_diff, DM, tb, DM, S, DM, 2048);
    hipLaunchKernelGGL(merge_kernel, dim3((unsigned)((size_t)S * DM / 256)), dim3(256), 0, stream, ga, gb, gate_b, ta, tb, merged);
    gemm(stream, merged, DM, w_out, DM, out, DM, S, DM, DM, x, DM, ALPHA);
    hipLaunchKernelGGL(ln_kernel, dim3(S), dim3(256), 0, stream, out, ln1_g, ln1_b, x1);
    gemm(stream, x1, DM, peer_wq, 2048, pq, 2048, S, 2048, DM);
    hipLaunchKernelGGL(peer_route_naive, dim3(S), dim3(256), 0, stream, pq, keys1, keys2, eidx, gates);
    hipLaunchKernelGGL(peer_expert_naive, dim3(S), dim3(256), 0, stream, x1, eidx, gates, peer_u, peer_v, ln2_g, ln2_b, out);
}
```

```cpp
#include <hip/hip_runtime.h>
#include <math.h>
#include <cstdio>
#include <cstdint>

namespace {
constexpr int S = 8192, DM = 4096, INW = 20480;
constexpr float SCALE = 0.08838834764831845f;
constexpr float ALPHA = 1.189207115002721f;
constexpr float LN_EPS = 1e-5f;
constexpr float LAMBDA_INIT = 0.2f;
typedef float f32x16 __attribute__((ext_vector_type(16)));

__device__ __forceinline__ int t5_bucket(int n) {
    if (n < 16) return n;
    int b = 16;
    b += (n >= 19); b += (n >= 21); b += (n >= 24); b += (n >= 27); b += (n >= 31); b += (n >= 35); b += (n >= 40); b += (n >= 46);
    b += (n >= 52); b += (n >= 59); b += (n >= 67); b += (n >= 77); b += (n >= 87); b += (n >= 99); b += (n >= 113);
    return b;
}

__global__ void __launch_bounds__(256) gemm_f32(const float* __restrict__ A, int lda, const float* __restrict__ B, int ldb, float* __restrict__ C, int ldc, int K,
                                                const float* __restrict__ R, int ldr, float alpha) {
    __shared__ float As[16][132];
    __shared__ float Bs[16][132];
    const int tid = threadIdx.x, lane = tid & 63, wid = tid >> 6, wm = wid >> 1, wn = wid & 1;
    const int m0 = blockIdx.y * 128, n0 = blockIdx.x * 128;
    f32x16 acc[2][2];
    for (int i = 0; i < 2; ++i) for (int j = 0; j < 2; ++j) for (int r = 0; r < 16; ++r) acc[i][j][r] = 0.f;
    for (int k0 = 0; k0 < K; k0 += 16) {
        for (int i = 0; i < 2; ++i) {
            const int idx = tid + i * 256;
            const int r = idx >> 2, c4 = idx & 3;
            const float4 v = *(const float4*)(A + (size_t)(m0 + r) * lda + k0 + c4 * 4);
            As[c4 * 4 + 0][r] = v.x; As[c4 * 4 + 1][r] = v.y; As[c4 * 4 + 2][r] = v.z; As[c4 * 4 + 3][r] = v.w;
            const int kr = idx >> 5, cb = idx & 31;
            const float4 w = *(const float4*)(B + (size_t)(k0 + kr) * ldb + n0 + cb * 4);
            *(float4*)&Bs[kr][cb * 4] = w;
        }
        __syncthreads();
        for (int kk = 0; kk < 16; kk += 2) {
            float a[2], b[2];
            for (int i = 0; i < 2; ++i) a[i] = As[kk + (lane >> 5)][wm * 64 + i * 32 + (lane & 31)];
            for (int j = 0; j < 2; ++j) b[j] = Bs[kk + (lane >> 5)][wn * 64 + j * 32 + (lane & 31)];
            for (int i = 0; i < 2; ++i) for (int j = 0; j < 2; ++j) acc[i][j] = __builtin_amdgcn_mfma_f32_32x32x2f32(a[i], b[j], acc[i][j], 0, 0, 0);
        }
        __syncthreads();
    }
    for (int i = 0; i < 2; ++i) for (int j = 0; j < 2; ++j) for (int r = 0; r < 16; ++r) {
        const int row = m0 + wm * 64 + i * 32 + (r & 3) + 8 * (r >> 2) + 4 * (lane >> 5);
        const int col = n0 + wn * 64 + j * 32 + (lane & 31);
        float v = acc[i][j][r];
        if (R) v += alpha * R[(size_t)row * ldr + col];
        C[(size_t)row * ldc + col] = v;
    }
}

__global__ void transpose_f32(const float* __restrict__ in, int ld_in, float* __restrict__ out, int ld_out) {
    __shared__ float tile[32][33];
    const int tx = threadIdx.x & 31, ty = threadIdx.x >> 5;
    const int r0 = blockIdx.y * 32, c0 = blockIdx.x * 32;
    for (int i = ty; i < 32; i += 8) tile[i][tx] = in[(size_t)(r0 + i) * ld_in + c0 + tx];
    __syncthreads();
    for (int i = ty; i < 32; i += 8) out[(size_t)(c0 + i) * ld_out + r0 + tx] = tile[tx][i];
}

__global__ void kmean_kernel(const float* __restrict__ mk, float* __restrict__ kmean) {
    const int j = blockIdx.x, h = blockIdx.y, d = threadIdx.x;
    float s = 0.f;
    for (int i = 0; i < 256; ++i) s += mk[(size_t)(j * 256 + i) * 2048 + h * 128 + d];
    kmean[(h * 32 + j) * 128 + d] = s * (1.0f / 256.0f);
}

__device__ __forceinline__ float block_reduce(float v, float* red, bool is_max) {
    const int t = threadIdx.x;
    for (int o = 32; o >= 1; o >>= 1) { const float w = __shfl_xor(v, o); v = is_max ? fmaxf(v, w) : v + w; }
    __syncthreads();
    if ((t & 63) == 0) red[t >> 6] = v;
    __syncthreads();
    float r = red[0];
    for (int i = 1; i < (int)(blockDim.x >> 6); ++i) r = is_max ? fmaxf(r, red[i]) : r + red[i];
    __syncthreads();
    return r;
}

__global__ void __launch_bounds__(256) moba_naive(const float* __restrict__ mq, const float* __restrict__ mkT, const float* __restrict__ mv, const float* __restrict__ kmean,
                                                  const float* __restrict__ rel_bias, float* __restrict__ ya) {
    const int q = blockIdx.x, h = blockIdx.y, t = threadIdx.x;
    __shared__ float qs[128]; __shared__ float gate[32]; __shared__ int blk[4]; __shared__ int okf[4]; __shared__ float sc[1024]; __shared__ float red[8]; __shared__ float biasl[32];
    __shared__ float part[256];
    if (t < 128) qs[t] = mq[(size_t)q * 2048 + h * 128 + t];
    if (t < 32) biasl[t] = rel_bias[t * 24 + h];
    __syncthreads();
    const int qb = q >> 8;
    if (t < 32) { float g = -1e30f; if (t < qb) { g = 0.f; const float* km = kmean + (h * 32 + t) * 128; for (int d = 0; d < 128; ++d) g += qs[d] * km[d]; } gate[t] = g; }
    __syncthreads();
    if (t == 0) {
        unsigned used = 0;
        for (int r = 0; r < 3; ++r) { int best = -1; for (int j = 0; j < 32; ++j) if (!((used >> j) & 1u) && (best < 0 || gate[j] > gate[best])) best = j;
            used |= 1u << best; blk[r] = best; okf[r] = best < qb ? 1 : 0; }
        blk[3] = qb; okf[3] = 1;
    }
    __syncthreads();
    float lmax = -1e30f;
    for (int r = 0; r < 4; ++r) {
        const int kpos = blk[r] * 256 + t, dist = q - kpos; float s = -1e30f;
        if (okf[r] && dist >= 0) { float dot = 0.f; const float* kp = mkT + (size_t)(h * 128) * S + kpos; for (int d = 0; d < 128; ++d) dot += qs[d] * kp[(size_t)d * S];
            s = dot * SCALE + biasl[t5_bucket(dist)]; }
        sc[r * 256 + t] = s; lmax = fmaxf(lmax, s);
    }
    const float mx = block_reduce(lmax, red, true);
    float lsum = 0.f;
    for (int r = 0; r < 4; ++r) { const float e = expf(sc[r * 256 + t] - mx); sc[r * 256 + t] = e; lsum += e; }
    const float sum = block_reduce(lsum, red, false);
    const int d = t & 127, half = t >> 7; float a = 0.f;
    for (int i = half * 512; i < half * 512 + 512; ++i) { const float p = sc[i]; if (p != 0.f) { const int kpos = blk[i >> 8] * 256 + (i & 255); a += p * mv[(size_t)kpos * 2048 + h * 128 + d]; } }
    part[t] = a; __syncthreads();
    if (t < 128) ya[(size_t)q * 2048 + h * 128 + t] = (part[t] + part[t + 128]) / sum;
}

__global__ void __launch_bounds__(256) diff_naive(const float* __restrict__ dq, const float* __restrict__ dkT, const float* __restrict__ dv, const float* __restrict__ rel_bias,
                                                  const float* __restrict__ lq1, const float* __restrict__ lk1, const float* __restrict__ lq2, const float* __restrict__ lk2,
                                                  const float* __restrict__ subln_g, float* __restrict__ yb) {
    __shared__ float sc[S];
    __shared__ float qs[256]; __shared__ float red[8]; __shared__ float biasl[32]; __shared__ float lamsh;
    const int q = blockIdx.x, h = blockIdx.y, t = threadIdx.x;
    qs[t] = dq[(size_t)q * 2048 + h * 256 + t];
    if (t < 32) biasl[t] = rel_bias[t * 24 + 16 + h];
    if (t == 0) { float a = 0.f, b = 0.f; for (int d = 0; d < 128; ++d) { a += lq1[d] * lk1[d]; b += lq2[d] * lk2[d]; } lamsh = expf(a) - expf(b) + LAMBDA_INIT; }
    __syncthreads();
    const float lam = lamsh; const int nk = q + 1;
    float acc = 0.f;
    for (int mp = 0; mp < 2; ++mp) {
        float lmax = -1e30f;
        for (int kpos = t; kpos < nk; kpos += 256) { float dot = 0.f; const float* kp = dkT + (size_t)(h * 256 + mp * 128) * S + kpos;
            for (int d = 0; d < 128; ++d) dot += qs[mp * 128 + d] * kp[(size_t)d * S];
            const float s = dot * SCALE + biasl[t5_bucket(q - kpos)]; sc[kpos] = s; lmax = fmaxf(lmax, s); }
        const float mx = block_reduce(lmax, red, true);
        float lsum = 0.f;
        for (int kpos = t; kpos < nk; kpos += 256) { const float e = expf(sc[kpos] - mx); sc[kpos] = e; lsum += e; }
        const float inv = 1.0f / block_reduce(lsum, red, false);
        float a = 0.f;
        for (int i = 0; i < nk; ++i) a += sc[i] * dv[(size_t)i * 2048 + h * 256 + t];
        acc += (mp == 0 ? inv : -lam * inv) * a;
        __syncthreads();
    }
    const float ss = block_reduce(acc * acc, red, false);
    yb[(size_t)q * 2048 + h * 256 + t] = acc * rsqrtf(ss * (1.0f / 256.0f) + LN_EPS) * subln_g[t] * (1.0f - LAMBDA_INIT);
}

__global__ void merge_kernel(const float* __restrict__ ga, const float* __restrict__ gb, const float* __restrict__ gate_b, const float* __restrict__ ta, const float* __restrict__ tb, float* __restrict__ merged) {
    const size_t i = (size_t)blockIdx.x * blockDim.x + threadIdx.x; const int c = (int)(i & (DM - 1));
    const float a = 1.0f / (1.0f + expf(-(ga[i] + gate_b[c]))), b = 1.0f / (1.0f + expf(-(gb[i] + gate_b[DM + c])));
    merged[i] = a * ta[i] + b * tb[i];
}

__global__ void __launch_bounds__(256) ln_kernel(const float* __restrict__ in, const float* __restrict__ g, const float* __restrict__ b, float* __restrict__ out) {
    __shared__ float red[8];
    const int row = blockIdx.x, t = threadIdx.x; float v[16]; float s = 0.f;
    for (int i = 0; i < 16; ++i) { v[i] = in[(size_t)row * DM + i * 256 + t]; s += v[i]; }
    const float mu = block_reduce(s, red, false) * (1.0f / DM); float q = 0.f;
    for (int i = 0; i < 16; ++i) { v[i] -= mu; q += v[i] * v[i]; }
    const float rstd = rsqrtf(block_reduce(q, red, false) * (1.0f / DM) + LN_EPS);
    for (int i = 0; i < 16; ++i) out[(size_t)row * DM + i * 256 + t] = v[i] * rstd * g[i * 256 + t] + b[i * 256 + t];
}

__global__ void __launch_bounds__(256) peer_route_naive(const float* __restrict__ pq, const float* __restrict__ keys1, const float* __restrict__ keys2, int* __restrict__ eidx, float* __restrict__ gates) {
    __shared__ float qh[256]; __shared__ float sc[2][128]; __shared__ float tv[2][16]; __shared__ int ti[2][16];
    const int tok = blockIdx.x, t = threadIdx.x;
    for (int h = 0; h < 8; ++h) {
        qh[t] = pq[(size_t)tok * 2048 + h * 256 + t];
        __syncthreads();
        { const int side = t >> 7, k = t & 127; const float* kr = (side ? keys2 : keys1) + k * 128; float d = 0.f; for (int i = 0; i < 128; ++i) d += qh[side * 128 + i] * kr[i]; sc[side][k] = d; }
        __syncthreads();
        if (t == 0 || t == 128) { const int side = t >> 7; unsigned used[4] = {0, 0, 0, 0};
            for (int r = 0; r < 16; ++r) { int best = -1; for (int j = 0; j < 128; ++j) if (!((used[j >> 5] >> (j & 31)) & 1u) && (best < 0 || sc[side][j] > sc[side][best])) best = j;
                used[best >> 5] |= 1u << (best & 31); tv[side][r] = sc[side][best]; ti[side][r] = best; } }
        __syncthreads();
        if (t == 0) { unsigned used[8] = {0, 0, 0, 0, 0, 0, 0, 0}; float ts[16]; int tp[16];
            for (int r = 0; r < 16; ++r) { int best = -1; float bv = 0.f; for (int j = 0; j < 256; ++j) { if ((used[j >> 5] >> (j & 31)) & 1u) continue; const float c = tv[0][j >> 4] + tv[1][j & 15]; if (best < 0 || c > bv) { best = j; bv = c; } }
                used[best >> 5] |= 1u << (best & 31); ts[r] = bv; tp[r] = best; }
            float sum = 0.f; const float tmax = ts[0]; for (int r = 0; r < 16; ++r) { ts[r] = expf(ts[r] - tmax); sum += ts[r]; }
            for (int r = 0; r < 16; ++r) { eidx[(size_t)tok * 128 + h * 16 + r] = ti[0][tp[r] >> 4] * 128 + ti[1][tp[r] & 15]; gates[(size_t)tok * 128 + h * 16 + r] = ts[r] / sum; } }
        __syncthreads();
    }
}

__global__ void __launch_bounds__(256) peer_expert_naive(const float* __restrict__ x1, const int* __restrict__ eidx, const float* __restrict__ gates, const float* __restrict__ U, const float* __restrict__ V,
                                                         const float* __restrict__ g2, const float* __restrict__ b2, float* __restrict__ out) {
    __shared__ float xs[DM]; __shared__ float wts[128]; __shared__ int es[128]; __shared__ float red[8];
    const int tok = blockIdx.x, t = threadIdx.x, lane = t & 63, wid = t >> 6;
    for (int i = t; i < DM; i += 256) xs[i] = x1[(size_t)tok * DM + i];
    if (t < 128) es[t] = eidx[(size_t)tok * 128 + t];
    __syncthreads();
    for (int e = wid; e < 128; e += 4) { const float* u = U + (size_t)es[e] * DM; float d = 0.f;
        for (int j = 0; j < 16; ++j) { const float4 w = *(const float4*)(u + j * 256 + lane * 4); const float* xp = xs + j * 256 + lane * 4; d += w.x * xp[0] + w.y * xp[1] + w.z * xp[2] + w.w * xp[3]; }
        for (int o = 32; o >= 1; o >>= 1) d += __shfl_xor(d, o);
        if (lane == 0) wts[e] = gates[(size_t)tok * 128 + e] * 0.5f * d * (1.0f + erff(d * 0.7071067811865476f)); }
    __syncthreads();
    float acc[16];
    for (int i = 0; i < 16; ++i) acc[i] = 0.f;
    for (int e = 0; e < 128; ++e) { const float w = wts[e]; const float* v = V + (size_t)es[e] * DM; for (int i = 0; i < 16; ++i) acc[i] += w * v[i * 256 + t]; }
    float s = 0.f;
    for (int i = 0; i < 16; ++i) { acc[i] += ALPHA * xs[i * 256 + t]; s += acc[i]; }
    const float mu = block_reduce(s, red, false) * (1.0f / DM); float qq = 0.f;
    for (int i = 0; i < 16; ++i) { acc[i] -= mu; qq += acc[i] * acc[i]; }
    const float rstd = rsqrtf(block_reduce(qq, red, false) * (1.0f / DM) + LN_EPS);
    for (int i = 0; i < 16; ++i) out[(size_t)tok * DM + i * 256 + t] = acc[i] * rstd * g2[i * 256 + t] + b2[i * 256 + t];
}

void gemm(hipStream_t st, const float* A, int lda, const float* B, int ldb, float* C, int ldc, int M, int N, int K, const float* R = nullptr, int ldr = 0, float alpha = 0.f) {
    hipLaunchKernelGGL(gemm_f32, dim3(N / 128, M / 128), dim3(256), 0, st, A, lda, B, ldb, C, ldc, K, R, ldr, alpha);
}
#define GAS __attribute__((address_space(1)))
#define LAS __attribute__((address_space(3)))
typedef unsigned short bf16;
typedef unsigned v4u __attribute__((ext_vector_type(4)));
typedef unsigned v2u __attribute__((ext_vector_type(2)));
typedef float f32x4 __attribute__((ext_vector_type(4)));
typedef short bf16x8 __attribute__((ext_vector_type(8)));
typedef GAS unsigned gu32;
#define RLX_AGENT __ATOMIC_RELAXED, __HIP_MEMORY_SCOPE_AGENT
#define LDS_WAIT() asm volatile("s_waitcnt lgkmcnt(0)" ::: "memory")
#define VM_WAIT() asm volatile("s_waitcnt vmcnt(0)" ::: "memory")
__device__ __forceinline__ unsigned f2bf(float f) { unsigned u = __builtin_bit_cast(unsigned, f); return (u + 0x7fffu + ((u >> 16) & 1u)) >> 16; }
__device__ __forceinline__ unsigned pk2(float lo, float hi) { return f2bf(lo) | (f2bf(hi) << 16); }
__device__ __forceinline__ float bf2f(unsigned short b) { return __builtin_bit_cast(float, (unsigned)b << 16); }
__device__ __forceinline__ float bflo(unsigned w) { return __builtin_bit_cast(float, w << 16); }
__device__ __forceinline__ float bfhi(unsigned w) { return __builtin_bit_cast(float, w & 0xffff0000u); }

namespace pg8 {
#define PG8_LAS __attribute__((address_space(3)))
typedef unsigned short bf16_t;
typedef short bf16x8 __attribute__((ext_vector_type(8)));
typedef float f32x4 __attribute__((ext_vector_type(4)));
typedef unsigned u32x4 __attribute__((ext_vector_type(4)));
constexpr int BM = 256, BK = 64, HALF = 128, HTB = HALF * BK * 2  , STAGE_BYTES = 8 * HTB, NXCD = 8, WGM = 8;

__host__ __device__ __forceinline__ int lds_byte(int r, int c) { const int st = (r >> 4) * 2 + (c >> 5), rr = r & 15, cc = c & 31, ob = rr * 64 + cc * 2; return st * 1024 + (ob ^ (((ob >> 9) & 1) << 5)); }
__host__ __device__ __forceinline__ void stage_rc(int b, int& R, int& C) { const int st = b / 1024, sb = b % 1024, swz = sb ^ (((sb >> 9) & 1) << 5); R = (st >> 1) * 16 + swz / 64; C = (st & 1) * 32 + (swz % 64) / 2; }
__host__ __device__ __forceinline__ int perm32(int rho) { const int n = rho >> 4, i = rho & 15; return 8 * (i >> 2) + 4 * n + (i & 3); }

struct Unit { int pm, pn, part; };
struct Gemm { const bf16_t* A; const bf16_t* Bt; const bf16_t* A2; const bf16_t* Bt2; int M, N, K; };

struct StaticOrder {
    int nM, nN, nwg, G, c;
    __host__ __device__ void init(int M, int N, int G_, int c_) { nM = M / BM; nN = N / BM; nwg = nM * nN; G = G_; c = c_; }
    __host__ __device__ bool next(int i, Unit& u) const {
        const long L = (long)i * G + c; if (L >= nwg) return false;
        int wgid = (int)L; { const int q = nwg / NXCD, r = nwg % NXCD, xcd = wgid % NXCD, off = wgid / NXCD; wgid = (xcd < r ? xcd * (q + 1) : r * (q + 1) + (xcd - r) * q) + off; }
        const int nig = WGM * nN, gid = wgid / nig, fm = gid * WGM, gsz = (nM - fm) < WGM ? (nM - fm) : WGM;
        u.pm = fm + ((wgid % nig) % gsz); u.pn = (wgid % nig) / gsz; u.part = 0; return true;
    }
    __device__ __forceinline__ void a_ready(const Unit&) const {}
    __device__ __forceinline__ void done(const Unit&) const {}
};


template <class Epi, class Sched, bool ALIGN_EPI = false, bool SP2 = false>
__device__ __forceinline__ void gemm_phase(PG8_LAS unsigned char* lds, const Gemm g, const Sched& S, const Epi& E) {
    const int tid = threadIdx.x, wid = __builtin_amdgcn_readfirstlane(tid >> 6), lane = tid & 63, wr = wid >> 2, wc = wid & 3, fr = lane & 15, fq = lane >> 4;
    const int K = g.K, nt = K / BK;
    unsigned voffA[2], voffB[2];
#pragma unroll
    for (int i = 0; i < 2; ++i) { int R, C; stage_rc(tid * 16 + i * 8192, R, C); const int Rb = Epi::PERM ? ((R & ~31) + perm32(R & 31)) : R;
        voffA[i] = (unsigned)(R * K + C) * 2u; voffB[i] = (unsigned)(Rb * K + C) * 2u; }
    const size_t kstep = (size_t)(BK * 2);
    const size_t hstep = (size_t)HALF * K * 2;
    const size_t tstep = 2 * hstep;
    const unsigned ldsw = (unsigned)wid * 1024u;
    const int aoff = lds_byte(wr * 64 + fr, fq * 8), boff = lds_byte(wc * 32 + fr, fq * 8);
#define PG8_SA(b, h) (((b) * 2 + (h)) * HTB)
#define PG8_SB(b, h) ((4 + (b) * 2 + (h)) * HTB)
#define PG8_STAGE(bufoff, gbase, voff) do { _Pragma("unroll") for (int _i = 0; _i < 2; ++_i) \
        __builtin_amdgcn_global_load_lds((const unsigned*)((const char*)(gbase) + (voff)[_i]), (PG8_LAS unsigned*)(lds + (bufoff) + ldsw + _i * 8192), 16, 0, 0); } while (0)
#define PG8_LDA(dst, b, h) do { _Pragma("unroll") for (int m = 0; m < 4; ++m) _Pragma("unroll") for (int k = 0; k < 2; ++k) dst[m][k] = *(const PG8_LAS bf16x8*)(lds + PG8_SA(b, h) + aoff + m * 2048 + k * 1024); } while (0)
#define PG8_LDB(dst, b, h) do { _Pragma("unroll") for (int n = 0; n < 2; ++n) _Pragma("unroll") for (int k = 0; k < 2; ++k) dst[n][k] = *(const PG8_LAS bf16x8*)(lds + PG8_SB(b, h) + boff + n * 2048 + k * 1024); } while (0)
#define PG8_MMA(ai, bj, At, Bt) do { __builtin_amdgcn_s_setprio(1); _Pragma("unroll") for (int m = 0; m < 4; ++m) _Pragma("unroll") for (int n = 0; n < 2; ++n) _Pragma("unroll") for (int k = 0; k < 2; ++k) \
        acc[ai][bj][m][n] = __builtin_amdgcn_mfma_f32_16x16x32_bf16(Bt[n][k], At[m][k], acc[ai][bj][m][n], 0, 0, 0); __builtin_amdgcn_s_setprio(0); } while (0)
#define PG8_WAIT_V(n) asm volatile("s_waitcnt vmcnt(" #n ")" ::: "memory")
#define PG8_WAIT_L(n) asm volatile("s_waitcnt lgkmcnt(" #n ")" ::: "memory")
#define PG8_BAR __builtin_amdgcn_s_barrier()
#define PG8_SCHED __builtin_amdgcn_sched_barrier(0)
    Unit cur, nxt; int ui = 0;
    if (!S.next(0, cur)) return;
    f32x4 acc[2][2][4][2];
#pragma unroll
    for (int a = 0; a < 2; ++a)
#pragma unroll
        for (int b = 0; b < 2; ++b)
#pragma unroll
            for (int m = 0; m < 4; ++m)
#pragma unroll
                for (int n = 0; n < 2; ++n) acc[a][b][m][n] = (f32x4){0.f, 0.f, 0.f, 0.f};
    bf16x8 At[4][2], B0[2][2], B1[2][2];
    const char* cA = (const char*)(cur.part ? g.A2 : g.A) + (size_t)cur.pm * tstep; const char* cB = (const char*)(cur.part ? g.Bt2 : g.Bt) + (size_t)cur.pn * tstep;
    S.a_ready(cur);
    if constexpr (SP2) {
        PG8_STAGE(PG8_SB(0, 0), cB, voffB); PG8_STAGE(PG8_SB(0, 1), cB + hstep, voffB); PG8_STAGE(PG8_SA(0, 0), cA, voffA); PG8_STAGE(PG8_SA(0, 1), cA + hstep, voffA);
        if (wr == 1) PG8_BAR;
        PG8_WAIT_V(2); PG8_BAR;
        PG8_STAGE(PG8_SB(1, 0), cB + kstep, voffB); PG8_STAGE(PG8_SA(1, 0), cA + kstep, voffA); PG8_STAGE(PG8_SB(1, 1), cB + hstep + kstep, voffB);
        PG8_WAIT_V(6); PG8_BAR;
    } else {
        PG8_STAGE(PG8_SB(0, 0), cB, voffB); PG8_STAGE(PG8_SA(0, 0), cA, voffA); PG8_STAGE(PG8_SB(0, 1), cB + hstep, voffB); PG8_STAGE(PG8_SA(0, 1), cA + hstep, voffA);
        if (wr == 1) PG8_BAR;
        PG8_WAIT_V(4); PG8_BAR;
        PG8_STAGE(PG8_SB(1, 0), cB + kstep, voffB); PG8_STAGE(PG8_SA(1, 0), cA + kstep, voffA); PG8_STAGE(PG8_SB(1, 1), cB + hstep + kstep, voffB);
        PG8_WAIT_V(6); PG8_BAR;
    }
    for (;;) {
        const bool has_next = S.next(ui + 1, nxt);
        const char* nA = has_next ? (const char*)(nxt.part ? g.A2 : g.A) + (size_t)nxt.pm * tstep : cA; const char* nB = has_next ? (const char*)(nxt.part ? g.Bt2 : g.Bt) + (size_t)nxt.pn * tstep : cB;
        for (int t = 0; t < nt; t += 2) {
            const bool last = (t == nt - 2);
            const char* a1 = cA + (size_t)(t + 1) * kstep;
            const char* a2 = last ? nA : cA + (size_t)(t + 2) * kstep; const char* b2 = last ? nB : cB + (size_t)(t + 2) * kstep;
            const char* a3 = a2 + kstep; const char* b3 = b2 + kstep;
            if (last && has_next) S.a_ready(nxt);
            if constexpr (SP2) {
            PG8_LDB(B0, 0, 0); PG8_LDB(B1, 0, 1); PG8_SCHED; PG8_LDA(At, 0, 0); PG8_STAGE(PG8_SA(1, 1), a1 + hstep, voffA);
            PG8_WAIT_V(8); PG8_WAIT_L(0); PG8_BAR; PG8_MMA(0, 0, At, B0); PG8_MMA(0, 1, At, B1); PG8_BAR; PG8_SCHED;
            PG8_LDA(At, 0, 1); PG8_STAGE(PG8_SB(0, 0), b2, voffB); PG8_STAGE(PG8_SB(0, 1), b2 + hstep, voffB); PG8_STAGE(PG8_SA(0, 0), a2, voffA);
            PG8_WAIT_V(8); PG8_WAIT_L(0); PG8_BAR; PG8_MMA(1, 0, At, B0); PG8_MMA(1, 1, At, B1); PG8_BAR; PG8_SCHED;
            PG8_LDB(B0, 1, 0); PG8_LDB(B1, 1, 1); PG8_SCHED; PG8_LDA(At, 1, 0); PG8_STAGE(PG8_SA(0, 1), a2 + hstep, voffA);
            PG8_WAIT_V(8); PG8_WAIT_L(0); PG8_BAR; PG8_MMA(0, 0, At, B0); PG8_MMA(0, 1, At, B1); PG8_BAR; PG8_SCHED;
            PG8_LDA(At, 1, 1); PG8_STAGE(PG8_SB(1, 0), b3, voffB); PG8_STAGE(PG8_SB(1, 1), b3 + hstep, voffB); PG8_STAGE(PG8_SA(1, 0), a3, voffA);
            PG8_WAIT_V(8); PG8_WAIT_L(0); PG8_BAR; PG8_MMA(1, 0, At, B0); PG8_MMA(1, 1, At, B1); PG8_BAR; PG8_SCHED;
            } else {
            PG8_LDB(B0, 0, 0); PG8_SCHED; PG8_LDA(At, 0, 0); PG8_STAGE(PG8_SA(1, 1), a1 + hstep, voffA);
            PG8_WAIT_L(8); PG8_BAR; PG8_WAIT_L(0); PG8_MMA(0, 0, At, B0); PG8_BAR; PG8_SCHED;
            PG8_LDB(B1, 0, 1); PG8_STAGE(PG8_SB(0, 0), b2, voffB);
            PG8_BAR; PG8_WAIT_L(0); PG8_MMA(0, 1, At, B1); PG8_BAR;
            PG8_LDA(At, 0, 1); PG8_STAGE(PG8_SA(0, 0), a2, voffA);
            PG8_BAR; PG8_WAIT_L(0); PG8_MMA(1, 0, At, B0); PG8_BAR; PG8_SCHED;
            PG8_STAGE(PG8_SB(0, 1), b2 + hstep, voffB);
            PG8_WAIT_V(6); PG8_BAR; PG8_MMA(1, 1, At, B1); PG8_BAR;
            PG8_LDB(B0, 1, 0); PG8_SCHED; PG8_LDA(At, 1, 0); PG8_STAGE(PG8_SA(0, 1), a2 + hstep, voffA);
            PG8_WAIT_L(8); PG8_BAR; PG8_WAIT_L(0); PG8_MMA(0, 0, At, B0); PG8_BAR; PG8_SCHED;
            PG8_LDB(B1, 1, 1); PG8_STAGE(PG8_SB(1, 0), b3, voffB);
            PG8_BAR; PG8_WAIT_L(0); PG8_MMA(0, 1, At, B1); PG8_BAR;
            PG8_LDA(At, 1, 1); PG8_STAGE(PG8_SA(1, 0), a3, voffA);
            PG8_BAR; PG8_WAIT_L(0); PG8_MMA(1, 0, At, B0); PG8_BAR; PG8_SCHED;
            PG8_STAGE(PG8_SB(1, 1), b3 + hstep, voffB);
            PG8_WAIT_V(6); PG8_BAR; PG8_MMA(1, 1, At, B1); PG8_BAR;
            }
        }
        if constexpr (ALIGN_EPI) { if (wr == 0) PG8_BAR; }
        if constexpr (!Epi::AFTER_DRAIN) { E(acc, cur, wr, wc, fr, fq); S.done(cur); }
        if (!has_next) break;
#pragma unroll
        for (int a = 0; a < 2; ++a)
#pragma unroll
            for (int b = 0; b < 2; ++b)
#pragma unroll
                for (int m = 0; m < 4; ++m)
#pragma unroll
                    for (int n = 0; n < 2; ++n) acc[a][b][m][n] = (f32x4){0.f, 0.f, 0.f, 0.f};
        cur = nxt; cA = nA; cB = nB; ++ui;
        if constexpr (ALIGN_EPI) { if (wr == 1) PG8_BAR; }
    }
    PG8_WAIT_V(0);
    if constexpr (!ALIGN_EPI) { if (wr == 0) PG8_BAR; }
    PG8_BAR;
    if constexpr (Epi::AFTER_DRAIN) { E.fused(acc, cur, wr, wc, fr, fq, lds, wid, lane); S.done(cur); }
#undef PG8_SA
#undef PG8_SB
#undef PG8_STAGE
#undef PG8_LDA
#undef PG8_LDB
#undef PG8_MMA
#undef PG8_WAIT_V
#undef PG8_WAIT_L
#undef PG8_BAR
#undef PG8_SCHED
}
}

#define XB_TMO      128
#define XB_XCNT(j)  (256  + 64 * (j))
#define XB_XSUB(j)  (1280 + 64 * (j))
#define XB_XGEN(j)  (2304 + 64 * (j))
#define XB_TOP      3328
#define XB_TOPGEN   3392
#define XCD_BAR_WORDS 3456
#define XB_SPIN_CAP (1u << 18)

__device__ __forceinline__ unsigned xb_ld(unsigned* p)              { return __hip_atomic_load(p, __ATOMIC_RELAXED, __HIP_MEMORY_SCOPE_AGENT); }
__device__ __forceinline__ unsigned xb_add(unsigned* p, unsigned v) { return __hip_atomic_fetch_add(p, v, __ATOMIC_RELAXED, __HIP_MEMORY_SCOPE_AGENT); }
__device__ __forceinline__ unsigned xb_xcc_id() { return (unsigned)__builtin_amdgcn_s_getreg((3 << 11) | 20) & 0xFu; }
#define XB_SPIN(cond, bar) do { unsigned _sp = 0; while (cond) { __builtin_amdgcn_s_sleep(1); \
    if ((++_sp & 255u) == 0u) { if (xb_ld(&(bar)[XB_TMO])) break; if (_sp > XB_SPIN_CAP) { atomicAdd(&(bar)[XB_TMO], 1u); break; } } } } while (0)

struct XcdBarrier {
    unsigned* bar; unsigned x;
    volatile LAS unsigned* st;
};

__device__ __forceinline__ XcdBarrier xcd_barrier_post(unsigned* bar, volatile LAS unsigned* st) {
    XcdBarrier b; b.bar = bar; b.x = xb_xcc_id(); b.st = st;
    if (threadIdx.x == 0) (void)xb_add(&bar[XB_XCNT(b.x)], 1u);
    return b;
}
__device__ __forceinline__ void xcd_barrier_complete(unsigned* bar, unsigned x, unsigned& nloc, unsigned& nx) {
    const unsigned G = gridDim.x * gridDim.y * gridDim.z;
    unsigned sum, cnt, mine, sp = 0u;
    for (;;) {
        sum = 0u; cnt = 0u; mine = 0u;
#pragma unroll
        for (unsigned j = 0; j < 16; ++j) { const unsigned c = xb_ld(&bar[XB_XCNT(j)]); sum += c; cnt += (c > 0u) ? 1u : 0u; mine = (j == x) ? c : mine; }
        if (sum == G) break;
        __builtin_amdgcn_s_sleep(1);
        if ((++sp & 255u) == 0u) { if (xb_ld(&bar[XB_TMO])) break; if (sp > XB_SPIN_CAP) { atomicAdd(&bar[XB_TMO], 1u); break; } }
    }
    nloc = mine > 0u ? mine : 1u; nx = cnt > 0u ? cnt : 1u;
}

__device__ __forceinline__ void xcd_barrier(const XcdBarrier& b) {
    asm volatile("s_waitcnt vmcnt(0)" ::: "memory");
    __syncthreads();
    if (threadIdx.x == 0) {
        unsigned* bar = b.bar;
        __builtin_amdgcn_s_waitcnt(0);
        unsigned nloc = b.st[0], nx = b.st[1];
        if (nloc == 0u) { xcd_barrier_complete(bar, b.x, nloc, nx); b.st[0] = nloc; b.st[1] = nx; }
        const unsigned old = xb_add(&bar[XB_XSUB(b.x)], 1u);
        const unsigned gen = old / nloc;
        if (old + 1u == (gen + 1u) * nloc) {
            __builtin_amdgcn_fence(__ATOMIC_RELEASE, "agent");
            asm volatile("s_waitcnt vmcnt(0)" ::: "memory");
            const unsigned og = xb_add(&bar[XB_TOP], 1u);
            const unsigned tg = og / nx;
            if (og + 1u == (tg + 1u) * nx) xb_add(&bar[XB_TOPGEN], 1u);
            else XB_SPIN(xb_ld(&bar[XB_TOPGEN]) == tg, bar);
            __builtin_amdgcn_fence(__ATOMIC_ACQUIRE, "agent");
            xb_add(&bar[XB_XGEN(b.x)], 1u);
            asm volatile("s_waitcnt vmcnt(0)" ::: "memory");
        } else {
            XB_SPIN(xb_ld(&bar[XB_XGEN(b.x)]) == gen, bar);
            __builtin_amdgcn_fence(__ATOMIC_ACQUIRE, "agent");
            asm volatile("s_waitcnt vmcnt(0)" ::: "memory");
        }
    }
    __syncthreads();
}

constexpr int NWAVES = 8;
constexpr size_t MiB = 1u << 20;
constexpr int RING_BYTES = 131072, LDSCTL_OFF = RING_BYTES, MISC_OFF = LDSCTL_OFF + 320, LDS_BYTES = 147456;
constexpr int CW_BAR = 4096;
constexpr size_t CTL_ZERO_BYTES = 1 * MiB;

namespace pg8 {
__device__ __forceinline__ unsigned cvt_pk_bf16(float lo, float hi) { unsigned r; asm volatile("v_cvt_pk_bf16_f32 %0, %1, %2" : "=v"(r) : "v"(lo), "v"(hi)); return r; }
typedef float f32x2 __attribute__((ext_vector_type(2)));
struct EpiStoreBf16 {
    static constexpr bool PERM = true, AFTER_DRAIN = false;
    bf16_t* O; int ldc;
    __device__ __forceinline__ void operator()(const f32x4 (&acc)[2][2][4][2], const Unit& u, int wr, int wc, int fr, int fq) const {
        const int row0 = u.pm * BM + wr * 64 + fr, col0 = u.pn * BM + wc * 32 + 8 * fq;
#pragma unroll
        for (int ai = 0; ai < 2; ++ai)
#pragma unroll
            for (int m = 0; m < 4; ++m) { bf16_t* rowp = O + (size_t)(row0 + ai * HALF + m * 16) * ldc + col0;
#pragma unroll
                for (int bj = 0; bj < 2; ++bj) { const f32x4 v0 = acc[ai][bj][m][0], v1 = acc[ai][bj][m][1];
                    u32x4 w; w.x = cvt_pk_bf16(v0[0], v0[1]); w.y = cvt_pk_bf16(v0[2], v0[3]); w.z = cvt_pk_bf16(v1[0], v1[1]); w.w = cvt_pk_bf16(v1[2], v1[3]);
                    *(u32x4*)(rowp + bj * HALF) = w; } }
    }
};

struct EpiMerge {
    static constexpr bool PERM = true, AFTER_DRAIN = false;
    bf16_t* Mg; const bf16_t* proj; const float* gate_b;
    __device__ __forceinline__ void operator()(const f32x4 (&acc)[2][2][4][2], const Unit& u, int wr, int wc, int fr, int fq) const {
        const int row0 = u.pm * BM + wr * 64 + fr, col0 = u.pn * BM + wc * 32 + 8 * fq; const int part = u.part;
        const bf16_t* gsrc = proj + (part ? 16384 : 12288); const float* gbp = gate_b + (part ? 4096 : 0);
        f32x4 gbv[2][2];
#pragma unroll
        for (int bj = 0; bj < 2; ++bj)
#pragma unroll
            for (int n = 0; n < 2; ++n) gbv[bj][n] = *(const f32x4*)(gbp + col0 + bj * HALF + 4 * n);
#pragma unroll
        for (int ai = 0; ai < 2; ++ai)
#pragma unroll
            for (int m = 0; m < 4; ++m) { const int row = row0 + ai * HALF + m * 16;
#pragma unroll
                for (int bj = 0; bj < 2; ++bj) { const int col = col0 + bj * HALF;
                    const u32x4 gw = *(const u32x4*)(gsrc + (size_t)row * 20480 + col);
                    float z[8]; z[0] = __uint_as_float(gw.x << 16); z[1] = __uint_as_float(gw.x & 0xffff0000u); z[2] = __uint_as_float(gw.y << 16); z[3] = __uint_as_float(gw.y & 0xffff0000u);
                    z[4] = __uint_as_float(gw.z << 16); z[5] = __uint_as_float(gw.z & 0xffff0000u); z[6] = __uint_as_float(gw.w << 16); z[7] = __uint_as_float(gw.w & 0xffff0000u);
                    float v[8];
#pragma unroll
                    for (int k = 0; k < 8; ++k) { const float zz = z[k] + gbv[bj][k >> 2][k & 3]; const float sg = __builtin_amdgcn_rcpf(1.0f + __builtin_amdgcn_exp2f(-1.4426950408889634f * zz)); v[k] = sg * acc[ai][bj][m][k >> 2][k & 3]; }
                    bf16_t* dst = Mg + (size_t)row * 4096 + col;
                    if (part) { const u32x4 pw = *(const u32x4*)dst;
                        v[0] += __uint_as_float(pw.x << 16); v[1] += __uint_as_float(pw.x & 0xffff0000u); v[2] += __uint_as_float(pw.y << 16); v[3] += __uint_as_float(pw.y & 0xffff0000u);
                        v[4] += __uint_as_float(pw.z << 16); v[5] += __uint_as_float(pw.z & 0xffff0000u); v[6] += __uint_as_float(pw.w << 16); v[7] += __uint_as_float(pw.w & 0xffff0000u); }
                    u32x4 w; w.x = cvt_pk_bf16(v[0], v[1]); w.y = cvt_pk_bf16(v[2], v[3]); w.z = cvt_pk_bf16(v[4], v[5]); w.w = cvt_pk_bf16(v[6], v[7]);
                    *(u32x4*)dst = w; } }
    }
};
struct DualOrder : StaticOrder { __device__ bool next(int i, Unit& u) const { if (!StaticOrder::next(i >> 1, u)) return false; u.part = i & 1; return true; } };
struct EpiResF32 {
    static constexpr bool PERM = false, AFTER_DRAIN = false;
    float* C; const float* R; float alpha;
    __device__ __forceinline__ void operator()(const f32x4 (&acc)[2][2][4][2], const Unit& u, int wr, int wc, int fr, int fq) const {
        const int row0 = u.pm * BM + wr * 64 + fr, col0 = u.pn * BM + wc * 32 + 4 * fq;
#pragma unroll
        for (int ai = 0; ai < 2; ++ai)
#pragma unroll
            for (int m = 0; m < 4; ++m) { const size_t off = (size_t)(row0 + ai * HALF + m * 16) * 4096 + col0;
#pragma unroll
                for (int bj = 0; bj < 2; ++bj)
#pragma unroll
                    for (int n = 0; n < 2; ++n) { const f32x4 r = *(const f32x4*)(R + off + bj * HALF + n * 16); *(f32x4*)(C + off + bj * HALF + n * 16) = r * alpha + acc[ai][bj][m][n]; } }
    }
};
struct EpiPeerAct {
    static constexpr bool PERM = true, AFTER_DRAIN = false;
    bf16_t* Gd;
    __device__ __forceinline__ void operator()(const f32x4 (&acc)[2][2][4][2], const Unit& u, int wr, int wc, int fr, int fq) const {
        const int row0 = u.pm * BM + wr * 64 + fr, col0 = u.pn * BM + wc * 32 + 8 * fq;
#pragma unroll
        for (int ai = 0; ai < 2; ++ai)
#pragma unroll
            for (int m = 0; m < 4; ++m) { bf16_t* rowp = Gd + (size_t)(row0 + ai * HALF + m * 16) * 16384 + col0;
#pragma unroll
                for (int bj = 0; bj < 2; ++bj) { const u32x4 gw = *(const u32x4*)(rowp + bj * HALF);
                    if ((gw.x | gw.y | gw.z | gw.w) != 0u) {
                        float g[8]; g[0] = __uint_as_float(gw.x << 16); g[1] = __uint_as_float(gw.x & 0xffff0000u); g[2] = __uint_as_float(gw.y << 16); g[3] = __uint_as_float(gw.y & 0xffff0000u);
                        g[4] = __uint_as_float(gw.z << 16); g[5] = __uint_as_float(gw.z & 0xffff0000u); g[6] = __uint_as_float(gw.w << 16); g[7] = __uint_as_float(gw.w & 0xffff0000u);
                        float v[8];
#pragma unroll
                        for (int k = 0; k < 8; ++k) { const float a = acc[ai][bj][m][k >> 2][k & 3]; v[k] = g[k] != 0.f ? g[k] * 0.5f * a * (1.0f + erff(a * 0.7071067811865476f)) : 0.f; }
                        u32x4 w; w.x = cvt_pk_bf16(v[0], v[1]); w.y = cvt_pk_bf16(v[2], v[3]); w.z = cvt_pk_bf16(v[4], v[5]); w.w = cvt_pk_bf16(v[6], v[7]);
                        *(u32x4*)(rowp + bj * HALF) = w; } } }
    }
};
}

__device__ __forceinline__ void p0_transpose_item(const float* W, int K, int N, bf16* WT, LAS float* scr, int item, int lane) {
    const int nblk = N / 32, kb = item / nblk, nb = item % nblk, k0 = 64 * kb, n0 = 32 * nb;
#pragma unroll 8
    for (int i = 0; i < 32; ++i) { const int kk = 2 * i + (lane >> 5); scr[kk * 33 + (lane & 31)] = W[(size_t)(k0 + kk) * N + n0 + (lane & 31)]; }
    LDS_WAIT(); asm volatile("" ::: "memory");
    const int c = lane & 7;
#pragma unroll
    for (int j = 0; j < 4; ++j) { const int n = (lane >> 3) + 8 * j; const LAS float* s = scr + (8 * c) * 33 + n;
        v4u o; o.x = pk2(s[0 * 33], s[1 * 33]); o.y = pk2(s[2 * 33], s[3 * 33]); o.z = pk2(s[4 * 33], s[5 * 33]); o.w = pk2(s[6 * 33], s[7 * 33]);
        *(GAS v4u*)(WT + (size_t)(n0 + n) * K + k0 + 8 * c) = o; }
    LDS_WAIT(); asm volatile("" ::: "memory");
}
__device__ __forceinline__ void p0_convert(const float* src, bf16* dst, size_t n8, size_t gtid, size_t gthreads) {
    for (size_t i = gtid; i < n8; i += gthreads) { const f32x4 a = *(const GAS f32x4*)(src + i * 8), b = *(const GAS f32x4*)(src + i * 8 + 4);
        v4u o; o.x = pk2(a.x, a.y); o.y = pk2(a.z, a.w); o.z = pk2(b.x, b.y); o.w = pk2(b.z, b.w); *(GAS v4u*)(dst + i * 8) = o; }
}

namespace att {
using s16x4  = __attribute__((ext_vector_type(4))) short;
using f32x16 = __attribute__((ext_vector_type(16))) float;
using u32x4  = __attribute__((ext_vector_type(4))) unsigned;
constexpr int NW = 8, QBLK = 32, KVBLK = 64, LDP = INW;
constexpr float LOG2E = 1.4426950408889634f, CQK = SCALE * LOG2E, THRL = 11.5f, NEGBIG = -1e30f;
constexpr int SHM_V = 16384, SHM_K = 16384;
constexpr int OFF_V = 0, OFF_K = 2 * SHM_V, OFF_WS = OFF_K + 2 * SHM_K, OFF_LUT = OFF_WS + NW * 64 * 4, OFF_GATE = OFF_LUT + 2176, GATE_W = 33 * 32 * 4, OFF_END = OFF_GATE + NW * GATE_W;
static_assert(OFF_END <= RING_BYTES, "attention LDS");
#define KSWZ(row, colB) ((row) * 256 + ((colB) ^ (((row) & 7) << 4)))
#define SBAR() __builtin_amdgcn_sched_barrier(0)
__device__ __forceinline__ int crow(int r, int hi) { return (r & 3) + 8 * (r >> 2) + 4 * hi; }
__device__ __forceinline__ unsigned cvtpk(float lo, float hi) { unsigned r; asm volatile("v_cvt_pk_bf16_f32 %0, %1, %2" : "=v"(r) : "v"(lo), "v"(hi)); return r; }

__device__ __forceinline__ void bias_far(f32x16& p0, f32x16& p1, float rowoff) {
#pragma unroll
  for (int r = 0; r < 16; ++r) { p0[r] = fmaf(p0[r], CQK, rowoff); p1[r] = fmaf(p1[r], CQK, rowoff); }
}
constexpr int LUT_DMAX = 207, LUT_N = 528;
__device__ __forceinline__ void bias_near(f32x16& p0, f32x16& p1, const LAS float* rl, int dist0  , int hi) {
  const LAS float* b = rl + (LUT_DMAX - dist0 + 4 * hi);
#pragma unroll
  for (int r = 0; r < 16; ++r) { const int c = (r & 3) + 8 * (r >> 2); p0[r] = fmaf(p0[r], CQK, b[c]); p1[r] = fmaf(p1[r], CQK, b[c + 32]); }
}
__device__ __forceinline__ void partialSM(f32x16& p0, f32x16& p1, float& m_reg, float& mn, float& alpha) {
  float pmax = p0[0];
#pragma unroll
  for (int r = 1; r < 16; ++r) pmax = fmaxf(pmax, p0[r]);
#pragma unroll
  for (int r = 0; r < 16; ++r) pmax = fmaxf(pmax, p1[r]);
  { auto rr = __builtin_amdgcn_permlane32_swap(__float_as_uint(pmax), __float_as_uint(pmax), false, false);
    pmax = fmaxf(__uint_as_float(rr[0]), __uint_as_float(rr[1])); }
  if (__builtin_expect(__all(pmax - m_reg <= THRL), 1)) { mn = m_reg; alpha = 1.f; }
  else { mn = fmaxf(m_reg, pmax); alpha = __builtin_amdgcn_exp2f(m_reg - mn); m_reg = mn; }
#pragma unroll
  for (int r = 0; r < 16; ++r) { p0[r] -= mn; p1[r] -= mn; }
#pragma unroll
  for (int r = 0; r < 16; ++r) p0[r] = __builtin_amdgcn_exp2f(p0[r]);
}
__device__ __forceinline__ void finishSM(f32x16& p0, f32x16& p1, float alpha, float& l_reg, bf16x8& pa0, bf16x8& pa1, bf16x8& pa2, bf16x8& pa3) {
#pragma unroll
  for (int r = 0; r < 16; ++r) p1[r] = __builtin_amdgcn_exp2f(p1[r]);
  float ps = 0;
#pragma unroll
  for (int r = 0; r < 16; ++r) ps += p0[r];
#pragma unroll
  for (int r = 0; r < 16; ++r) ps += p1[r];
  { auto rr = __builtin_amdgcn_permlane32_swap(__float_as_uint(ps), __float_as_uint(ps), false, false);
    ps = __uint_as_float(rr[0]) + __uint_as_float(rr[1]); }
  l_reg = l_reg * alpha + ps;
#define PK4(P, BASE, OUT) do { unsigned a0 = cvtpk(P[BASE + 0], P[BASE + 1]), a1 = cvtpk(P[BASE + 2], P[BASE + 3]);   \
    unsigned b0 = cvtpk(P[BASE + 4], P[BASE + 5]), b1 = cvtpk(P[BASE + 6], P[BASE + 7]);                              \
    auto r0 = __builtin_amdgcn_permlane32_swap(a0, b0, false, false); auto r1 = __builtin_amdgcn_permlane32_swap(a1, b1, false, false); \
    u32x4 w = {r0[0], r1[0], r0[1], r1[1]}; OUT = *reinterpret_cast<bf16x8*>(&w); } while (0)
  PK4(p0, 0, pa0); PK4(p0, 8, pa1); PK4(p1, 0, pa2); PK4(p1, 8, pa3);
#undef PK4
}
__device__ __forceinline__ void qkt(f32x16& p0, f32x16& p1, const LAS char* Ks, const bf16x8* qr, int r32, int hi) {
  p0 = f32x16{}; p1 = f32x16{};
#pragma unroll
  for (int d0 = 0; d0 < 8; ++d0) { const int cb = (d0 * 16 + hi * 8) * 2;
    const bf16x8 b0 = *reinterpret_cast<const LAS bf16x8*>(Ks + KSWZ(r32, cb));
    const bf16x8 b1 = *reinterpret_cast<const LAS bf16x8*>(Ks + KSWZ(32 + r32, cb));
    p0 = __builtin_amdgcn_mfma_f32_32x32x16_bf16(b0, qr[d0], p0, 0, 0, 0);
    p1 = __builtin_amdgcn_mfma_f32_32x32x16_bf16(b1, qr[d0], p1, 0, 0, 0); }
}
__device__ __forceinline__ int v_st(int k, int c) { const int kk = (k & ~0xC) | ((k & 4) << 1) | ((k & 8) >> 1); return ((kk >> 3) * 4 + (c >> 5)) * 512 + ((kk & 7) * 32 + (c & 31)) * 2; }
__device__ __forceinline__ int v_rd_base(int lane) { return ((lane & 3) << 3) | (((lane >> 2) & 3) << 6) | (((lane >> 4) & 1) << 5) | (((lane >> 5) & 1) << 8); }
constexpr int v_rd_off(int d0, int ks, int half) { return d0 * 512 + ks * 4096 + half * 2048; }
template <int OFF> __device__ __forceinline__ s16x4 tr_read(int vb) {
  s16x4 r; asm volatile("ds_read_b64_tr_b16 %0, %1 offset:%2" : "=&v"(r) : "v"(vb), "i"(OFF) : "memory"); return r;
}
template <int D0> __device__ __forceinline__ void pv_one(f32x16& od, int vb, bf16x8 pa0, bf16x8 pa1, bf16x8 pa2, bf16x8 pa3) {
  const s16x4 l0 = tr_read<v_rd_off(D0, 0, 0)>(vb), h0 = tr_read<v_rd_off(D0, 0, 1)>(vb), l1 = tr_read<v_rd_off(D0, 1, 0)>(vb), h1 = tr_read<v_rd_off(D0, 1, 1)>(vb);
  const s16x4 l2 = tr_read<v_rd_off(D0, 2, 0)>(vb), h2 = tr_read<v_rd_off(D0, 2, 1)>(vb), l3 = tr_read<v_rd_off(D0, 3, 0)>(vb), h3 = tr_read<v_rd_off(D0, 3, 1)>(vb);
  asm volatile("s_waitcnt lgkmcnt(0)" ::: "memory"); SBAR();
#define PK(L, H) (bf16x8){L[0], L[1], L[2], L[3], H[0], H[1], H[2], H[3]}
  od = __builtin_amdgcn_mfma_f32_32x32x16_bf16(pa0, PK(l0, h0), od, 0, 0, 0);
  od = __builtin_amdgcn_mfma_f32_32x32x16_bf16(pa1, PK(l1, h1), od, 0, 0, 0);
  od = __builtin_amdgcn_mfma_f32_32x32x16_bf16(pa2, PK(l2, h2), od, 0, 0, 0);
  od = __builtin_amdgcn_mfma_f32_32x32x16_bf16(pa3, PK(l3, h3), od, 0, 0, 0);
#undef PK
}
__device__ __forceinline__ void pv_d0(f32x16* o, int vb, bf16x8 pa0, bf16x8 pa1, bf16x8 pa2, bf16x8 pa3) {
  pv_one<0>(o[0], vb, pa0, pa1, pa2, pa3); pv_one<1>(o[1], vb, pa0, pa1, pa2, pa3); pv_one<2>(o[2], vb, pa0, pa1, pa2, pa3); pv_one<3>(o[3], vb, pa0, pa1, pa2, pa3);
}

struct UnitDesc { const bf16* Q; const bf16* K; const bf16* V; bf16* O; int ldo; int qb; int bias_head; const bf16* kmean;   };

__device__ __forceinline__ void attn_unit(const UnitDesc& u, const float* __restrict__ rel_bias, LAS char* lds) {
  int tid_ = threadIdx.x; asm volatile("" : "+v"(tid_));
  const int tid = tid_, wid = tid >> 6, lane = tid & 63, r32 = lane & 31, hi = lane >> 5;
  LAS char* V_lds = lds + OFF_V; LAS char* K_lds = lds + OFF_K;
  LAS float* wsl = (LAS float*)(lds + OFF_WS) + wid * 64; LAS float* li_l = wsl; LAS float* al_l = wsl + 32;
  LAS float* lut = (LAS float*)(lds + OFF_LUT);
  const int q0 = u.qb * 256, qw0 = q0 + wid * QBLK, qpos = qw0 + r32;
  __syncthreads();
  for (int i = tid; i < LUT_N; i += 512) { const int d = LUT_DMAX - i; lut[i] = d < 0 ? NEGBIG : rel_bias[t5_bucket(d > 127 ? 127 : d) * 24 + u.bias_head] * LOG2E; }
  float m_reg = NEGBIG, l_reg = 0; f32x16 o[4] = {}; bf16x8 qr[8];
  const bf16* Qw = u.Q + (size_t)(qw0 + r32) * LDP + hi * 8;
#pragma unroll
  for (int d0 = 0; d0 < 8; ++d0) qr[d0] = *reinterpret_cast<const bf16x8*>(Qw + d0 * 16);
  unsigned rowmask = 0xffffffffu;
  if (u.kmean) {
    { const int r = tid >> 4, c = (tid & 15) * 8;
      *reinterpret_cast<LAS bf16x8*>(K_lds + KSWZ(r, c * 2)) = *reinterpret_cast<const bf16x8*>(u.kmean + r * 128 + c); }
    __syncthreads();
    f32x16 g0 = f32x16{};
#pragma unroll
    for (int d0 = 0; d0 < 8; ++d0) { const int cb = (d0 * 16 + hi * 8) * 2;
      const bf16x8 b0 = *reinterpret_cast<const LAS bf16x8*>(K_lds + KSWZ(r32, cb));
      g0 = __builtin_amdgcn_mfma_f32_32x32x16_bf16(b0, qr[d0], g0, 0, 0, 0); }
    LAS float* gs = (LAS float*)(lds + OFF_GATE + wid * GATE_W);
#pragma unroll
    for (int r = 0; r < 16; ++r) gs[r32 * 33 + crow(r, hi)] = g0[r];
    asm volatile("s_waitcnt lgkmcnt(0)" ::: "memory");
    __builtin_amdgcn_wave_barrier();
    float b1v = NEGBIG, b2v = NEGBIG, b3v = NEGBIG; int b1i = -1, b2i = -1, b3i = -1;
    for (int j = 0; j < u.qb; ++j) { const float g = gs[r32 * 33 + j];
      if (g > b1v) { b3v = b2v; b3i = b2i; b2v = b1v; b2i = b1i; b1v = g; b1i = j; }
      else if (g > b2v) { b3v = b2v; b3i = b2i; b2v = g; b2i = j; }
      else if (g > b3v) { b3v = g; b3i = j; } }
    rowmask = 1u << u.qb;
    if (b1i >= 0) rowmask |= 1u << b1i; if (b2i >= 0) rowmask |= 1u << b2i; if (b3i >= 0) rowmask |= 1u << b3i;
    __syncthreads();
  }
  const int sr = tid >> 4, sc = (tid & 15) * 8, vst0 = v_st(sr, sc), vst1 = v_st(32 + sr, sc);
  const int vb0 = (int)(uintptr_t)V_lds + v_rd_base(lane);
  struct { bf16x8 vs0, vs1, ks0, ks1; } sr_[2];
  const bf16* Kh = u.K; const bf16* Vh = u.V;
#define SLOAD(i, k0) do { sr_[i].vs0 = *reinterpret_cast<const bf16x8*>(&Vh[(size_t)((k0) + sr) * LDP + sc]); sr_[i].vs1 = *reinterpret_cast<const bf16x8*>(&Vh[(size_t)((k0) + 32 + sr) * LDP + sc]); \
    sr_[i].ks0 = *reinterpret_cast<const bf16x8*>(&Kh[(size_t)((k0) + sr) * LDP + sc]); sr_[i].ks1 = *reinterpret_cast<const bf16x8*>(&Kh[(size_t)((k0) + 32 + sr) * LDP + sc]); } while (0)
#define SWRITE(b, i) do { *(LAS bf16x8*)(V_lds + (b) * SHM_V + vst0) = sr_[i].vs0; *(LAS bf16x8*)(V_lds + (b) * SHM_V + vst1) = sr_[i].vs1; const int kc = sc * 2; \
    *(LAS bf16x8*)(K_lds + (b) * SHM_K + KSWZ(sr, kc)) = sr_[i].ks0; *(LAS bf16x8*)(K_lds + (b) * SHM_K + KSWZ(32 + sr, kc)) = sr_[i].ks1; } while (0)
#define SWAIT() asm volatile("s_waitcnt vmcnt(4)" ::: "memory")
#define RESC(a) do { if (__any((a) < 1.f)) { if (hi == 0) al_l[r32] = (a); asm volatile("s_waitcnt lgkmcnt(0)" ::: "memory"); \
    _Pragma("unroll") for (int d = 0; d < 4; ++d) _Pragma("unroll") for (int r = 0; r < 16; ++r) o[d][r] *= al_l[crow(r, hi)]; } } while (0)
#define BIAS(P0, P1, j) do { const int k0_ = (j) * KVBLK; const bool allowed_ = (rowmask >> ((j) >> 2)) & 1u; \
    if (qw0 - k0_ - 63 >= 113) bias_far(P0, P1, allowed_ ? b31c : NEGBIG); else bias_near(P0, P1, lut, allowed_ ? qpos - k0_ : -64, hi); } while (0)
  f32x16 pA0, pA1, pB0, pB1; float mnA, mnB, alA, alB; bf16x8 pa0, pa1, pa2, pa3; const int NT = 4 * (u.qb + 1);
  constexpr int SE = 0, SO = 1;
  SLOAD(SE, 0); asm volatile("s_waitcnt vmcnt(0)" ::: "memory"); SWRITE(0, SE); __syncthreads();
  const float b31c = lut[LUT_DMAX - 127];
  qkt(pA0, pA1, K_lds, qr, r32, hi); BIAS(pA0, pA1, 0); partialSM(pA0, pA1, m_reg, mnA, alA);
  SLOAD(SO, KVBLK); if (2 < NT) SLOAD(SE, 2 * KVBLK);
  SWAIT(); SWRITE(1, SO); __syncthreads();
  for (int j = 1; j + 1 < NT; j += 2) {
    SBAR(); qkt(pB0, pB1, K_lds + SHM_K, qr, r32, hi);
    finishSM(pA0, pA1, alA, l_reg, pa0, pa1, pa2, pa3); SBAR();
    SLOAD(SO, (j + 2) * KVBLK); SBAR();
    pv_d0(o, vb0, pa0, pa1, pa2, pa3); BIAS(pB0, pB1, j); partialSM(pB0, pB1, m_reg, mnB, alB);
    __syncthreads(); SWAIT(); SWRITE(0, SE);
    RESC(alB); __syncthreads();
    SBAR(); qkt(pA0, pA1, K_lds, qr, r32, hi);
    finishSM(pB0, pB1, alB, l_reg, pa0, pa1, pa2, pa3); SBAR();
    if (j + 3 < NT) SLOAD(SE, (j + 3) * KVBLK); SBAR();
    pv_d0(o, vb0 + SHM_V, pa0, pa1, pa2, pa3); BIAS(pA0, pA1, j + 1); partialSM(pA0, pA1, m_reg, mnA, alA);
    __syncthreads(); SWAIT(); SWRITE(1, SO);
    RESC(alA); __syncthreads();
  }
  SBAR(); qkt(pB0, pB1, K_lds + SHM_K, qr, r32, hi);
  finishSM(pA0, pA1, alA, l_reg, pa0, pa1, pa2, pa3); SBAR();
  pv_d0(o, vb0, pa0, pa1, pa2, pa3); BIAS(pB0, pB1, NT - 1); partialSM(pB0, pB1, m_reg, mnB, alB);
  __syncthreads(); RESC(alB);
  finishSM(pB0, pB1, alB, l_reg, pa0, pa1, pa2, pa3); SBAR();
  pv_d0(o, vb0 + SHM_V, pa0, pa1, pa2, pa3);
  if (hi == 0) li_l[r32] = l_reg; asm volatile("s_waitcnt lgkmcnt(0)" ::: "memory");
  float rli[16];
#pragma unroll
  for (int r = 0; r < 16; ++r) rli[r] = __builtin_amdgcn_rcpf(li_l[crow(r, hi)]);
  bf16* Ow = u.O + (size_t)qw0 * u.ldo;
#pragma unroll
  for (int r = 0; r < 16; ++r) { const int orow = crow(r, hi);
#pragma unroll
    for (int d0 = 0; d0 < 4; ++d0) Ow[(size_t)orow * u.ldo + d0 * 32 + r32] = (bf16)f2bf(o[d0][r] * rli[r]); }
#undef SLOAD
#undef SWRITE
#undef SWAIT
#undef RESC
#undef BIAS
}
}

namespace rt {
using f32x16 = __attribute__((ext_vector_type(16))) float;
__device__ __forceinline__ void ins16(float (&val)[16], int (&idx)[16], float v, int i) {
#pragma unroll
    for (int s = 0; s < 16; ++s) { const bool gt = v > val[s]; const float tv = gt ? val[s] : v; const int ti = gt ? idx[s] : i; val[s] = gt ? v : val[s]; idx[s] = gt ? i : idx[s]; v = tv; i = ti; }
}
__device__ __forceinline__ void side_top16(const bf16* q, const bf16* keys, int r32, int hi, float (&val)[16], int (&idx)[16]) {
    bf16x8 qf[8];
#pragma unroll
    for (int d0 = 0; d0 < 8; ++d0) qf[d0] = *reinterpret_cast<const bf16x8*>(q + d0 * 16 + hi * 8);
    f32x16 acc[4];
#pragma unroll
    for (int nb = 0; nb < 4; ++nb) { acc[nb] = f32x16{};
#pragma unroll
        for (int d0 = 0; d0 < 8; ++d0) { const bf16x8 kf = *reinterpret_cast<const bf16x8*>(keys + (32 * nb + r32) * 128 + d0 * 16 + hi * 8);
            acc[nb] = __builtin_amdgcn_mfma_f32_32x32x16_bf16(kf, qf[d0], acc[nb], 0, 0, 0); } }
#pragma unroll
    for (int s = 0; s < 16; ++s) { val[s] = -3.0e38f; idx[s] = 0; }
#pragma unroll
    for (int nb = 0; nb < 4; ++nb)
#pragma unroll
        for (int r = 0; r < 16; ++r) ins16(val, idx, acc[nb][r], 32 * nb + (r & 3) + 8 * (r >> 2) + 4 * hi);
    float pv[16]; int pi[16];
#pragma unroll
    for (int s = 0; s < 16; ++s) { pv[s] = __shfl_xor(val[s], 32); pi[s] = __shfl_xor(idx[s], 32); }
#pragma unroll
    for (int s = 0; s < 16; ++s) ins16(val, idx, pv[s], pi[s]);
}
template <int I, int J> struct Cand {
    static __device__ __forceinline__ void run(float (&cv)[16], int (&ci)[16], const float (&v1)[16], const float (&v2)[16], const int (&i1)[16], const int (&i2)[16]) {
        if constexpr ((I + 1) * (J + 1) <= 16) { ins16(cv, ci, v1[I] + v2[J], i1[I] * 128 + i2[J]); Cand<I, J + 1>::run(cv, ci, v1, v2, i1, i2); }
        else if constexpr (I + 1 < 16) Cand<I + 1, 0>::run(cv, ci, v1, v2, i1, i2);
    }
};
template <int I> struct Cand<I, 16> { static __device__ __forceinline__ void run(float (&cv)[16], int (&ci)[16], const float (&v1)[16], const float (&v2)[16], const int (&i1)[16], const int (&i2)[16]) {
        if constexpr (I + 1 < 16) Cand<I + 1, 0>::run(cv, ci, v1, v2, i1, i2); } };
constexpr int OFF_E = 0, OFF_G = 16384;
__device__ __forceinline__ void route_block(int t0, const bf16* PQ, const bf16* KEYSB, bf16* GD, int* EIDX, float* GATES, LAS char* lds) {
    int tid_ = threadIdx.x; asm volatile("" : "+v"(tid_));
    const int tid = tid_, h = tid >> 6, lane = tid & 63, r32 = lane & 31, hi = lane >> 5;
    LAS int* ent_e = (LAS int*)(lds + OFF_E); LAS float* ent_g = (LAS float*)(lds + OFF_G);
    __syncthreads();
    const bf16* q = PQ + (size_t)(t0 + r32) * 2048 + h * 256;
    float v1[16], v2[16], cv[16]; int i1[16], i2[16], ci[16];
    side_top16(q, KEYSB, r32, hi, v1, i1);
    side_top16(q + 128, KEYSB + 128 * 128, r32, hi, v2, i2);
#pragma unroll
    for (int s = 0; s < 16; ++s) { cv[s] = -3.0e38f; ci[s] = 0; }
    Cand<0, 0>::run(cv, ci, v1, v2, i1, i2);
    const float mx = cv[0]; float sum = 0.f;
#pragma unroll
    for (int s = 0; s < 16; ++s) { cv[s] = __expf(cv[s] - mx); sum += cv[s]; }
    const float inv = 1.0f / sum;
    if (hi == 0) {
#pragma unroll
        for (int s = 0; s < 16; ++s) { ent_e[r32 * 128 + h * 16 + s] = ci[s]; ent_g[r32 * 128 + h * 16 + s] = cv[s] * inv; }
        if (EIDX) {
#pragma unroll
            for (int s = 0; s < 16; ++s) { EIDX[(size_t)(t0 + r32) * 128 + h * 16 + s] = ci[s]; GATES[(size_t)(t0 + r32) * 128 + h * 16 + s] = cv[s] * inv; } }
    }
    __syncthreads();
    { const int tok = tid >> 4, s0 = (tid & 15) * 8;
        for (int k = 0; k < 8; ++k) { const int sidx = s0 + k, e = ent_e[tok * 128 + sidx]; float g = 0.f; bool first = true;
            for (int s2 = 0; s2 < 128; ++s2) { if (ent_e[tok * 128 + s2] == e) { g += ent_g[tok * 128 + s2]; if (s2 < sidx) first = false; } }
            if (first) GD[(size_t)(t0 + tok) * 16384 + e] = (bf16)f2bf(g); } }
}
}

__device__ __forceinline__ float wave_sum(float v) {
#pragma unroll
    for (int o = 1; o < 64; o <<= 1) v += __shfl_xor(v, o);
    return v;
}
__device__ __forceinline__ void ln_row(const float* in, const float* g, const float* b, float* outf, bf16* outb, int lane) {
    f32x4 v[16]; float s = 0.f;
#pragma unroll
    for (int j = 0; j < 16; ++j) { v[j] = *(const GAS f32x4*)(in + 256 * j + 4 * lane); s += (v[j].x + v[j].y) + (v[j].z + v[j].w); }
    const float mean = wave_sum(s) * (1.0f / DM); float s2 = 0.f;
#pragma unroll
    for (int j = 0; j < 16; ++j) { v[j] = v[j] - mean; s2 += (v[j].x * v[j].x + v[j].y * v[j].y) + (v[j].z * v[j].z + v[j].w * v[j].w); }
    const float rstd = rsqrtf(wave_sum(s2) * (1.0f / DM) + LN_EPS);
#pragma unroll
    for (int j = 0; j < 16; ++j) { const f32x4 gv = *(const GAS f32x4*)(g + 256 * j + 4 * lane), bv = *(const GAS f32x4*)(b + 256 * j + 4 * lane); const f32x4 y = v[j] * rstd * gv + bv;
        *(GAS f32x4*)(outf + 256 * j + 4 * lane) = y;
        if (outb) { v2u o; o.x = pk2(y.x, y.y); o.y = pk2(y.z, y.w); *(GAS v2u*)(outb + 256 * j + 4 * lane) = o; } }
}

struct Args { const float* in[21]; float* out; unsigned char* ws; int ph_lo, ph_hi; };
constexpr size_t WS_CTL = 0, WS_KMEANB = 1 * MiB, WS_KEYSB = 1 * MiB + 512 * 1024;
constexpr size_t WS_WINT = 2 * MiB, WS_MERGED = 2 * MiB, WS_X1B = 66 * MiB, WS_PQ = 130 * MiB;
constexpr size_t WS_XB = 162 * MiB, WS_YA = 162 * MiB, WS_YB = 194 * MiB;
constexpr size_t WS_PROJ = 226 * MiB, WS_G = 226 * MiB;
constexpr size_t WS_OP0 = 546 * MiB, WS_OP1 = 578 * MiB, WS_WOA = 610 * MiB, WS_WOB = 626 * MiB, WS_WOUT = 642 * MiB, WS_WQ = 674 * MiB, WS_UB = 690 * MiB, WS_VT = 818 * MiB, WS_X1F = 946 * MiB;
constexpr size_t WS_EIDX = 1074 * MiB, WS_GATES = 1078 * MiB, WS_NEED = 1082 * MiB;

__global__ void __launch_bounds__(NWAVES * 64, 2) mega_fwd(Args args) {
    extern __shared__ __attribute__((aligned(16))) unsigned char lds_raw[];
    LAS unsigned char* lds = (LAS unsigned char*)lds_raw;
    volatile LAS unsigned* MISC = (volatile LAS unsigned*)(lds + MISC_OFF);
    const int tid = threadIdx.x, lane = tid & 63, wave = __builtin_amdgcn_readfirstlane(tid >> 6);
    const int G = gridDim.x; const int vcu = (G % 8 == 0) ? ((int)blockIdx.x % 8) * (G / 8) + (int)blockIdx.x / 8 : (int)blockIdx.x;
    unsigned char* ws = args.ws;
    gu32* ctl = (gu32*)(ws + WS_CTL);
    for (int u = tid; u < (LDS_BYTES - LDSCTL_OFF) / 4; u += NWAVES * 64) ((LAS unsigned*)(lds + LDSCTL_OFF))[u] = 0u;
    __syncthreads();
    XcdBarrier bar = xcd_barrier_post((unsigned*)(ctl + CW_BAR), MISC + 8);
    const int lo = args.ph_lo, hi = args.ph_hi;
#define IN(k) (lo <= (k) && (k) < hi)
#define BOTH(k) (IN(k) && IN((k) + 1))
    bf16* WINT = (bf16*)(ws + WS_WINT); bf16* XB = (bf16*)(ws + WS_XB); bf16* PROJ = (bf16*)(ws + WS_PROJ);

    bf16* MERGED = (bf16*)(ws + WS_MERGED); bf16* X1B = (bf16*)(ws + WS_X1B); bf16* PQ = (bf16*)(ws + WS_PQ); bf16* GD = (bf16*)(ws + WS_G);
    bf16* WOA = (bf16*)(ws + WS_WOA); bf16* WOB = (bf16*)(ws + WS_WOB); bf16* WOUT = (bf16*)(ws + WS_WOUT); bf16* WQ = (bf16*)(ws + WS_WQ); bf16* UB = (bf16*)(ws + WS_UB); bf16* VT = (bf16*)(ws + WS_VT);
    bf16* KEYSB = (bf16*)(ws + WS_KEYSB); float* X1F = (float*)(ws + WS_X1F);
    if (IN(0)) {
        LAS float* scr = (LAS float*)(lds + wave * 16384);
        const int gw = vcu * NWAVES + wave, NGW = G * NWAVES;
        constexpr int I_IN = (DM / 64) * (INW / 32), I_OA = (2048 / 64) * (DM / 32), I_OUT = (DM / 64) * (DM / 32), I_WQ = (DM / 64) * (2048 / 32), I_V = (16384 / 64) * (DM / 32);
        for (int it = gw; it < I_IN + 2 * I_OA + I_OUT + I_WQ + I_V; it += NGW) { int r = it;
            if (r < I_IN) { p0_transpose_item(args.in[1], DM, INW, WINT, scr, r, lane); continue; } r -= I_IN;
            if (r < I_OA) { p0_transpose_item(args.in[9], 2048, DM, WOA, scr, r, lane); continue; } r -= I_OA;
            if (r < I_OA) { p0_transpose_item(args.in[10], 2048, DM, WOB, scr, r, lane); continue; } r -= I_OA;
            if (r < I_OUT) { p0_transpose_item(args.in[11], DM, DM, WOUT, scr, r, lane); continue; } r -= I_OUT;
            if (r < I_WQ) { p0_transpose_item(args.in[14], DM, 2048, WQ, scr, r, lane); continue; } r -= I_WQ;
            p0_transpose_item(args.in[18], 16384, DM, VT, scr, r, lane); }
        const size_t gtid = (size_t)blockIdx.x * 512 + tid, gth = (size_t)G * 512;
        p0_convert(args.in[0], XB, (size_t)S * DM / 8, gtid, gth);
        p0_convert(args.in[17], UB, (size_t)16384 * DM / 8, gtid, gth);
        p0_convert(args.in[15], KEYSB, 128 * 128 / 8, gtid, gth);
        p0_convert(args.in[16], KEYSB + 128 * 128, 128 * 128 / 8, gtid, gth);
        if (BOTH(0)) xcd_barrier(bar);
    }
    if (IN(1)) {
        pg8::Gemm g{XB, WINT, XB, WINT, S, INW, DM}; pg8::StaticOrder So; So.init(S, INW, G, (int)blockIdx.x);
        pg8::EpiStoreBf16 E{PROJ, INW};
        pg8::gemm_phase<pg8::EpiStoreBf16, pg8::StaticOrder, true, true>(lds, g, So, E);
        if (BOTH(1)) xcd_barrier(bar);
    }

    bf16* KMEANB = (bf16*)(ws + WS_KMEANB); bf16* YA = (bf16*)(ws + WS_YA); bf16* YB = (bf16*)(ws + WS_YB); bf16* OP0 = (bf16*)(ws + WS_OP0); bf16* OP1 = (bf16*)(ws + WS_OP1);
    if (IN(2)) {
        for (int it = vcu * NWAVES + wave; it < 16 * 32; it += G * NWAVES) { const int h = it >> 5, j = it & 31;
            const bf16* kp = PROJ + (size_t)(j * 256) * INW + 2048 + h * 128 + 2 * lane; float s0 = 0.f, s1 = 0.f;
            for (int i = 0; i < 256; ++i) { const unsigned w = *(const unsigned*)(kp + (size_t)i * INW); s0 += bflo(w); s1 += bfhi(w); }
            *(unsigned*)(KMEANB + (size_t)it * 128 + 2 * lane) = pk2(s0 * (1.0f / 256.0f), s1 * (1.0f / 256.0f)); }
        if (BOTH(2)) xcd_barrier(bar);
    }
    if (IN(3)) {
#pragma nounroll
        for (int p = (int)blockIdx.x; p < 768; p += G) {
            const int xcd = p & 7, rank = (p >> 3) & 31, slot = p >> 8, t = rank & 15, gsel = rank >> 4;
#pragma nounroll
            for (int sub = 0; sub < 2; ++sub) {
                att::UnitDesc u; u.qb = sub == 0 ? 31 - t : t; u.ldo = 2048;
                if (slot == 0) { const int h = 2 * xcd + gsel; u.Q = PROJ + h * 128; u.K = PROJ + 2048 + h * 128; u.V = PROJ + 4096 + h * 128; u.O = YA + h * 128; u.bias_head = h; u.kmean = KMEANB + (size_t)h * 32 * 128; }
                else { const int pm = slot - 1, h = xcd; u.Q = PROJ + 6144 + h * 256 + pm * 128; u.K = PROJ + 8192 + h * 256 + pm * 128; u.V = PROJ + 10240 + h * 256 + gsel * 128;
                       u.O = (pm ? OP1 : OP0) + h * 256 + gsel * 128; u.bias_head = 16 + h; u.kmean = nullptr; }
                att::attn_unit(u, args.in[3], (LAS char*)lds);
            }
        }
        if (BOTH(3)) xcd_barrier(bar);
    }
    if (IN(4)) {
        float a = args.in[4][lane] * args.in[5][lane] + args.in[4][lane + 64] * args.in[5][lane + 64], b = args.in[6][lane] * args.in[7][lane] + args.in[6][lane + 64] * args.in[7][lane + 64];
#pragma unroll
        for (int o = 1; o < 64; o <<= 1) { a += __shfl_xor(a, o); b += __shfl_xor(b, o); }
        const float lam = expf(a) - expf(b) + LAMBDA_INIT;
        const f32x4 gsub = *(const GAS f32x4*)(args.in[8] + 4 * lane);
        for (int it = vcu * NWAVES + wave; it < S * 8; it += G * NWAVES) { const size_t off = (size_t)(it >> 3) * 2048 + (it & 7) * 256 + 4 * lane;
            const v2u w0 = *(const GAS v2u*)(OP0 + off), w1 = *(const GAS v2u*)(OP1 + off);
            const float y0 = bflo(w0.x) - lam * bflo(w1.x), y1 = bfhi(w0.x) - lam * bfhi(w1.x), y2 = bflo(w0.y) - lam * bflo(w1.y), y3 = bfhi(w0.y) - lam * bfhi(w1.y);
            float ss = (y0 * y0 + y1 * y1) + (y2 * y2 + y3 * y3);
#pragma unroll
            for (int o = 1; o < 64; o <<= 1) ss += __shfl_xor(ss, o);
            const float rs = rsqrtf(ss * (1.0f / 256.0f) + LN_EPS) * (1.0f - LAMBDA_INIT);
            v2u o2; o2.x = pk2(y0 * rs * gsub.x, y1 * rs * gsub.y); o2.y = pk2(y2 * rs * gsub.z, y3 * rs * gsub.w); *(GAS v2u*)(YB + off) = o2; }
        if (BOTH(4)) xcd_barrier(bar);
    }

    if (IN(5)) {
        pg8::Gemm g{YA, WOA, YB, WOB, S, DM, 2048}; pg8::DualOrder So; So.init(S, DM, G, (int)blockIdx.x);
        pg8::EpiMerge E{MERGED, PROJ, args.in[2]};
        pg8::gemm_phase<pg8::EpiMerge, pg8::DualOrder, true, true>(lds, g, So, E);
        if (BOTH(5)) xcd_barrier(bar);
    }
    if (IN(6)) {
        pg8::Gemm g{MERGED, WOUT, MERGED, WOUT, S, DM, DM}; pg8::StaticOrder So; So.init(S, DM, G, (int)blockIdx.x);
        pg8::EpiResF32 E{args.out, args.in[0], ALPHA};
        pg8::gemm_phase<pg8::EpiResF32, pg8::StaticOrder, true, true>(lds, g, So, E);
        if (BOTH(6)) xcd_barrier(bar);
    }
    if (IN(7)) {
        for (int m = vcu * NWAVES + wave; m < S; m += G * NWAVES) ln_row(args.out + (size_t)m * DM, args.in[12], args.in[13], X1F + (size_t)m * DM, X1B + (size_t)m * DM, lane);
        { GAS v4u* gz = (GAS v4u*)GD; const v4u z = {0u, 0u, 0u, 0u}; for (size_t i = (size_t)blockIdx.x * 512 + tid; i < (size_t)S * 16384 / 8; i += (size_t)G * 512) gz[i] = z; }
        if (BOTH(7)) xcd_barrier(bar);
    }
    if (IN(8)) {
        pg8::Gemm g{X1B, WQ, X1B, WQ, S, 2048, DM}; pg8::StaticOrder So; So.init(S, 2048, G, (int)blockIdx.x);
        pg8::EpiStoreBf16 E{PQ, 2048};
        pg8::gemm_phase<pg8::EpiStoreBf16, pg8::StaticOrder, true, true>(lds, g, So, E);
        if (BOTH(8)) xcd_barrier(bar);
    }
    if (IN(9)) {
#pragma nounroll
        for (int b = (int)blockIdx.x; b < S / 32; b += G) rt::route_block(b * 32, PQ, KEYSB, GD, (int*)(ws + WS_EIDX), (float*)(ws + WS_GATES), (LAS char*)lds);
        if (BOTH(9)) xcd_barrier(bar);
    }
    if (IN(10)) {
        pg8::Gemm g{X1B, UB, X1B, UB, S, 16384, DM}; pg8::StaticOrder So; So.init(S, 16384, G, (int)blockIdx.x);
        pg8::EpiPeerAct E{GD};
        pg8::gemm_phase<pg8::EpiPeerAct, pg8::StaticOrder, true, true>(lds, g, So, E);
        if (BOTH(10)) xcd_barrier(bar);
    }
    if (IN(11)) {
        pg8::Gemm g{GD, VT, GD, VT, S, DM, 16384}; pg8::StaticOrder So; So.init(S, DM, G, (int)blockIdx.x);
        pg8::EpiResF32 E{args.out, X1F, ALPHA};
        pg8::gemm_phase<pg8::EpiResF32, pg8::StaticOrder, true, true>(lds, g, So, E);
        if (BOTH(11)) xcd_barrier(bar);
    }
    if (IN(12)) {
        for (int m = vcu * NWAVES + wave; m < S; m += G * NWAVES) ln_row(args.out + (size_t)m * DM, args.in[19], args.in[20], args.out + (size_t)m * DM, nullptr, lane);
    }
#undef IN
#undef BOTH
}

__global__ void shim_proj(const bf16* __restrict__ PROJ, float* __restrict__ ws) {
    const size_t U64 = (size_t)S * 2048;
    const size_t i = (size_t)blockIdx.x * blockDim.x + threadIdx.x; const int row = (int)(i / INW), col = (int)(i % INW);
    const float v = bf2f(PROJ[i]);
    if (col < 12288) { const int t = col >> 11, c = col & 2047; ws[(size_t)t * U64 + (size_t)row * 2048 + c] = v; }
    else { const int t = (col - 12288) >> 12, c = (col - 12288) & 4095; ws[(size_t)(6 + 2 * t) * U64 + (size_t)row * 4096 + c] = v; }
}

__global__ void shim_bf16_f32(const bf16* __restrict__ src, float* __restrict__ dst) { const size_t i = (size_t)blockIdx.x * blockDim.x + threadIdx.x; dst[i] = bf2f(src[i]); }
}

extern "C" void kernel_launch(void* const* d_in, const int* in_sizes, int n_in, void* d_out, int out_size, void* d_ws, size_t ws_size, hipStream_t stream) {
    if (ws_size < WS_NEED) return;
    static int grid = 0;
    if (grid == 0) {
        int dev = 0, cus = 0;
        if (hipGetDevice(&dev) != hipSuccess || hipDeviceGetAttribute(&cus, hipDeviceAttributeMultiprocessorCount, dev) != hipSuccess) { grid = -1; return; }
        if (hipFuncSetAttribute((const void*)mega_fwd, hipFuncAttributeMaxDynamicSharedMemorySize, LDS_BYTES) != hipSuccess) { grid = -1; return; }
        grid = cus;
    }
    if (grid < 0) return;
    (void)hipMemsetAsync((char*)d_ws + WS_CTL, 0, CTL_ZERO_BYTES, stream);
    Args a{};
    for (int i = 0; i < 21; ++i) a.in[i] = (const float*)d_in[i];
    a.out = (float*)d_out; a.ws = (unsigned char*)d_ws;
    const int cuts[] = {0, 13};
    for (int li = 0; li + 1 < (int)(sizeof(cuts) / sizeof(int)); ++li) { a.ph_lo = cuts[li]; a.ph_hi = cuts[li + 1];
        hipLaunchKernelGGL(mega_fwd, dim3(grid), dim3(NWAVES * 64), LDS_BYTES, stream, a); }
}
```

```cpp
#include <hip/hip_runtime.h>
#include <math.h>
#include <cstdio>
#include <cstdint>

namespace {
constexpr int S = 8192, DM = 4096, INW = 20480;
constexpr float SCALE = 0.08838834764831845f;
constexpr float ALPHA = 1.189207115002721f;
constexpr float LN_EPS = 1e-5f;
constexpr float LAMBDA_INIT = 0.2f;
typedef float f32x16 __attribute__((ext_vector_type(16)));

__device__ __forceinline__ int t5_bucket(int n) {
    if (n < 16) return n;
    int b = 16;
    b += (n >= 19); b += (n >= 21); b += (n >= 24); b += (n >= 27); b += (n >= 31); b += (n >= 35); b += (n >= 40); b += (n >= 46);
    b += (n >= 52); b += (n >= 59); b += (n >= 67); b += (n >= 77); b += (n >= 87); b += (n >= 99); b += (n >= 113);
    return b;
}

__global__ void __launch_bounds__(256) gemm_f32(const float* __restrict__ A, int lda, const float* __restrict__ B, int ldb, float* __restrict__ C, int ldc, int K,
                                                const float* __restrict__ R, int ldr, float alpha) {
    __shared__ float As[16][132];
    __shared__ float Bs[16][132];
    const int tid = threadIdx.x, lane = tid & 63, wid = tid >> 6, wm = wid >> 1, wn = wid & 1;
    const int m0 = blockIdx.y * 128, n0 = blockIdx.x * 128;
    f32x16 acc[2][2];
    for (int i = 0; i < 2; ++i) for (int j = 0; j < 2; ++j) for (int r = 0; r < 16; ++r) acc[i][j][r] = 0.f;
    for (int k0 = 0; k0 < K; k0 += 16) {
        for (int i = 0; i < 2; ++i) {
            const int idx = tid + i * 256;
            const int r = idx >> 2, c4 = idx & 3;
            const float4 v = *(const float4*)(A + (size_t)(m0 + r) * lda + k0 + c4 * 4);
            As[c4 * 4 + 0][r] = v.x; As[c4 * 4 + 1][r] = v.y; As[c4 * 4 + 2][r] = v.z; As[c4 * 4 + 3][r] = v.w;
            const int kr = idx >> 5, cb = idx & 31;
            const float4 w = *(const float4*)(B + (size_t)(k0 + kr) * ldb + n0 + cb * 4);
            *(float4*)&Bs[kr][cb * 4] = w;
        }
        __syncthreads();
        for (int kk = 0; kk < 16; kk += 2) {
            float a[2], b[2];
            for (int i = 0; i < 2; ++i) a[i] = As[kk + (lane >> 5)][wm * 64 + i * 32 + (lane & 31)];
            for (int j = 0; j < 2; ++j) b[j] = Bs[kk + (lane >> 5)][wn * 64 + j * 32 + (lane & 31)];
            for (int i = 0; i < 2; ++i) for (int j = 0; j < 2; ++j) acc[i][j] = __builtin_amdgcn_mfma_f32_32x32x2f32(a[i], b[j], acc[i][j], 0, 0, 0);
        }
        __syncthreads();
    }
    for (int i = 0; i < 2; ++i) for (int j = 0; j < 2; ++j) for (int r = 0; r < 16; ++r) {
        const int row = m0 + wm * 64 + i * 32 + (r & 3) + 8 * (r >> 2) + 4 * (lane >> 5);
        const int col = n0 + wn * 64 + j * 32 + (lane & 31);
        float v = acc[i][j][r];
        if (R) v += alpha * R[(size_t)row * ldr + col];
        C[(size_t)row * ldc + col] = v;
    }
}

__global__ void transpose_f32(const float* __restrict__ in, int ld_in, float* __restrict__ out, int ld_out) {
    __shared__ float tile[32][33];
    const int tx = threadIdx.x & 31, ty = threadIdx.x >> 5;
    const int r0 = blockIdx.y * 32, c0 = blockIdx.x * 32;
    for (int i = ty; i < 32; i += 8) tile[i][tx] = in[(size_t)(r0 + i) * ld_in + c0 + tx];
    __syncthreads();
    for (int i = ty; i < 32; i += 8) out[(size_t)(c0 + i) * ld_out + r0 + tx] = tile[tx][i];
}

__global__ void kmean_kernel(const float* __restrict__ mk, float* __restrict__ kmean) {
    const int j = blockIdx.x, h = blockIdx.y, d = threadIdx.x;
    float s = 0.f;
    for (int i = 0; i < 256; ++i) s += mk[(size_t)(j * 256 + i) * 2048 + h * 128 + d];
    kmean[(h * 32 + j) * 128 + d] = s * (1.0f / 256.0f);
}

__device__ __forceinline__ float block_reduce(float v, float* red, bool is_max) {
    const int t = threadIdx.x;
    for (int o = 32; o >= 1; o >>= 1) { const float w = __shfl_xor(v, o); v = is_max ? fmaxf(v, w) : v + w; }
    __syncthreads();
    if ((t & 63) == 0) red[t >> 6] = v;
    __syncthreads();
    float r = red[0];
    for (int i = 1; i < (int)(blockDim.x >> 6); ++i) r = is_max ? fmaxf(r, red[i]) : r + red[i];
    __syncthreads();
    return r;
}

__global__ void __launch_bounds__(256) moba_naive(const float* __restrict__ mq, const float* __restrict__ mkT, const float* __restrict__ mv, const float* __restrict__ kmean,
                                                  const float* __restrict__ rel_bias, float* __restrict__ ya) {
    const int q = blockIdx.x, h = blockIdx.y, t = threadIdx.x;
    __shared__ float qs[128]; __shared__ float gate[32]; __shared__ int blk[4]; __shared__ int okf[4]; __shared__ float sc[1024]; __shared__ float red[8]; __shared__ float biasl[32];
    __shared__ float part[256];
    if (t < 128) qs[t] = mq[(size_t)q * 2048 + h * 128 + t];
    if (t < 32) biasl[t] = rel_bias[t * 24 + h];
    __syncthreads();
    const int qb = q >> 8;
    if (t < 32) { float g = -1e30f; if (t < qb) { g = 0.f; const float* km = kmean + (h * 32 + t) * 128; for (int d = 0; d < 128; ++d) g += qs[d] * km[d]; } gate[t] = g; }
    __syncthreads();
    if (t == 0) {
        unsigned used = 0;
        for (int r = 0; r < 3; ++r) { int best = -1; for (int j = 0; j < 32; ++j) if (!((used >> j) & 1u) && (best < 0 || gate[j] > gate[best])) best = j;
            used |= 1u << best; blk[r] = best; okf[r] = best < qb ? 1 : 0; }
        blk[3] = qb; okf[3] = 1;
    }
    __syncthreads();
    float lmax = -1e30f;
    for (int r = 0; r < 4; ++r) {
        const int kpos = blk[r] * 256 + t, dist = q - kpos; float s = -1e30f;
        if (okf[r] && dist >= 0) { float dot = 0.f; const float* kp = mkT + (size_t)(h * 128) * S + kpos; for (int d = 0; d < 128; ++d) dot += qs[d] * kp[(size_t)d * S];
            s = dot * SCALE + biasl[t5_bucket(dist)]; }
        sc[r * 256 + t] = s; lmax = fmaxf(lmax, s);
    }
    const float mx = block_reduce(lmax, red, true);
    float lsum = 0.f;
    for (int r = 0; r < 4; ++r) { const float e = expf(sc[r * 256 + t] - mx); sc[r * 256 + t] = e; lsum += e; }
    const float sum = block_reduce(lsum, red, false);
    const int d = t & 127, half = t >> 7; float a = 0.f;
    for (int i = half * 512; i < half * 512 + 512; ++i) { const float p = sc[i]; if (p != 0.f) { const int kpos = blk[i >> 8] * 256 + (i & 255); a += p * mv[(size_t)kpos * 2048 + h * 128 + d]; } }
    part[t] = a; __syncthreads();
    if (t < 128) ya[(size_t)q * 2048 + h * 128 + t] = (part[t] + part[t + 128]) / sum;
}

__global__ void __launch_bounds__(256) diff_naive(const float* __restrict__ dq, const float* __restrict__ dkT, const float* __restrict__ dv, const float* __restrict__ rel_bias,
                                                  const float* __restrict__ lq1, const float* __restrict__ lk1, const float* __restrict__ lq2, const float* __restrict__ lk2,
                                                  const float* __restrict__ subln_g, float* __restrict__ yb) {
    __shared__ float sc[S];
    __shared__ float qs[256]; __shared__ float red[8]; __shared__ float biasl[32]; __shared__ float lamsh;
    const int q = blockIdx.x, h = blockIdx.y, t = threadIdx.x;
    qs[t] = dq[(size_t)q * 2048 + h * 256 + t];
    if (t < 32) biasl[t] = rel_bias[t * 24 + 16 + h];
    if (t == 0) { float a = 0.f, b = 0.f; for (int d = 0; d < 128; ++d) { a += lq1[d] * lk1[d]; b += lq2[d] * lk2[d]; } lamsh = expf(a) - expf(b) + LAMBDA_INIT; }
    __syncthreads();
    const float lam = lamsh; const int nk = q + 1;
    float acc = 0.f;
    for (int mp = 0; mp < 2; ++mp) {
        float lmax = -1e30f;
        for (int kpos = t; kpos < nk; kpos += 256) { float dot = 0.f; const float* kp = dkT + (size_t)(h * 256 + mp * 128) * S + kpos;
            for (int d = 0; d < 128; ++d) dot += qs[mp * 128 + d] * kp[(size_t)d * S];
            const float s = dot * SCALE + biasl[t5_bucket(q - kpos)]; sc[kpos] = s; lmax = fmaxf(lmax, s); }
        const float mx = block_reduce(lmax, red, true);
        float lsum = 0.f;
        for (int kpos = t; kpos < nk; kpos += 256) { const float e = expf(sc[kpos] - mx); sc[kpos] = e; lsum += e; }
        const float inv = 1.0f / block_reduce(lsum, red, false);
        float a = 0.f;
        for (int i = 0; i < nk; ++i) a += sc[i] * dv[(size_t)i * 2048 + h * 256 + t];
        acc += (mp == 0 ? inv : -lam * inv) * a;
        __syncthreads();
    }
    const float ss = block_reduce(acc * acc, red, false);
    yb[(size_t)q * 2048 + h * 256 + t] = acc * rsqrtf(ss * (1.0f / 256.0f) + LN_EPS) * subln_g[t] * (1.0f - LAMBDA_INIT);
}

__global__ void merge_kernel(const float* __restrict__ ga, const float* __restrict__ gb, const float* __restrict__ gate_b, const float* __restrict__ ta, const float* __restrict__ tb, float* __restrict__ merged) {
    const size_t i = (size_t)blockIdx.x * blockDim.x + threadIdx.x; const int c = (int)(i & (DM - 1));
    const float a = 1.0f / (1.0f + expf(-(ga[i] + gate_b[c]))), b = 1.0f / (1.0f + expf(-(gb[i] + gate_b[DM + c])));
    merged[i] = a * ta[i] + b * tb[i];
}

__global__ void __launch_bounds__(256) ln_kernel(const float* __restrict__ in, const float* __restrict__ g, const float* __restrict__ b, float* __restrict__ out) {
    __shared__ float red[8];
    const int row = blockIdx.x, t = threadIdx.x; float v[16]; float s = 0.f;
    for (int i = 0; i < 16; ++i) { v[i] = in[(size_t)row * DM + i * 256 + t]; s += v[i]; }
    const float mu = block_reduce(s, red, false) * (1.0f / DM); float q = 0.f;
    for (int i = 0; i < 16; ++i) { v[i] -= mu; q += v[i] * v[i]; }
    const float rstd = rsqrtf(block_reduce(q, red, false) * (1.0f / DM) + LN_EPS);
    for (int i = 0; i < 16; ++i) out[(size_t)row * DM + i * 256 + t] = v[i] * rstd * g[i * 256 + t] + b[i * 256 + t];
}

__global__ void __launch_bounds__(256) peer_route_naive(const float* __restrict__ pq, const float* __restrict__ keys1, const float* __restrict__ keys2, int* __restrict__ eidx, float* __restrict__ gates) {
    __shared__ float qh[256]; __shared__ float sc[2][128]; __shared__ float tv[2][16]; __shared__ int ti[2][16];
    const int tok = blockIdx.x, t = threadIdx.x;
    for (int h = 0; h < 8; ++h) {
        qh[t] = pq[(size_t)tok * 2048 + h * 256 + t];
        __syncthreads();
        { const int side = t >> 7, k = t & 127; const float* kr = (side ? keys2 : keys1) + k * 128; float d = 0.f; for (int i = 0; i < 128; ++i) d += qh[side * 128 + i] * kr[i]; sc[side][k] = d; }
        __syncthreads();
        if (t == 0 || t == 128) { const int side = t >> 7; unsigned used[4] = {0, 0, 0, 0};
            for (int r = 0; r < 16; ++r) { int best = -1; for (int j = 0; j < 128; ++j) if (!((used[j >> 5] >> (j & 31)) & 1u) && (best < 0 || sc[side][j] > sc[side][best])) best = j;
                used[best >> 5] |= 1u << (best & 31); tv[side][r] = sc[side][best]; ti[side][r] = best; } }
        __syncthreads();
        if (t == 0) { unsigned used[8] = {0, 0, 0, 0, 0, 0, 0, 0}; float ts[16]; int tp[16];
            for (int r = 0; r < 16; ++r) { int best = -1; float bv = 0.f; for (int j = 0; j < 256; ++j) { if ((used[j >> 5] >> (j & 31)) & 1u) continue; const float c = tv[0][j >> 4] + tv[1][j & 15]; if (best < 0 || c > bv) { best = j; bv = c; } }
                used[best >> 5] |= 1u << (best & 31); ts[r] = bv; tp[r] = best; }
            float sum = 0.f; const float tmax = ts[0]; for (int r = 0; r < 16; ++r) { ts[r] = expf(ts[r] - tmax); sum += ts[r]; }
            for (int r = 0; r < 16; ++r) { eidx[(size_t)tok * 128 + h * 16 + r] = ti[0][tp[r] >> 4] * 128 + ti[1][tp[r] & 15]; gates[(size_t)tok * 128 + h * 16 + r] = ts[r] / sum; } }
        __syncthreads();
    }
}

__global__ void __launch_bounds__(256) peer_expert_naive(const float* __restrict__ x1, const int* __restrict__ eidx, const float* __restrict__ gates, const float* __restrict__ U, const float* __restrict__ V,
                                                         const float* __restrict__ g2, const float* __restrict__ b2, float* __restrict__ out) {
    __shared__ float xs[DM]; __shared__ float wts[128]; __shared__ int es[128]; __shared__ float red[8];
    const int tok = blockIdx.x, t = threadIdx.x, lane = t & 63, wid = t >> 6;
    for (int i = t; i < DM; i += 256) xs[i] = x1[(size_t)tok * DM + i];
    if (t < 128) es[t] = eidx[(size_t)tok * 128 + t];
    __syncthreads();
    for (int e = wid; e < 128; e += 4) { const float* u = U + (size_t)es[e] * DM; float d = 0.f;
        for (int j = 0; j < 16; ++j) { const float4 w = *(const float4*)(u + j * 256 + lane * 4); const float* xp = xs + j * 256 + lane * 4; d += w.x * xp[0] + w.y * xp[1] + w.z * xp[2] + w.w * xp[3]; }
        for (int o = 32; o >= 1; o >>= 1) d += __shfl_xor(d, o);
        if (lane == 0) wts[e] = gates[(size_t)tok * 128 + e] * 0.5f * d * (1.0f + erff(d * 0.7071067811865476f)); }
    __syncthreads();
    float acc[16];
    for (int i = 0; i < 16; ++i) acc[i] = 0.f;
    for (int e = 0; e < 128; ++e) { const float w = wts[e]; const float* v = V + (size_t)es[e] * DM; for (int i = 0; i < 16; ++i) acc[i] += w * v[i * 256 + t]; }
    float s = 0.f;
    for (int i = 0; i < 16; ++i) { acc[i] += ALPHA * xs[i * 256 + t]; s += acc[i]; }
    const float mu = block_reduce(s, red, false) * (1.0f / DM); float qq = 0.f;
    for (int i = 0; i < 16; ++i) { acc[i] -= mu; qq += acc[i] * acc[i]; }
    const float rstd = rsqrtf(block_reduce(qq, red, false) * (1.0f / DM) + LN_EPS);
    for (int i = 0; i < 16; ++i) out[(size_t)tok * DM + i * 256 + t] = acc[i] * rstd * g2[i * 256 + t] + b2[i * 256 + t];
}

void gemm(hipStream_t st, const float* A, int lda, const float* B, int ldb, float* C, int ldc, int M, int N, int K, const float* R = nullptr, int ldr = 0, float alpha = 0.f) {
    hipLaunchKernelGGL(gemm_f32, dim3(N / 128, M / 128), dim3(256), 0, st, A, lda, B, ldb, C, ldc, K, R, ldr, alpha);
}
#define GAS __attribute__((address_space(1)))
#define LAS __attribute__((address_space(3)))
typedef unsigned short bf16;
typedef unsigned v4u __attribute__((ext_vector_type(4)));
typedef unsigned v2u __attribute__((ext_vector_type(2)));
typedef float f32x4 __attribute__((ext_vector_type(4)));
typedef short bf16x8 __attribute__((ext_vector_type(8)));
typedef GAS unsigned gu32;
#define RLX_AGENT __ATOMIC_RELAXED, __HIP_MEMORY_SCOPE_AGENT
#define LDS_WAIT() asm volatile("s_waitcnt lgkmcnt(0)" ::: "memory")
#define VM_WAIT() asm volatile("s_waitcnt vmcnt(0)" ::: "memory")
__device__ __forceinline__ int lane_id() { int r; asm volatile("v_mbcnt_lo_u32_b32 %0, -1, 0\n\tv_mbcnt_hi_u32_b32 %0, -1, %0" : "=v"(r)); return r; }
__device__ __forceinline__ unsigned f2bf(float f) { unsigned u = __builtin_bit_cast(unsigned, f); return (u + 0x7fffu + ((u >> 16) & 1u)) >> 16; }
__device__ __forceinline__ unsigned pk2(float lo, float hi) { return f2bf(lo) | (f2bf(hi) << 16); }
__device__ __forceinline__ float bf2f(unsigned short b) { return __builtin_bit_cast(float, (unsigned)b << 16); }
__device__ __forceinline__ float bflo(unsigned w) { return __builtin_bit_cast(float, w << 16); }
__device__ __forceinline__ float bfhi(unsigned w) { return __builtin_bit_cast(float, w & 0xffff0000u); }

namespace pg8 {
#define PG8_LAS __attribute__((address_space(3)))
typedef unsigned short bf16_t;
typedef short bf16x8 __attribute__((ext_vector_type(8)));
typedef float f32x4 __attribute__((ext_vector_type(4)));
typedef unsigned u32x4 __attribute__((ext_vector_type(4)));
constexpr int BM = 256, BK = 64, HALF = 128, HTB = HALF * BK * 2  , STAGE_BYTES = 8 * HTB, NXCD = 8, WGM = 8;

__host__ __device__ __forceinline__ int lds_byte(int r, int c) { const int st = (r >> 4) * 2 + (c >> 5), rr = r & 15, cc = c & 31, ob = rr * 64 + cc * 2; return st * 1024 + (ob ^ (((ob >> 9) & 1) << 5)); }
__host__ __device__ __forceinline__ void stage_rc(int b, int& R, int& C) { const int st = b / 1024, sb = b % 1024, swz = sb ^ (((sb >> 9) & 1) << 5); R = (st >> 1) * 16 + swz / 64; C = (st & 1) * 32 + (swz % 64) / 2; }
__host__ __device__ __forceinline__ int perm32(int rho) { const int n = rho >> 4, i = rho & 15; return 8 * (i >> 2) + 4 * n + (i & 3); }

struct Unit { int pm, pn, part; };
struct Gemm { const bf16_t* A; const bf16_t* Bt; const bf16_t* A2; const bf16_t* Bt2; int M, N, K; int sc; };

struct StaticOrder {
    int nM, nN, nwg, G, c;
    __host__ __device__ void init(int M, int N, int G_, int c_) { nM = M / BM; nN = N / BM; nwg = nM * nN; G = G_; c = c_; }
    __host__ __device__ bool next(int i, Unit& u) const {
        const long L = (long)i * G + c; if (L >= nwg) return false;
        int wgid = (int)L; { const int q = nwg / NXCD, r = nwg % NXCD, xcd = wgid % NXCD, off = wgid / NXCD; wgid = (xcd < r ? xcd * (q + 1) : r * (q + 1) + (xcd - r) * q) + off; }
        const int nig = WGM * nN, gid = wgid / nig, fm = gid * WGM, gsz = (nM - fm) < WGM ? (nM - fm) : WGM;
        u.pm = fm + ((wgid % nig) % gsz); u.pn = (wgid % nig) / gsz; u.part = 0; return true;
    }
    __device__ __forceinline__ void a_ready(const Unit&) const {}
    __device__ __forceinline__ void done(const Unit&) const {}
};


typedef int v4i_t __attribute__((ext_vector_type(4))); typedef int v8i_t __attribute__((ext_vector_type(8)));
__device__ __forceinline__ v8i_t cat8(bf16x8 a, bf16x8 b) { return __builtin_shufflevector(__builtin_bit_cast(v4i_t, a), __builtin_bit_cast(v4i_t, b), 0, 1, 2, 3, 4, 5, 6, 7); }
template <class Epi, class Sched, bool ALIGN_EPI = false, bool SP2 = false, bool F8 = false>
__device__ __forceinline__ void gemm_phase(PG8_LAS unsigned char* lds, const Gemm g, const Sched& S, const Epi& E, const int wave_id) {
    int lane_; asm volatile("v_mbcnt_lo_u32_b32 %0, -1, 0\n\tv_mbcnt_hi_u32_b32 %0, -1, %0" : "=v"(lane_));
    const int lane = lane_, wid = wave_id, tid = wid * 64 + lane, wr = wid >> 2, wc = wid & 3, fr = lane & 15, fq = lane >> 4;
    const int K = g.K, nt = K / BK;
    unsigned voffA[2], voffB[2];
#pragma unroll
    for (int i = 0; i < 2; ++i) { int R, C; stage_rc(tid * 16 + i * 8192, R, C); const int Rb = Epi::PERM ? ((R & ~31) + perm32(R & 31)) : R;
        voffA[i] = (unsigned)(R * K + C) * 2u; voffB[i] = (unsigned)(Rb * K + C) * 2u; }
    const size_t kstep = (size_t)(BK * 2);
    const size_t rstep64 = (size_t)64 * K * 2;
    const size_t hstep = (size_t)HALF * K * 2;
    const size_t tstep = 2 * hstep;
    const unsigned ldsw = (unsigned)wid * 1024u;
    const int aoff = lds_byte(wr * 64 + fr, fq * 8), boff = lds_byte(wc * 32 + fr, fq * 8);
#define PG8_SA(b, h) (((b) * 2 + (h)) * HTB)
#define PG8_SB(b, h) ((4 + (b) * 2 + (h)) * HTB)
#define PG8_STAGE(bufoff, gbase, voff) do { _Pragma("unroll") for (int _i = 0; _i < 2; ++_i) \
        __builtin_amdgcn_global_load_lds((const unsigned*)((const char*)(gbase) + (size_t)_i * rstep64 + (voff)[0]), (PG8_LAS unsigned*)(lds + (bufoff) + ldsw + _i * 8192), 16, 0, 0); } while (0)
#define PG8_LDA(dst, b, h) do { _Pragma("unroll") for (int m = 0; m < 4; ++m) _Pragma("unroll") for (int k = 0; k < 2; ++k) dst[m][k] = *(const PG8_LAS bf16x8*)(lds + PG8_SA(b, h) + aoff + m * 2048 + k * 1024); } while (0)
#define PG8_LDB(dst, b, h) do { _Pragma("unroll") for (int n = 0; n < 2; ++n) _Pragma("unroll") for (int k = 0; k < 2; ++k) dst[n][k] = *(const PG8_LAS bf16x8*)(lds + PG8_SB(b, h) + boff + n * 2048 + k * 1024); } while (0)
#define PG8_MMA(ai, bj, At, Bt) do { __builtin_amdgcn_s_setprio(1); if constexpr (F8) { _Pragma("unroll") for (int m = 0; m < 4; ++m) _Pragma("unroll") for (int n = 0; n < 2; ++n) \
        acc[ai][bj][m][n] = __builtin_amdgcn_mfma_scale_f32_16x16x128_f8f6f4(cat8(Bt[n][0], Bt[n][1]), cat8(At[m][0], At[m][1]), acc[ai][bj][m][n], 0, 0, 0, g.sc, 0, 0x7f7f7f7f); } else { \
        _Pragma("unroll") for (int m = 0; m < 4; ++m) _Pragma("unroll") for (int n = 0; n < 2; ++n) _Pragma("unroll") for (int k = 0; k < 2; ++k) \
        acc[ai][bj][m][n] = __builtin_amdgcn_mfma_f32_16x16x32_bf16(Bt[n][k], At[m][k], acc[ai][bj][m][n], 0, 0, 0); } __builtin_amdgcn_s_setprio(0); } while (0)
#define PG8_WAIT_V(n) asm volatile("s_waitcnt vmcnt(" #n ")" ::: "memory")
#define PG8_WAIT_L(n) asm volatile("s_waitcnt lgkmcnt(" #n ")" ::: "memory")
#define PG8_BAR __builtin_amdgcn_s_barrier()
#define PG8_SCHED __builtin_amdgcn_sched_barrier(0)
    Unit cur, nxt; int ui = 0;
    if (!S.next(0, cur)) return;
    f32x4 acc[2][2][4][2];
#pragma unroll
    for (int a = 0; a < 2; ++a)
#pragma unroll
        for (int b = 0; b < 2; ++b)
#pragma unroll
            for (int m = 0; m < 4; ++m)
#pragma unroll
                for (int n = 0; n < 2; ++n) acc[a][b][m][n] = (f32x4){0.f, 0.f, 0.f, 0.f};
    bf16x8 At[4][2], B0[2][2], B1[2][2];
    const char* cA = (const char*)(cur.part ? g.A2 : g.A) + (size_t)cur.pm * tstep; const char* cB = (const char*)(cur.part ? g.Bt2 : g.Bt) + (size_t)cur.pn * tstep;
    S.a_ready(cur);
    if constexpr (SP2) {
        PG8_STAGE(PG8_SB(0, 0), cB, voffB); PG8_STAGE(PG8_SB(0, 1), cB + hstep, voffB); PG8_STAGE(PG8_SA(0, 0), cA, voffA); PG8_STAGE(PG8_SA(0, 1), cA + hstep, voffA);
        if (wr == 1) PG8_BAR;
        PG8_WAIT_V(2); PG8_BAR;
        PG8_STAGE(PG8_SB(1, 0), cB + kstep, voffB); PG8_STAGE(PG8_SA(1, 0), cA + kstep, voffA); PG8_STAGE(PG8_SB(1, 1), cB + hstep + kstep, voffB);
        PG8_WAIT_V(6); PG8_BAR;
    } else {
        PG8_STAGE(PG8_SB(0, 0), cB, voffB); PG8_STAGE(PG8_SA(0, 0), cA, voffA); PG8_STAGE(PG8_SB(0, 1), cB + hstep, voffB); PG8_STAGE(PG8_SA(0, 1), cA + hstep, voffA);
        if (wr == 1) PG8_BAR;
        PG8_WAIT_V(4); PG8_BAR;
        PG8_STAGE(PG8_SB(1, 0), cB + kstep, voffB); PG8_STAGE(PG8_SA(1, 0), cA + kstep, voffA); PG8_STAGE(PG8_SB(1, 1), cB + hstep + kstep, voffB);
        PG8_WAIT_V(6); PG8_BAR;
    }
    for (;;) {
        const bool has_next = S.next(ui + 1, nxt);
        const char* nA = has_next ? (const char*)(nxt.part ? g.A2 : g.A) + (size_t)nxt.pm * tstep : cA; const char* nB = has_next ? (const char*)(nxt.part ? g.Bt2 : g.Bt) + (size_t)nxt.pn * tstep : cB;
        for (int t = 0; t < nt; t += 2) {
            const bool last = (t == nt - 2);
            const char* a1 = cA + (size_t)(t + 1) * kstep;
            const char* a2 = last ? nA : cA + (size_t)(t + 2) * kstep; const char* b2 = last ? nB : cB + (size_t)(t + 2) * kstep;
            const char* a3 = a2 + kstep; const char* b3 = b2 + kstep;
            if (last && has_next) S.a_ready(nxt);
            if constexpr (SP2) {
            PG8_LDB(B0, 0, 0); PG8_LDB(B1, 0, 1); PG8_SCHED; PG8_LDA(At, 0, 0); PG8_STAGE(PG8_SA(1, 1), a1 + hstep, voffA);
            PG8_WAIT_V(8); PG8_WAIT_L(0); PG8_BAR; PG8_MMA(0, 0, At, B0); PG8_MMA(0, 1, At, B1); PG8_BAR; PG8_SCHED;
            PG8_LDA(At, 0, 1); PG8_STAGE(PG8_SB(0, 0), b2, voffB); PG8_STAGE(PG8_SB(0, 1), b2 + hstep, voffB); PG8_STAGE(PG8_SA(0, 0), a2, voffA);
            PG8_WAIT_V(8); PG8_WAIT_L(0); PG8_BAR; PG8_MMA(1, 0, At, B0); PG8_MMA(1, 1, At, B1); PG8_BAR; PG8_SCHED;
            PG8_LDB(B0, 1, 0); PG8_LDB(B1, 1, 1); PG8_SCHED; PG8_LDA(At, 1, 0); PG8_STAGE(PG8_SA(0, 1), a2 + hstep, voffA);
            PG8_WAIT_V(8); PG8_WAIT_L(0); PG8_BAR; PG8_MMA(0, 0, At, B0); PG8_MMA(0, 1, At, B1); PG8_BAR; PG8_SCHED;
            PG8_LDA(At, 1, 1); PG8_STAGE(PG8_SB(1, 0), b3, voffB); PG8_STAGE(PG8_SB(1, 1), b3 + hstep, voffB); PG8_STAGE(PG8_SA(1, 0), a3, voffA);
            PG8_WAIT_V(8); PG8_WAIT_L(0); PG8_BAR; PG8_MMA(1, 0, At, B0); PG8_MMA(1, 1, At, B1); PG8_BAR; PG8_SCHED;
            } else {
            PG8_LDB(B0, 0, 0); PG8_SCHED; PG8_LDA(At, 0, 0); PG8_STAGE(PG8_SA(1, 1), a1 + hstep, voffA);
            PG8_WAIT_L(8); PG8_BAR; PG8_WAIT_L(0); PG8_MMA(0, 0, At, B0); PG8_BAR; PG8_SCHED;
            PG8_LDB(B1, 0, 1); PG8_STAGE(PG8_SB(0, 0), b2, voffB);
            PG8_BAR; PG8_WAIT_L(0); PG8_MMA(0, 1, At, B1); PG8_BAR;
            PG8_LDA(At, 0, 1); PG8_STAGE(PG8_SA(0, 0), a2, voffA);
            PG8_BAR; PG8_WAIT_L(0); PG8_MMA(1, 0, At, B0); PG8_BAR; PG8_SCHED;
            PG8_STAGE(PG8_SB(0, 1), b2 + hstep, voffB);
            PG8_WAIT_V(6); PG8_BAR; PG8_MMA(1, 1, At, B1); PG8_BAR;
            PG8_LDB(B0, 1, 0); PG8_SCHED; PG8_LDA(At, 1, 0); PG8_STAGE(PG8_SA(0, 1), a2 + hstep, voffA);
            PG8_WAIT_L(8); PG8_BAR; PG8_WAIT_L(0); PG8_MMA(0, 0, At, B0); PG8_BAR; PG8_SCHED;
            PG8_LDB(B1, 1, 1); PG8_STAGE(PG8_SB(1, 0), b3, voffB);
            PG8_BAR; PG8_WAIT_L(0); PG8_MMA(0, 1, At, B1); PG8_BAR;
            PG8_LDA(At, 1, 1); PG8_STAGE(PG8_SA(1, 0), a3, voffA);
            PG8_BAR; PG8_WAIT_L(0); PG8_MMA(1, 0, At, B0); PG8_BAR; PG8_SCHED;
            PG8_STAGE(PG8_SB(1, 1), b3 + hstep, voffB);
            PG8_WAIT_V(6); PG8_BAR; PG8_MMA(1, 1, At, B1); PG8_BAR;
            }
        }
        if constexpr (ALIGN_EPI) { if (wr == 0) PG8_BAR; }
        if constexpr (!Epi::AFTER_DRAIN) { int l_; asm volatile("v_mbcnt_lo_u32_b32 %0, -1, 0\n\tv_mbcnt_hi_u32_b32 %0, -1, %0" : "=v"(l_));
            E(acc, cur, wr, wc, l_ & 15, l_ >> 4); S.done(cur); }
        if (!has_next) break;
#pragma unroll
        for (int a = 0; a < 2; ++a)
#pragma unroll
            for (int b = 0; b < 2; ++b)
#pragma unroll
                for (int m = 0; m < 4; ++m)
#pragma unroll
                    for (int n = 0; n < 2; ++n) acc[a][b][m][n] = (f32x4){0.f, 0.f, 0.f, 0.f};
        cur = nxt; cA = nA; cB = nB; ++ui;
        if constexpr (ALIGN_EPI) { if (wr == 1) PG8_BAR; }
    }
    PG8_WAIT_V(0);
    if constexpr (!ALIGN_EPI) { if (wr == 0) PG8_BAR; }
    PG8_BAR;
    if constexpr (Epi::AFTER_DRAIN) { E.fused(acc, cur, wr, wc, fr, fq, lds, wid, lane); S.done(cur); }
#undef PG8_SA
#undef PG8_SB
#undef PG8_STAGE
#undef PG8_LDA
#undef PG8_LDB
#undef PG8_MMA
#undef PG8_WAIT_V
#undef PG8_WAIT_L
#undef PG8_BAR
#undef PG8_SCHED
}
}

#define XB_TMO      128
#define XB_XCNT(j)  (256  + 64 * (j))
#define XB_XSUB(j)  (1280 + 64 * (j))
#define XB_XGEN(j)  (2304 + 64 * (j))
#define XB_TOP      3328
#define XB_TOPGEN   3392
#define XCD_BAR_WORDS 3456
#define XB_SPIN_CAP (1u << 18)

__device__ __forceinline__ unsigned xb_ld(unsigned* p)              { return __hip_atomic_load(p, __ATOMIC_RELAXED, __HIP_MEMORY_SCOPE_AGENT); }
__device__ __forceinline__ unsigned xb_add(unsigned* p, unsigned v) { return __hip_atomic_fetch_add(p, v, __ATOMIC_RELAXED, __HIP_MEMORY_SCOPE_AGENT); }
__device__ __forceinline__ unsigned xb_xcc_id() { return (unsigned)__builtin_amdgcn_s_getreg((3 << 11) | 20) & 0xFu; }
#define XB_SPIN(cond, bar) do { unsigned _sp = 0; while (cond) { __builtin_amdgcn_s_sleep(1); \
    if ((++_sp & 255u) == 0u) { if (xb_ld(&(bar)[XB_TMO])) break; if (_sp > XB_SPIN_CAP) { atomicAdd(&(bar)[XB_TMO], 1u); break; } } } } while (0)

struct XcdBarrier {
    unsigned* bar; unsigned x;
    volatile LAS unsigned* st;
};

__device__ __forceinline__ XcdBarrier xcd_barrier_post(unsigned* bar, volatile LAS unsigned* st) {
    XcdBarrier b; b.bar = bar; b.x = xb_xcc_id(); b.st = st;
    if (threadIdx.x == 0) (void)xb_add(&bar[XB_XCNT(b.x)], 1u);
    return b;
}
__device__ __forceinline__ void xcd_barrier_complete(unsigned* bar, unsigned x, unsigned& nloc, unsigned& nx) {
    const unsigned G = gridDim.x * gridDim.y * gridDim.z;
    unsigned sum, cnt, mine, sp = 0u;
    for (;;) {
        sum = 0u; cnt = 0u; mine = 0u;
#pragma unroll
        for (unsigned j = 0; j < 16; ++j) { const unsigned c = xb_ld(&bar[XB_XCNT(j)]); sum += c; cnt += (c > 0u) ? 1u : 0u; mine = (j == x) ? c : mine; }
        if (sum == G) break;
        __builtin_amdgcn_s_sleep(1);
        if ((++sp & 255u) == 0u) { if (xb_ld(&bar[XB_TMO])) break; if (sp > XB_SPIN_CAP) { atomicAdd(&bar[XB_TMO], 1u); break; } }
    }
    nloc = mine > 0u ? mine : 1u; nx = cnt > 0u ? cnt : 1u;
}

__device__ __forceinline__ void xcd_barrier(const XcdBarrier& b) {
    asm volatile("s_waitcnt vmcnt(0)" ::: "memory");
    __syncthreads();
    if (threadIdx.x == 0) {
        unsigned* bar = b.bar;
        __builtin_amdgcn_s_waitcnt(0);
        unsigned nloc = b.st[0], nx = b.st[1];
        if (nloc == 0u) { xcd_barrier_complete(bar, b.x, nloc, nx); b.st[0] = nloc; b.st[1] = nx; }
        const unsigned old = xb_add(&bar[XB_XSUB(b.x)], 1u);
        const unsigned gen = old / nloc;
        if (old + 1u == (gen + 1u) * nloc) {
            __builtin_amdgcn_fence(__ATOMIC_RELEASE, "agent");
            asm volatile("s_waitcnt vmcnt(0)" ::: "memory");
            const unsigned og = xb_add(&bar[XB_TOP], 1u);
            const unsigned tg = og / nx;
            if (og + 1u == (tg + 1u) * nx) xb_add(&bar[XB_TOPGEN], 1u);
            else XB_SPIN(xb_ld(&bar[XB_TOPGEN]) == tg, bar);
            __builtin_amdgcn_fence(__ATOMIC_ACQUIRE, "agent");
            xb_add(&bar[XB_XGEN(b.x)], 1u);
            asm volatile("s_waitcnt vmcnt(0)" ::: "memory");
        } else {
            XB_SPIN(xb_ld(&bar[XB_XGEN(b.x)]) == gen, bar);
            __builtin_amdgcn_fence(__ATOMIC_ACQUIRE, "agent");
            asm volatile("s_waitcnt vmcnt(0)" ::: "memory");
        }
    }
    __syncthreads();
}

constexpr int NWAVES = 8;
constexpr size_t MiB = 1u << 20;
constexpr int RING_BYTES = 131072, LDSCTL_OFF = RING_BYTES, MISC_OFF = LDSCTL_OFF + 320, LDS_BYTES = 147456;
constexpr int CW_BAR = 4096;
constexpr size_t CTL_ZERO_BYTES = 1 * MiB;

namespace pg8 {
__device__ __forceinline__ unsigned cvt_pk_bf16(float lo, float hi) { unsigned r; asm volatile("v_cvt_pk_bf16_f32 %0, %1, %2" : "=v"(r) : "v"(lo), "v"(hi)); return r; }
typedef float f32x2 __attribute__((ext_vector_type(2)));
struct EpiStoreBf16 {
    static constexpr bool PERM = true, AFTER_DRAIN = false;
    bf16_t* O; int ldc;
    __device__ __forceinline__ void operator()(const f32x4 (&acc)[2][2][4][2], const Unit& u, int wr, int wc, int fr, int fq) const {
        const int row0 = u.pm * BM + wr * 64 + fr, col0 = u.pn * BM + wc * 32 + 8 * fq;
#pragma unroll
        for (int ai = 0; ai < 2; ++ai)
#pragma unroll
            for (int m = 0; m < 4; ++m) { bf16_t* rowp = O + (size_t)(row0 + ai * HALF + m * 16) * ldc + col0;
#pragma unroll
                for (int bj = 0; bj < 2; ++bj) { const f32x4 v0 = acc[ai][bj][m][0], v1 = acc[ai][bj][m][1];
                    u32x4 w; w.x = cvt_pk_bf16(v0[0], v0[1]); w.y = cvt_pk_bf16(v0[2], v0[3]); w.z = cvt_pk_bf16(v1[0], v1[1]); w.w = cvt_pk_bf16(v1[2], v1[3]);
                    *(u32x4*)(rowp + bj * HALF) = w; } }
    }
};

struct EpiMerge {
    static constexpr bool PERM = true, AFTER_DRAIN = false;
    bf16_t* Mg; const bf16_t* proj; const float* gate_b;
    __device__ __forceinline__ void operator()(const f32x4 (&acc)[2][2][4][2], const Unit& u, int wr, int wc, int fr, int fq) const {
        const int row0 = u.pm * BM + wr * 64 + fr, col0 = u.pn * BM + wc * 32 + 8 * fq; const int part = u.part;
        const bf16_t* gsrc = proj + (part ? 16384 : 12288); const float* gbp = gate_b + (part ? 4096 : 0);
        f32x4 gbv[2][2];
#pragma unroll
        for (int bj = 0; bj < 2; ++bj)
#pragma unroll
            for (int n = 0; n < 2; ++n) gbv[bj][n] = *(const f32x4*)(gbp + col0 + bj * HALF + 4 * n);
#pragma unroll
        for (int ai = 0; ai < 2; ++ai)
#pragma unroll
            for (int m = 0; m < 4; ++m) { const int row = row0 + ai * HALF + m * 16;
#pragma unroll
                for (int bj = 0; bj < 2; ++bj) { const int col = col0 + bj * HALF;
                    const u32x4 gw = *(const u32x4*)(gsrc + (size_t)row * 20480 + col);
                    float z[8]; z[0] = __uint_as_float(gw.x << 16); z[1] = __uint_as_float(gw.x & 0xffff0000u); z[2] = __uint_as_float(gw.y << 16); z[3] = __uint_as_float(gw.y & 0xffff0000u);
                    z[4] = __uint_as_float(gw.z << 16); z[5] = __uint_as_float(gw.z & 0xffff0000u); z[6] = __uint_as_float(gw.w << 16); z[7] = __uint_as_float(gw.w & 0xffff0000u);
                    float v[8];
#pragma unroll
                    for (int k = 0; k < 8; ++k) { const float zz = z[k] + gbv[bj][k >> 2][k & 3]; const float sg = __builtin_amdgcn_rcpf(1.0f + __builtin_amdgcn_exp2f(-1.4426950408889634f * zz)); v[k] = sg * acc[ai][bj][m][k >> 2][k & 3]; }
                    bf16_t* dst = Mg + (size_t)row * 4096 + col;
                    if (part) { const u32x4 pw = *(const u32x4*)dst;
                        v[0] += __uint_as_float(pw.x << 16); v[1] += __uint_as_float(pw.x & 0xffff0000u); v[2] += __uint_as_float(pw.y << 16); v[3] += __uint_as_float(pw.y & 0xffff0000u);
                        v[4] += __uint_as_float(pw.z << 16); v[5] += __uint_as_float(pw.z & 0xffff0000u); v[6] += __uint_as_float(pw.w << 16); v[7] += __uint_as_float(pw.w & 0xffff0000u); }
                    u32x4 w; w.x = cvt_pk_bf16(v[0], v[1]); w.y = cvt_pk_bf16(v[2], v[3]); w.z = cvt_pk_bf16(v[4], v[5]); w.w = cvt_pk_bf16(v[6], v[7]);
                    *(u32x4*)dst = w; } }
    }
};
struct DualOrder : StaticOrder { __device__ bool next(int i, Unit& u) const { if (!StaticOrder::next(i >> 1, u)) return false; u.part = i & 1; return true; } };
struct EpiResF32 {
    static constexpr bool PERM = false, AFTER_DRAIN = false;
    float* C; const float* R; float alpha;
    __device__ __forceinline__ void operator()(const f32x4 (&acc)[2][2][4][2], const Unit& u, int wr, int wc, int fr, int fq) const {
        const int row0 = u.pm * BM + wr * 64 + fr, col0 = u.pn * BM + wc * 32 + 4 * fq;
#pragma unroll
        for (int ai = 0; ai < 2; ++ai)
#pragma unroll
            for (int m = 0; m < 4; ++m) { const size_t off = (size_t)(row0 + ai * HALF + m * 16) * 4096 + col0;
#pragma unroll
                for (int bj = 0; bj < 2; ++bj)
#pragma unroll
                    for (int n = 0; n < 2; ++n) { const f32x4 r = *(const f32x4*)(R + off + bj * HALF + n * 16); *(f32x4*)(C + off + bj * HALF + n * 16) = r * alpha + acc[ai][bj][m][n]; } }
    }
};
struct EpiPeerAct {
    static constexpr bool PERM = true, AFTER_DRAIN = false;
    unsigned char* Gd;
    __device__ __forceinline__ void operator()(const f32x4 (&acc)[2][2][4][2], const Unit& u, int wr, int wc, int fr, int fq) const {
        typedef unsigned u32x2v __attribute__((ext_vector_type(2)));
        const int row0 = u.pm * BM + wr * 64 + fr, col0 = u.pn * BM + wc * 32 + 8 * fq;
#pragma unroll
        for (int ai = 0; ai < 2; ++ai)
#pragma unroll
            for (int m = 0; m < 4; ++m) { unsigned char* rowp = Gd + (size_t)(row0 + ai * HALF + m * 16) * 16384 + col0;
#pragma unroll
                for (int bj = 0; bj < 2; ++bj) { const u32x2v gw = *(const u32x2v*)(rowp + bj * HALF);
                    if ((gw.x | gw.y) != 0u) {
                        float v[8];
#pragma unroll
                        for (int k = 0; k < 8; ++k) { const unsigned word = k < 4 ? gw.x : gw.y; const float gk = (k & 3) == 0 ? __builtin_amdgcn_cvt_f32_fp8((int)word, 0) : (k & 3) == 1 ? __builtin_amdgcn_cvt_f32_fp8((int)word, 1) : (k & 3) == 2 ? __builtin_amdgcn_cvt_f32_fp8((int)word, 2) : __builtin_amdgcn_cvt_f32_fp8((int)word, 3);
                            const float a = acc[ai][bj][m][k >> 2][k & 3]; v[k] = gk != 0.f ? __builtin_amdgcn_fmed3f(gk * 0.125f * a * (1.0f + erff(a * 0.7071067811865476f)), -448.f, 448.f) : 0.f; }
                        u32x2v w; int t0 = 0, t1 = 0; t0 = __builtin_amdgcn_cvt_pk_fp8_f32(v[0], v[1], t0, false); t0 = __builtin_amdgcn_cvt_pk_fp8_f32(v[2], v[3], t0, true);
                        t1 = __builtin_amdgcn_cvt_pk_fp8_f32(v[4], v[5], t1, false); t1 = __builtin_amdgcn_cvt_pk_fp8_f32(v[6], v[7], t1, true); w.x = (unsigned)t0; w.y = (unsigned)t1;
                        *(u32x2v*)(rowp + bj * HALF) = w; } } }
    }
};
}

__device__ __forceinline__ void p0_transpose_item(const float* W, int K, int N, bf16* WT, LAS float* scr, int item, int lane) {
    const int nblk = N / 32, kb = item / nblk, nb = item % nblk, k0 = 64 * kb, n0 = 32 * nb;
#pragma unroll 8
    for (int i = 0; i < 32; ++i) { const int kk = 2 * i + (lane >> 5); scr[kk * 33 + (lane & 31)] = W[(size_t)(k0 + kk) * N + n0 + (lane & 31)]; }
    LDS_WAIT(); asm volatile("" ::: "memory");
    const int c = lane & 7;
#pragma unroll
    for (int j = 0; j < 4; ++j) { const int n = (lane >> 3) + 8 * j; const LAS float* s = scr + (8 * c) * 33 + n;
        v4u o; o.x = pk2(s[0 * 33], s[1 * 33]); o.y = pk2(s[2 * 33], s[3 * 33]); o.z = pk2(s[4 * 33], s[5 * 33]); o.w = pk2(s[6 * 33], s[7 * 33]);
        *(GAS v4u*)(WT + (size_t)(n0 + n) * K + k0 + 8 * c) = o; }
    LDS_WAIT(); asm volatile("" ::: "memory");
}
__device__ __forceinline__ void p0_convert(const float* src, bf16* dst, size_t n8, size_t gtid, size_t gthreads) {
    for (size_t i = gtid; i < n8; i += gthreads) { const f32x4 a = *(const GAS f32x4*)(src + i * 8), b = *(const GAS f32x4*)(src + i * 8 + 4);
        v4u o; o.x = pk2(a.x, a.y); o.y = pk2(a.z, a.w); o.z = pk2(b.x, b.y); o.w = pk2(b.z, b.w); *(GAS v4u*)(dst + i * 8) = o; }
}

namespace att {
using s16x4  = __attribute__((ext_vector_type(4))) short;
using f32x16 = __attribute__((ext_vector_type(16))) float;
using u32x4  = __attribute__((ext_vector_type(4))) unsigned;
constexpr int NW = 8, QBLK = 32, KVBLK = 64, LDP = INW;
constexpr float LOG2E = 1.4426950408889634f, CQK = SCALE * LOG2E, THRL = 11.5f, NEGBIG = -1e30f;
constexpr int SHM_V = 16384, SHM_K = 16384;
constexpr int OFF_V = 0, OFF_K = 2 * SHM_V, OFF_WS = OFF_K + 2 * SHM_K, OFF_LUT = OFF_WS + NW * 64 * 4, OFF_GATE = OFF_LUT + 2176, GATE_W = 33 * 32 * 4, OFF_END = OFF_GATE + NW * GATE_W;
static_assert(OFF_END <= RING_BYTES, "attention LDS");
#define KSWZ(row, colB) ((row) * 256 + ((colB) ^ (((row) & 7) << 4)))
#define SBAR() __builtin_amdgcn_sched_barrier(0)
__device__ __forceinline__ int crow(int r, int hi) { return (r & 3) + 8 * (r >> 2) + 4 * hi; }
__device__ __forceinline__ unsigned cvtpk(float lo, float hi) { unsigned r; asm volatile("v_cvt_pk_bf16_f32 %0, %1, %2" : "=v"(r) : "v"(lo), "v"(hi)); return r; }

__device__ __forceinline__ void bias_far(f32x16& p0, f32x16& p1, float rowoff) {
#pragma unroll
  for (int r = 0; r < 16; ++r) { p0[r] = fmaf(p0[r], CQK, rowoff); p1[r] = fmaf(p1[r], CQK, rowoff); }
}
constexpr int LUT_DMAX = 207, LUT_N = 528;
__device__ __forceinline__ void bias_near(f32x16& p0, f32x16& p1, const LAS float* rl, int dist0  , int hi) {
  const LAS float* b = rl + (LUT_DMAX - dist0 + 4 * hi);
#pragma unroll
  for (int r = 0; r < 16; ++r) { const int c = (r & 3) + 8 * (r >> 2); p0[r] = fmaf(p0[r], CQK, b[c]); p1[r] = fmaf(p1[r], CQK, b[c + 32]); }
}
__device__ __forceinline__ void partialSM(f32x16& p0, f32x16& p1, float& m_reg, float& mn, float& alpha) {
  float pmax = p0[0];
#pragma unroll
  for (int r = 1; r < 16; ++r) pmax = fmaxf(pmax, p0[r]);
#pragma unroll
  for (int r = 0; r < 16; ++r) pmax = fmaxf(pmax, p1[r]);
  { auto rr = __builtin_amdgcn_permlane32_swap(__float_as_uint(pmax), __float_as_uint(pmax), false, false);
    pmax = fmaxf(__uint_as_float(rr[0]), __uint_as_float(rr[1])); }
  if (__builtin_expect(__all(pmax - m_reg <= THRL), 1)) { mn = m_reg; alpha = 1.f; }
  else { mn = fmaxf(m_reg, pmax); alpha = __builtin_amdgcn_exp2f(m_reg - mn); m_reg = mn; }
#pragma unroll
  for (int r = 0; r < 16; ++r) { p0[r] -= mn; p1[r] -= mn; }
#pragma unroll
  for (int r = 0; r < 16; ++r) p0[r] = __builtin_amdgcn_exp2f(p0[r]);
}
__device__ __forceinline__ void finishSM(f32x16& p0, f32x16& p1, float alpha, float& l_reg, bf16x8& pa0, bf16x8& pa1, bf16x8& pa2, bf16x8& pa3) {
#pragma unroll
  for (int r = 0; r < 16; ++r) p1[r] = __builtin_amdgcn_exp2f(p1[r]);
  float ps = 0;
#pragma unroll
  for (int r = 0; r < 16; ++r) ps += p0[r];
#pragma unroll
  for (int r = 0; r < 16; ++r) ps += p1[r];
  { auto rr = __builtin_amdgcn_permlane32_swap(__float_as_uint(ps), __float_as_uint(ps), false, false);
    ps = __uint_as_float(rr[0]) + __uint_as_float(rr[1]); }
  l_reg = l_reg * alpha + ps;
#define PK4(P, BASE, OUT) do { unsigned a0 = cvtpk(P[BASE + 0], P[BASE + 1]), a1 = cvtpk(P[BASE + 2], P[BASE + 3]);   \
    unsigned b0 = cvtpk(P[BASE + 4], P[BASE + 5]), b1 = cvtpk(P[BASE + 6], P[BASE + 7]);                              \
    auto r0 = __builtin_amdgcn_permlane32_swap(a0, b0, false, false); auto r1 = __builtin_amdgcn_permlane32_swap(a1, b1, false, false); \
    u32x4 w = {r0[0], r1[0], r0[1], r1[1]}; OUT = *reinterpret_cast<bf16x8*>(&w); } while (0)
  PK4(p0, 0, pa0); PK4(p0, 8, pa1); PK4(p1, 0, pa2); PK4(p1, 8, pa3);
#undef PK4
}
__device__ __forceinline__ void qkt(f32x16& p0, f32x16& p1, const LAS char* Ks, const bf16x8* qr, int r32, int hi) {
  p0 = f32x16{}; p1 = f32x16{};
#pragma unroll
  for (int d0 = 0; d0 < 8; ++d0) { const int cb = (d0 * 16 + hi * 8) * 2;
    const bf16x8 b0 = *reinterpret_cast<const LAS bf16x8*>(Ks + KSWZ(r32, cb));
    const bf16x8 b1 = *reinterpret_cast<const LAS bf16x8*>(Ks + KSWZ(32 + r32, cb));
    p0 = __builtin_amdgcn_mfma_f32_32x32x16_bf16(b0, qr[d0], p0, 0, 0, 0);
    p1 = __builtin_amdgcn_mfma_f32_32x32x16_bf16(b1, qr[d0], p1, 0, 0, 0); }
}
__device__ __forceinline__ int v_st(int k, int c) { const int kk = (k & ~0xC) | ((k & 4) << 1) | ((k & 8) >> 1); return ((kk >> 3) * 4 + (c >> 5)) * 512 + ((kk & 7) * 32 + (c & 31)) * 2; }
__device__ __forceinline__ int v_rd_base(int lane) { return ((lane & 3) << 3) | (((lane >> 2) & 3) << 6) | (((lane >> 4) & 1) << 5) | (((lane >> 5) & 1) << 8); }
constexpr int v_rd_off(int d0, int ks, int half) { return d0 * 512 + ks * 4096 + half * 2048; }
template <int OFF> __device__ __forceinline__ s16x4 tr_read(int vb) {
  s16x4 r; asm volatile("ds_read_b64_tr_b16 %0, %1 offset:%2" : "=&v"(r) : "v"(vb), "i"(OFF) : "memory"); return r;
}
template <int D0> __device__ __forceinline__ void pv_one(f32x16& od, int vb, bf16x8 pa0, bf16x8 pa1, bf16x8 pa2, bf16x8 pa3) {
  const s16x4 l0 = tr_read<v_rd_off(D0, 0, 0)>(vb), h0 = tr_read<v_rd_off(D0, 0, 1)>(vb), l1 = tr_read<v_rd_off(D0, 1, 0)>(vb), h1 = tr_read<v_rd_off(D0, 1, 1)>(vb);
  const s16x4 l2 = tr_read<v_rd_off(D0, 2, 0)>(vb), h2 = tr_read<v_rd_off(D0, 2, 1)>(vb), l3 = tr_read<v_rd_off(D0, 3, 0)>(vb), h3 = tr_read<v_rd_off(D0, 3, 1)>(vb);
  asm volatile("s_waitcnt lgkmcnt(0)" ::: "memory"); SBAR();
#define PK(L, H) (bf16x8){L[0], L[1], L[2], L[3], H[0], H[1], H[2], H[3]}
  od = __builtin_amdgcn_mfma_f32_32x32x16_bf16(pa0, PK(l0, h0), od, 0, 0, 0);
  od = __builtin_amdgcn_mfma_f32_32x32x16_bf16(pa1, PK(l1, h1), od, 0, 0, 0);
  od = __builtin_amdgcn_mfma_f32_32x32x16_bf16(pa2, PK(l2, h2), od, 0, 0, 0);
  od = __builtin_amdgcn_mfma_f32_32x32x16_bf16(pa3, PK(l3, h3), od, 0, 0, 0);
#undef PK
}
__device__ __forceinline__ void pv_d0(f32x16* o, int vb, bf16x8 pa0, bf16x8 pa1, bf16x8 pa2, bf16x8 pa3) {
  pv_one<0>(o[0], vb, pa0, pa1, pa2, pa3); pv_one<1>(o[1], vb, pa0, pa1, pa2, pa3); pv_one<2>(o[2], vb, pa0, pa1, pa2, pa3); pv_one<3>(o[3], vb, pa0, pa1, pa2, pa3);
}

struct UnitDesc { const bf16* Q; const bf16* K; const bf16* V; bf16* O; int ldo; int qb; int bias_head; const bf16* kmean;   };

__device__ __forceinline__ void attn_unit(const UnitDesc& u, const float* __restrict__ rel_bias, LAS char* lds, const int wave_id) {
  int tid_ = wave_id * 64 + lane_id(); asm volatile("" : "+v"(tid_));
  const int tid = tid_, wid = tid >> 6, lane = tid & 63, r32 = lane & 31, hi = lane >> 5;
  LAS char* V_lds = lds + OFF_V; LAS char* K_lds = lds + OFF_K;
  LAS float* wsl = (LAS float*)(lds + OFF_WS) + wid * 64; LAS float* li_l = wsl; LAS float* al_l = wsl + 32;
  LAS float* lut = (LAS float*)(lds + OFF_LUT);
  const int q0 = u.qb * 256, qw0 = q0 + wid * QBLK, qpos = qw0 + r32;
  __syncthreads();
  for (int i = tid; i < LUT_N; i += 512) { const int d = LUT_DMAX - i; lut[i] = d < 0 ? NEGBIG : rel_bias[t5_bucket(d > 127 ? 127 : d) * 24 + u.bias_head] * LOG2E; }
  float m_reg = NEGBIG, l_reg = 0; f32x16 o[4] = {}; bf16x8 qr[8];
  const bf16* Qw = u.Q + (size_t)(qw0 + r32) * LDP + hi * 8;
#pragma unroll
  for (int d0 = 0; d0 < 8; ++d0) qr[d0] = *reinterpret_cast<const bf16x8*>(Qw + d0 * 16);
  unsigned rowmask = 0xffffffffu;
  if (u.kmean) {
    { const int r = tid >> 4, c = (tid & 15) * 8;
      *reinterpret_cast<LAS bf16x8*>(K_lds + KSWZ(r, c * 2)) = *reinterpret_cast<const bf16x8*>(u.kmean + r * 128 + c); }
    __syncthreads();
    f32x16 g0 = f32x16{};
#pragma unroll
    for (int d0 = 0; d0 < 8; ++d0) { const int cb = (d0 * 16 + hi * 8) * 2;
      const bf16x8 b0 = *reinterpret_cast<const LAS bf16x8*>(K_lds + KSWZ(r32, cb));
      g0 = __builtin_amdgcn_mfma_f32_32x32x16_bf16(b0, qr[d0], g0, 0, 0, 0); }
    LAS float* gs = (LAS float*)(lds + OFF_GATE + wid * GATE_W);
#pragma unroll
    for (int r = 0; r < 16; ++r) gs[r32 * 33 + crow(r, hi)] = g0[r];
    asm volatile("s_waitcnt lgkmcnt(0)" ::: "memory");
    __builtin_amdgcn_wave_barrier();
    float b1v = NEGBIG, b2v = NEGBIG, b3v = NEGBIG; int b1i = -1, b2i = -1, b3i = -1;
    for (int j = 0; j < u.qb; ++j) { const float g = gs[r32 * 33 + j];
      if (g > b1v) { b3v = b2v; b3i = b2i; b2v = b1v; b2i = b1i; b1v = g; b1i = j; }
      else if (g > b2v) { b3v = b2v; b3i = b2i; b2v = g; b2i = j; }
      else if (g > b3v) { b3v = g; b3i = j; } }
    rowmask = 1u << u.qb;
    if (b1i >= 0) rowmask |= 1u << b1i; if (b2i >= 0) rowmask |= 1u << b2i; if (b3i >= 0) rowmask |= 1u << b3i;
    __syncthreads();
  }
  const int sr = tid >> 4, sc = (tid & 15) * 8, vst0 = v_st(sr, sc), vst1 = v_st(32 + sr, sc);
  const int vb0 = (int)(uintptr_t)V_lds + v_rd_base(lane);
  struct { bf16x8 vs0, vs1, ks0, ks1; } sr_[2];
  const bf16* Kh = u.K; const bf16* Vh = u.V;
#define SLOAD(i, k0) do { sr_[i].vs0 = *reinterpret_cast<const bf16x8*>(&Vh[(size_t)((k0) + sr) * LDP + sc]); sr_[i].vs1 = *reinterpret_cast<const bf16x8*>(&Vh[(size_t)((k0) + 32 + sr) * LDP + sc]); \
    sr_[i].ks0 = *reinterpret_cast<const bf16x8*>(&Kh[(size_t)((k0) + sr) * LDP + sc]); sr_[i].ks1 = *reinterpret_cast<const bf16x8*>(&Kh[(size_t)((k0) + 32 + sr) * LDP + sc]); } while (0)
#define SWRITE(b, i) do { *(LAS bf16x8*)(V_lds + (b) * SHM_V + vst0) = sr_[i].vs0; *(LAS bf16x8*)(V_lds + (b) * SHM_V + vst1) = sr_[i].vs1; const int kc = sc * 2; \
    *(LAS bf16x8*)(K_lds + (b) * SHM_K + KSWZ(sr, kc)) = sr_[i].ks0; *(LAS bf16x8*)(K_lds + (b) * SHM_K + KSWZ(32 + sr, kc)) = sr_[i].ks1; } while (0)
#define SWAIT() asm volatile("s_waitcnt vmcnt(4)" ::: "memory")
#define RESC(a) do { if (__any((a) < 1.f)) { if (hi == 0) al_l[r32] = (a); asm volatile("s_waitcnt lgkmcnt(0)" ::: "memory"); \
    _Pragma("unroll") for (int d = 0; d < 4; ++d) _Pragma("unroll") for (int r = 0; r < 16; ++r) o[d][r] *= al_l[crow(r, hi)]; } } while (0)
#define BIAS(P0, P1, j) do { const int k0_ = (j) * KVBLK; const bool allowed_ = (rowmask >> ((j) >> 2)) & 1u; \
    if (qw0 - k0_ - 63 >= 113) bias_far(P0, P1, allowed_ ? b31c : NEGBIG); else bias_near(P0, P1, lut, allowed_ ? qpos - k0_ : -64, hi); } while (0)
  f32x16 pA0, pA1, pB0, pB1; float mnA, mnB, alA, alB; bf16x8 pa0, pa1, pa2, pa3; const int NT = 4 * (u.qb + 1);
  constexpr int SE = 0, SO = 1;
  SLOAD(SE, 0); asm volatile("s_waitcnt vmcnt(0)" ::: "memory"); SWRITE(0, SE); __syncthreads();
  const float b31c = lut[LUT_DMAX - 127];
  qkt(pA0, pA1, K_lds, qr, r32, hi); BIAS(pA0, pA1, 0); partialSM(pA0, pA1, m_reg, mnA, alA);
  SLOAD(SO, KVBLK); if (2 < NT) SLOAD(SE, 2 * KVBLK);
  SWAIT(); SWRITE(1, SO); __syncthreads();
  for (int j = 1; j + 1 < NT; j += 2) {
    SBAR(); qkt(pB0, pB1, K_lds + SHM_K, qr, r32, hi);
    finishSM(pA0, pA1, alA, l_reg, pa0, pa1, pa2, pa3); SBAR();
    SLOAD(SO, (j + 2) * KVBLK); SBAR();
    pv_d0(o, vb0, pa0, pa1, pa2, pa3); BIAS(pB0, pB1, j); partialSM(pB0, pB1, m_reg, mnB, alB);
    __syncthreads(); SWAIT(); SWRITE(0, SE);
    RESC(alB); __syncthreads();
    SBAR(); qkt(pA0, pA1, K_lds, qr, r32, hi);
    finishSM(pB0, pB1, alB, l_reg, pa0, pa1, pa2, pa3); SBAR();
    if (j + 3 < NT) SLOAD(SE, (j + 3) * KVBLK); SBAR();
    pv_d0(o, vb0 + SHM_V, pa0, pa1, pa2, pa3); BIAS(pA0, pA1, j + 1); partialSM(pA0, pA1, m_reg, mnA, alA);
    __syncthreads(); SWAIT(); SWRITE(1, SO);
    RESC(alA); __syncthreads();
  }
  SBAR(); qkt(pB0, pB1, K_lds + SHM_K, qr, r32, hi);
  finishSM(pA0, pA1, alA, l_reg, pa0, pa1, pa2, pa3); SBAR();
  pv_d0(o, vb0, pa0, pa1, pa2, pa3); BIAS(pB0, pB1, NT - 1); partialSM(pB0, pB1, m_reg, mnB, alB);
  __syncthreads(); RESC(alB);
  finishSM(pB0, pB1, alB, l_reg, pa0, pa1, pa2, pa3); SBAR();
  pv_d0(o, vb0 + SHM_V, pa0, pa1, pa2, pa3);
  if (hi == 0) li_l[r32] = l_reg; asm volatile("s_waitcnt lgkmcnt(0)" ::: "memory");
  float rli[16];
#pragma unroll
  for (int r = 0; r < 16; ++r) rli[r] = __builtin_amdgcn_rcpf(li_l[crow(r, hi)]);
  bf16* Ow = u.O + (size_t)qw0 * u.ldo;
#pragma unroll
  for (int r = 0; r < 16; ++r) { const int orow = crow(r, hi);
#pragma unroll
    for (int d0 = 0; d0 < 4; ++d0) Ow[(size_t)orow * u.ldo + d0 * 32 + r32] = (bf16)f2bf(o[d0][r] * rli[r]); }
#undef SLOAD
#undef SWRITE
#undef SWAIT
#undef RESC
#undef BIAS
}
}

__device__ __forceinline__ float clamp8(float x) { return __builtin_amdgcn_fmed3f(x, -448.f, 448.f); }
__device__ __forceinline__ unsigned pk4_fp8(float a, float b, float c, float d) { int w = 0; w = __builtin_amdgcn_cvt_pk_fp8_f32(clamp8(a), clamp8(b), w, false); w = __builtin_amdgcn_cvt_pk_fp8_f32(clamp8(c), clamp8(d), w, true); return (unsigned)w; }
__device__ __forceinline__ void p0_transpose_item8(const float* W, int K, int N, unsigned char* WT, float scale, LAS float* scr, int item, int lane) {
    const int nblk = N / 32, kb = item / nblk, nb = item % nblk, k0 = 64 * kb, n0 = 32 * nb;
#pragma unroll 8
    for (int i = 0; i < 32; ++i) { const int kk = 2 * i + (lane >> 5); scr[kk * 33 + (lane & 31)] = W[(size_t)(k0 + kk) * N + n0 + (lane & 31)]; }
    LDS_WAIT(); asm volatile("" ::: "memory");
    const int n = lane >> 1, kh = (lane & 1) * 32; const LAS float* sp = scr + kh * 33 + n;
    v4u o0, o1;
    o0.x = pk4_fp8(sp[0 * 33] * scale, sp[1 * 33] * scale, sp[2 * 33] * scale, sp[3 * 33] * scale); o0.y = pk4_fp8(sp[4 * 33] * scale, sp[5 * 33] * scale, sp[6 * 33] * scale, sp[7 * 33] * scale);
    o0.z = pk4_fp8(sp[8 * 33] * scale, sp[9 * 33] * scale, sp[10 * 33] * scale, sp[11 * 33] * scale); o0.w = pk4_fp8(sp[12 * 33] * scale, sp[13 * 33] * scale, sp[14 * 33] * scale, sp[15 * 33] * scale);
    o1.x = pk4_fp8(sp[16 * 33] * scale, sp[17 * 33] * scale, sp[18 * 33] * scale, sp[19 * 33] * scale); o1.y = pk4_fp8(sp[20 * 33] * scale, sp[21 * 33] * scale, sp[22 * 33] * scale, sp[23 * 33] * scale);
    o1.z = pk4_fp8(sp[24 * 33] * scale, sp[25 * 33] * scale, sp[26 * 33] * scale, sp[27 * 33] * scale); o1.w = pk4_fp8(sp[28 * 33] * scale, sp[29 * 33] * scale, sp[30 * 33] * scale, sp[31 * 33] * scale);
    GAS v4u* dst = (GAS v4u*)(WT + (size_t)(n0 + n) * K + k0 + kh); dst[0] = o0; dst[1] = o1;
    LDS_WAIT(); asm volatile("" ::: "memory");
}
__device__ __forceinline__ void p0_convert8(const float* src, unsigned char* dst, float scale, size_t n16, size_t gtid, size_t gthreads) {
    for (size_t i = gtid; i < n16; i += gthreads) { const GAS f32x4* p = (const GAS f32x4*)(src + i * 16); const f32x4 a = p[0] * scale, b = p[1] * scale, c = p[2] * scale, d = p[3] * scale;
        v4u o; o.x = pk4_fp8(a.x, a.y, a.z, a.w); o.y = pk4_fp8(b.x, b.y, b.z, b.w); o.z = pk4_fp8(c.x, c.y, c.z, c.w); o.w = pk4_fp8(d.x, d.y, d.z, d.w); *(GAS v4u*)(dst + i * 16) = o; }
}

namespace rt {
using f32x16 = __attribute__((ext_vector_type(16))) float;
__device__ __forceinline__ void ins16(float (&val)[16], int (&idx)[16], float v, int i) {
#pragma unroll
    for (int s = 0; s < 16; ++s) { const bool gt = v > val[s]; const float tv = gt ? val[s] : v; const int ti = gt ? idx[s] : i; val[s] = gt ? v : val[s]; idx[s] = gt ? i : idx[s]; v = tv; i = ti; }
}
__device__ __forceinline__ void side_top16(const bf16* q, const bf16* keys, int r32, int hi, float (&val)[16], int (&idx)[16]) {
    bf16x8 qf[8];
#pragma unroll
    for (int d0 = 0; d0 < 8; ++d0) qf[d0] = *reinterpret_cast<const bf16x8*>(q + d0 * 16 + hi * 8);
    f32x16 acc[4];
#pragma unroll
    for (int nb = 0; nb < 4; ++nb) { acc[nb] = f32x16{};
#pragma unroll
        for (int d0 = 0; d0 < 8; ++d0) { const bf16x8 kf = *reinterpret_cast<const bf16x8*>(keys + (32 * nb + r32) * 128 + d0 * 16 + hi * 8);
            acc[nb] = __builtin_amdgcn_mfma_f32_32x32x16_bf16(kf, qf[d0], acc[nb], 0, 0, 0); } }
#pragma unroll
    for (int s = 0; s < 16; ++s) { val[s] = -3.0e38f; idx[s] = 0; }
#pragma unroll
    for (int nb = 0; nb < 4; ++nb)
#pragma unroll
        for (int r = 0; r < 16; ++r) ins16(val, idx, acc[nb][r], 32 * nb + (r & 3) + 8 * (r >> 2) + 4 * hi);
    float pv[16]; int pi[16];
#pragma unroll
    for (int s = 0; s < 16; ++s) { pv[s] = __shfl_xor(val[s], 32); pi[s] = __shfl_xor(idx[s], 32); }
#pragma unroll
    for (int s = 0; s < 16; ++s) ins16(val, idx, pv[s], pi[s]);
}
template <int I, int J> struct Cand {
    static __device__ __forceinline__ void run(float (&cv)[16], int (&ci)[16], const float (&v1)[16], const float (&v2)[16], const int (&i1)[16], const int (&i2)[16]) {
        if constexpr ((I + 1) * (J + 1) <= 16) { ins16(cv, ci, v1[I] + v2[J], i1[I] * 128 + i2[J]); Cand<I, J + 1>::run(cv, ci, v1, v2, i1, i2); }
        else if constexpr (I + 1 < 16) Cand<I + 1, 0>::run(cv, ci, v1, v2, i1, i2);
    }
};
template <int I> struct Cand<I, 16> { static __device__ __forceinline__ void run(float (&cv)[16], int (&ci)[16], const float (&v1)[16], const float (&v2)[16], const int (&i1)[16], const int (&i2)[16]) {
        if constexpr (I + 1 < 16) Cand<I + 1, 0>::run(cv, ci, v1, v2, i1, i2); } };
constexpr int OFF_E = 0, OFF_G = 16384;
__device__ __forceinline__ void route_block(int t0, const bf16* PQ, const bf16* KEYSB, unsigned char* GD, int* EIDX, float* GATES, LAS char* lds, const int wave_id) {
    int tid_ = wave_id * 64 + lane_id(); asm volatile("" : "+v"(tid_));
    const int tid = tid_, h = tid >> 6, lane = tid & 63, r32 = lane & 31, hi = lane >> 5;
    LAS int* ent_e = (LAS int*)(lds + OFF_E); LAS float* ent_g = (LAS float*)(lds + OFF_G);
    __syncthreads();
    const bf16* q = PQ + (size_t)(t0 + r32) * 2048 + h * 256;
    float v1[16], v2[16], cv[16]; int i1[16], i2[16], ci[16];
    side_top16(q, KEYSB, r32, hi, v1, i1);
    side_top16(q + 128, KEYSB + 128 * 128, r32, hi, v2, i2);
#pragma unroll
    for (int s = 0; s < 16; ++s) { cv[s] = -3.0e38f; ci[s] = 0; }
    Cand<0, 0>::run(cv, ci, v1, v2, i1, i2);
    const float mx = cv[0]; float sum = 0.f;
#pragma unroll
    for (int s = 0; s < 16; ++s) { cv[s] = __expf(cv[s] - mx); sum += cv[s]; }
    const float inv = 1.0f / sum;
    if (hi == 0) {
#pragma unroll
        for (int s = 0; s < 16; ++s) { ent_e[r32 * 128 + h * 16 + s] = ci[s]; ent_g[r32 * 128 + h * 16 + s] = cv[s] * inv; }
        if (EIDX) {
#pragma unroll
            for (int s = 0; s < 16; ++s) { EIDX[(size_t)(t0 + r32) * 128 + h * 16 + s] = ci[s]; GATES[(size_t)(t0 + r32) * 128 + h * 16 + s] = cv[s] * inv; } }
    }
    __syncthreads();
    { const int tok = tid >> 4, s0 = (tid & 15) * 8;
        for (int k = 0; k < 8; ++k) { const int sidx = s0 + k, e = ent_e[tok * 128 + sidx]; float g = 0.f; bool first = true;
            for (int s2 = 0; s2 < 128; ++s2) { if (ent_e[tok * 128 + s2] == e) { g += ent_g[tok * 128 + s2]; if (s2 < sidx) first = false; } }
            if (first) GD[(size_t)(t0 + tok) * 16384 + e] = (unsigned char)(pk4_fp8(g * 256.f, 0.f, 0.f, 0.f) & 0xffu); } }
}
}

__device__ __forceinline__ float wave_sum(float v) {
#pragma unroll
    for (int o = 1; o < 64; o <<= 1) v += __shfl_xor(v, o);
    return v;
}
__device__ __forceinline__ void ln_row(const float* in, const float* g, const float* b, float* outf, bf16* outb, unsigned char* outq, int lane) {
    f32x4 v[16]; float s = 0.f;
#pragma unroll
    for (int j = 0; j < 16; ++j) { v[j] = *(const GAS f32x4*)(in + 256 * j + 4 * lane); s += (v[j].x + v[j].y) + (v[j].z + v[j].w); }
    const float mean = wave_sum(s) * (1.0f / DM); float s2 = 0.f;
#pragma unroll
    for (int j = 0; j < 16; ++j) { v[j] = v[j] - mean; s2 += (v[j].x * v[j].x + v[j].y * v[j].y) + (v[j].z * v[j].z + v[j].w * v[j].w); }
    const float rstd = rsqrtf(wave_sum(s2) * (1.0f / DM) + LN_EPS);
#pragma unroll
    for (int j = 0; j < 16; ++j) { const f32x4 gv = *(const GAS f32x4*)(g + 256 * j + 4 * lane), bv = *(const GAS f32x4*)(b + 256 * j + 4 * lane); const f32x4 y = v[j] * rstd * gv + bv;
        *(GAS f32x4*)(outf + 256 * j + 4 * lane) = y;
        if (outb) { v2u o; o.x = pk2(y.x, y.y); o.y = pk2(y.z, y.w); *(GAS v2u*)(outb + 256 * j + 4 * lane) = o; }
        if (outq) *(GAS unsigned*)(outq + 256 * j + 4 * lane) = pk4_fp8(y.x, y.y, y.z, y.w); }
}

struct Args { const float* in[21]; float* out; unsigned char* ws; int ph_lo, ph_hi; };
constexpr size_t WS_CTL = 0, WS_KMEANB = 1 * MiB, WS_KEYSB = 1 * MiB + 512 * 1024;
constexpr size_t WS_WINT = 2 * MiB, WS_MERGED = 2 * MiB, WS_X1B = 66 * MiB, WS_PQ = 130 * MiB;
constexpr size_t WS_XB = 162 * MiB, WS_YA = 162 * MiB, WS_YB = 194 * MiB;
constexpr size_t WS_PROJ = 226 * MiB, WS_G = 226 * MiB;
constexpr size_t WS_OP0 = 546 * MiB, WS_OP1 = 578 * MiB, WS_WOA = 610 * MiB, WS_WOB = 626 * MiB, WS_WOUT = 642 * MiB, WS_WQ = 674 * MiB, WS_UB = 690 * MiB, WS_VT = 818 * MiB, WS_X1F = 946 * MiB;
constexpr size_t WS_EIDX = 1074 * MiB, WS_GATES = 1078 * MiB, WS_NEED = 1082 * MiB;

__global__ void __launch_bounds__(NWAVES * 64, 2) mega_fwd(Args args) {
    extern __shared__ __attribute__((aligned(16))) unsigned char lds_raw[];
    LAS unsigned char* lds = (LAS unsigned char*)lds_raw;
    volatile LAS unsigned* MISC = (volatile LAS unsigned*)(lds + MISC_OFF);
    const int wave = __builtin_amdgcn_readfirstlane((int)threadIdx.x >> 6);
#define lane (lane_id())
#define tid (wave * 64 + lane_id())
    const int G = gridDim.x; const int vcu = (G % 8 == 0) ? ((int)blockIdx.x % 8) * (G / 8) + (int)blockIdx.x / 8 : (int)blockIdx.x;
    unsigned char* ws = args.ws;
    gu32* ctl = (gu32*)(ws + WS_CTL);
    for (int u = tid; u < (LDS_BYTES - LDSCTL_OFF) / 4; u += NWAVES * 64) ((LAS unsigned*)(lds + LDSCTL_OFF))[u] = 0u;
    __syncthreads();
    XcdBarrier bar = xcd_barrier_post((unsigned*)(ctl + CW_BAR), MISC + 8);
    const int lo = args.ph_lo, hi = args.ph_hi;
#define IN(k) (lo <= (k) && (k) < hi)
#define BOTH(k) (IN(k) && IN((k) + 1))
#define WINT ((bf16*)(ws + WS_WINT))
#define XB ((bf16*)(ws + WS_XB))
#define PROJ ((bf16*)(ws + WS_PROJ))

#define MERGED ((bf16*)(ws + WS_MERGED))
#define X1B ((bf16*)(ws + WS_X1B))
#define PQ ((bf16*)(ws + WS_PQ))
#define GD ((bf16*)(ws + WS_G))
#define WOA ((bf16*)(ws + WS_WOA))
#define WOB ((bf16*)(ws + WS_WOB))
#define WOUT ((bf16*)(ws + WS_WOUT))
#define WQ ((bf16*)(ws + WS_WQ))
#define UB ((bf16*)(ws + WS_UB))
#define VT ((bf16*)(ws + WS_VT))
#define KEYSB ((bf16*)(ws + WS_KEYSB))
#define X1F ((float*)(ws + WS_X1F))
#define X1Q ((unsigned char*)(ws + WS_OP0))
    if (IN(0)) {
        LAS float* scr = (LAS float*)(lds + wave * 16384);
        const int gw = vcu * NWAVES + wave, NGW = G * NWAVES;
        constexpr int I_IN = (DM / 64) * (INW / 32), I_OA = (2048 / 64) * (DM / 32), I_OUT = (DM / 64) * (DM / 32), I_WQ = (DM / 64) * (2048 / 32), I_V = (16384 / 64) * (DM / 32);
        for (int it = gw; it < I_IN + 2 * I_OA + I_OUT + I_WQ + I_V; it += NGW) { int r = it;
            if (r < I_IN) { p0_transpose_item(args.in[1], DM, INW, WINT, scr, r, lane); continue; } r -= I_IN;
            if (r < I_OA) { p0_transpose_item(args.in[9], 2048, DM, WOA, scr, r, lane); continue; } r -= I_OA;
            if (r < I_OA) { p0_transpose_item(args.in[10], 2048, DM, WOB, scr, r, lane); continue; } r -= I_OA;
            if (r < I_OUT) { p0_transpose_item(args.in[11], DM, DM, WOUT, scr, r, lane); continue; } r -= I_OUT;
            if (r < I_WQ) { p0_transpose_item(args.in[14], DM, 2048, WQ, scr, r, lane); continue; } r -= I_WQ;
            p0_transpose_item8(args.in[18], 16384, DM, (unsigned char*)VT, 8.0f, scr, r, lane); }
        const size_t gtid = (size_t)blockIdx.x * 512 + tid, gth = (size_t)G * 512;
        p0_convert(args.in[0], XB, (size_t)S * DM / 8, gtid, gth);
        p0_convert8(args.in[17], (unsigned char*)UB, 64.0f, (size_t)16384 * DM / 16, gtid, gth);
        p0_convert(args.in[15], KEYSB, 128 * 128 / 8, gtid, gth);
        p0_convert(args.in[16], KEYSB + 128 * 128, 128 * 128 / 8, gtid, gth);
        if (BOTH(0)) xcd_barrier(bar);
    }
    if (IN(1)) {
        pg8::Gemm g{XB, WINT, XB, WINT, S, INW, DM, 0}; pg8::StaticOrder So; So.init(S, INW, G, (int)blockIdx.x);
        pg8::EpiStoreBf16 E{PROJ, INW};
        pg8::gemm_phase<pg8::EpiStoreBf16, pg8::StaticOrder, true, true>(lds, g, So, E, wave);
        if (BOTH(1)) xcd_barrier(bar);
    }

#define KMEANB ((bf16*)(ws + WS_KMEANB))
#define YA ((bf16*)(ws + WS_YA))
#define YB ((bf16*)(ws + WS_YB))
#define OP0 ((bf16*)(ws + WS_OP0))
#define OP1 ((bf16*)(ws + WS_OP1))
    if (IN(2)) {
        for (int it = vcu * NWAVES + wave; it < 16 * 32; it += G * NWAVES) { const int h = it >> 5, j = it & 31;
            const bf16* kp = PROJ + (size_t)(j * 256) * INW + 2048 + h * 128 + 2 * lane; float s0 = 0.f, s1 = 0.f;
            for (int i = 0; i < 256; ++i) { const unsigned w = *(const unsigned*)(kp + (size_t)i * INW); s0 += bflo(w); s1 += bfhi(w); }
            *(unsigned*)(KMEANB + (size_t)it * 128 + 2 * lane) = pk2(s0 * (1.0f / 256.0f), s1 * (1.0f / 256.0f)); }
        if (BOTH(2)) xcd_barrier(bar);
    }
    if (IN(3)) {
#pragma nounroll
        for (int p = (int)blockIdx.x; p < 768; p += G) {
            const int xcd = p & 7, rank = (p >> 3) & 31, slot = p >> 8, t = rank & 15, gsel = rank >> 4;
#pragma nounroll
            for (int sub = 0; sub < 2; ++sub) {
                att::UnitDesc u; u.qb = sub == 0 ? 31 - t : t; u.ldo = 2048;
                if (slot == 0) { const int h = 2 * xcd + gsel; u.Q = PROJ + h * 128; u.K = PROJ + 2048 + h * 128; u.V = PROJ + 4096 + h * 128; u.O = YA + h * 128; u.bias_head = h; u.kmean = KMEANB + (size_t)h * 32 * 128; }
                else { const int pm = slot - 1, h = xcd; u.Q = PROJ + 6144 + h * 256 + pm * 128; u.K = PROJ + 8192 + h * 256 + pm * 128; u.V = PROJ + 10240 + h * 256 + gsel * 128;
                       u.O = (pm ? OP1 : OP0) + h * 256 + gsel * 128; u.bias_head = 16 + h; u.kmean = nullptr; }
                att::attn_unit(u, args.in[3], (LAS char*)lds, wave);
            }
        }
        if (BOTH(3)) xcd_barrier(bar);
    }
    if (IN(4)) {
        float a = args.in[4][lane] * args.in[5][lane] + args.in[4][lane + 64] * args.in[5][lane + 64], b = args.in[6][lane] * args.in[7][lane] + args.in[6][lane + 64] * args.in[7][lane + 64];
#pragma unroll
        for (int o = 1; o < 64; o <<= 1) { a += __shfl_xor(a, o); b += __shfl_xor(b, o); }
        const float lam = expf(a) - expf(b) + LAMBDA_INIT;
        const f32x4 gsub = *(const GAS f32x4*)(args.in[8] + 4 * lane);
        for (int it = vcu * NWAVES + wave; it < S * 8; it += G * NWAVES) { const size_t off = (size_t)(it >> 3) * 2048 + (it & 7) * 256 + 4 * lane;
            const v2u w0 = *(const GAS v2u*)(OP0 + off), w1 = *(const GAS v2u*)(OP1 + off);
            const float y0 = bflo(w0.x) - lam * bflo(w1.x), y1 = bfhi(w0.x) - lam * bfhi(w1.x), y2 = bflo(w0.y) - lam * bflo(w1.y), y3 = bfhi(w0.y) - lam * bfhi(w1.y);
            float ss = (y0 * y0 + y1 * y1) + (y2 * y2 + y3 * y3);
#pragma unroll
            for (int o = 1; o < 64; o <<= 1) ss += __shfl_xor(ss, o);
            const float rs = rsqrtf(ss * (1.0f / 256.0f) + LN_EPS) * (1.0f - LAMBDA_INIT);
            v2u o2; o2.x = pk2(y0 * rs * gsub.x, y1 * rs * gsub.y); o2.y = pk2(y2 * rs * gsub.z, y3 * rs * gsub.w); *(GAS v2u*)(YB + off) = o2; }
        if (BOTH(4)) xcd_barrier(bar);
    }

    if (IN(5)) {
        pg8::Gemm g{YA, WOA, YB, WOB, S, DM, 2048, 0}; pg8::DualOrder So; So.init(S, DM, G, (int)blockIdx.x);
        pg8::EpiMerge E{MERGED, PROJ, args.in[2]};
        pg8::gemm_phase<pg8::EpiMerge, pg8::DualOrder, true, true>(lds, g, So, E, wave);
        if (BOTH(5)) xcd_barrier(bar);
    }
    if (IN(6)) {
        pg8::Gemm g{MERGED, WOUT, MERGED, WOUT, S, DM, DM, 0}; pg8::StaticOrder So; So.init(S, DM, G, (int)blockIdx.x);
        pg8::EpiResF32 E{args.out, args.in[0], ALPHA};
        pg8::gemm_phase<pg8::EpiResF32, pg8::StaticOrder, true, true>(lds, g, So, E, wave);
        if (BOTH(6)) xcd_barrier(bar);
    }
    if (IN(7)) {
        for (int m = vcu * NWAVES + wave; m < S; m += G * NWAVES) ln_row(args.out + (size_t)m * DM, args.in[12], args.in[13], X1F + (size_t)m * DM, X1B + (size_t)m * DM, X1Q + (size_t)m * DM, lane);
        { GAS v4u* gz = (GAS v4u*)GD; const v4u z = {0u, 0u, 0u, 0u}; for (size_t i = (size_t)blockIdx.x * 512 + tid; i < (size_t)S * 16384 / 16; i += (size_t)G * 512) gz[i] = z; }
        if (BOTH(7)) xcd_barrier(bar);
    }
    if (IN(8)) {
        pg8::Gemm g{X1B, WQ, X1B, WQ, S, 2048, DM, 0}; pg8::StaticOrder So; So.init(S, 2048, G, (int)blockIdx.x);
        pg8::EpiStoreBf16 E{PQ, 2048};
        pg8::gemm_phase<pg8::EpiStoreBf16, pg8::StaticOrder, true, true>(lds, g, So, E, wave);
        if (BOTH(8)) xcd_barrier(bar);
    }
    if (IN(9)) {
#pragma nounroll
        for (int b = (int)blockIdx.x; b < S / 32; b += G) rt::route_block(b * 32, PQ, KEYSB, (unsigned char*)GD, nullptr, nullptr, (LAS char*)lds, wave);
        if (BOTH(9)) xcd_barrier(bar);
    }
    if (IN(10)) {
        pg8::Gemm g{(const bf16*)X1Q, UB, (const bf16*)X1Q, UB, S, 16384, DM / 2, (int)(0x01010101u * (127 - 6))}; pg8::StaticOrder So; So.init(S, 16384, G, (int)blockIdx.x);
        pg8::EpiPeerAct E{(unsigned char*)GD};
        pg8::gemm_phase<pg8::EpiPeerAct, pg8::StaticOrder, true, true, true>(lds, g, So, E, wave);
        if (BOTH(10)) xcd_barrier(bar);
    }
    if (IN(11)) {
        pg8::Gemm g{GD, VT, GD, VT, S, DM, 16384 / 2, (int)(0x01010101u * (127 - 9))}; pg8::StaticOrder So; So.init(S, DM, G, (int)blockIdx.x);
        pg8::EpiResF32 E{args.out, X1F, ALPHA};
        pg8::gemm_phase<pg8::EpiResF32, pg8::StaticOrder, true, true, true>(lds, g, So, E, wave);
        if (BOTH(11)) xcd_barrier(bar);
    }
    if (IN(12)) {
        for (int m = vcu * NWAVES + wave; m < S; m += G * NWAVES) ln_row(args.out + (size_t)m * DM, args.in[19], args.in[20], args.out + (size_t)m * DM, nullptr, nullptr, lane);
    }
#undef IN
#undef BOTH
#undef lane
#undef tid
#undef WINT
#undef XB
#undef PROJ
#undef MERGED
#undef X1B
#undef PQ
#undef GD
#undef WOA
#undef WOB
#undef WOUT
#undef WQ
#undef UB
#undef VT
#undef KEYSB
#undef X1F
#undef X1Q
#undef KMEANB
#undef YA
#undef YB
#undef OP0
#undef OP1
}

__global__ void shim_proj(const bf16* __restrict__ PROJ, float* __restrict__ ws) {
    const size_t U64 = (size_t)S * 2048;
    const size_t i = (size_t)blockIdx.x * blockDim.x + threadIdx.x; const int row = (int)(i / INW), col = (int)(i % INW);
    const float v = bf2f(PROJ[i]);
    if (col < 12288) { const int t = col >> 11, c = col & 2047; ws[(size_t)t * U64 + (size_t)row * 2048 + c] = v; }
    else { const int t = (col - 12288) >> 12, c = (col - 12288) & 4095; ws[(size_t)(6 + 2 * t) * U64 + (size_t)row * 4096 + c] = v; }
}

__global__ void shim_bf16_f32(const bf16* __restrict__ src, float* __restrict__ dst) { const size_t i = (size_t)blockIdx.x * blockDim.x + threadIdx.x; dst[i] = bf2f(src[i]); }
}

extern "C" void kernel_launch(void* const* d_in, const int* in_sizes, int n_in, void* d_out, int out_size, void* d_ws, size_t ws_size, hipStream_t stream) {
    if (ws_size < WS_NEED) return;
    static int grid = 0;
    if (grid == 0) {
        int dev = 0, cus = 0;
        if (hipGetDevice(&dev) != hipSuccess || hipDeviceGetAttribute(&cus, hipDeviceAttributeMultiprocessorCount, dev) != hipSuccess) { grid = -1; return; }
        if (hipFuncSetAttribute((const void*)mega_fwd, hipFuncAttributeMaxDynamicSharedMemorySize, LDS_BYTES) != hipSuccess) { grid = -1; return; }
        grid = cus;
    }
    if (grid < 0) return;
    (void)hipMemsetAsync((char*)d_ws + WS_CTL, 0, CTL_ZERO_BYTES, stream);
    Args a{};
    for (int i = 0; i < 21; ++i) a.in[i] = (const float*)d_in[i];
    a.out = (float*)d_out; a.ws = (unsigned char*)d_ws;
    const int cuts[] = {0, 13};
    for (int li = 0; li + 1 < (int)(sizeof(cuts) / sizeof(int)); ++li) { a.ph_lo = cuts[li]; a.ph_hi = cuts[li + 1];
        hipLaunchKernelGGL(mega_fwd, dim3(grid), dim3(NWAVES * 64), LDS_BYTES, stream, a); }
}
```

```cpp
#include <hip/hip_runtime.h>
#include <math.h>
#include <cstdio>
#include <cstdint>

namespace {
constexpr int S = 8192, DM = 4096, INW = 20480;
constexpr float SCALE = 0.08838834764831845f;
constexpr float ALPHA = 1.189207115002721f;
constexpr float LN_EPS = 1e-5f;
constexpr float LAMBDA_INIT = 0.2f;
typedef float f32x16 __attribute__((ext_vector_type(16)));

__device__ __forceinline__ int t5_bucket(int n) {
    if (n < 16) return n;
    int b = 16;
    b += (n >= 19); b += (n >= 21); b += (n >= 24); b += (n >= 27); b += (n >= 31); b += (n >= 35); b += (n >= 40); b += (n >= 46);
    b += (n >= 52); b += (n >= 59); b += (n >= 67); b += (n >= 77); b += (n >= 87); b += (n >= 99); b += (n >= 113);
    return b;
}

__global__ void __launch_bounds__(256) gemm_f32(const float* __restrict__ A, int lda, const float* __restrict__ B, int ldb, float* __restrict__ C, int ldc, int K,
                                                const float* __restrict__ R, int ldr, float alpha) {
    __shared__ float As[16][132];
    __shared__ float Bs[16][132];
    const int tid = threadIdx.x, lane = tid & 63, wid = tid >> 6, wm = wid >> 1, wn = wid & 1;
    const int m0 = blockIdx.y * 128, n0 = blockIdx.x * 128;
    f32x16 acc[2][2];
    for (int i = 0; i < 2; ++i) for (int j = 0; j < 2; ++j) for (int r = 0; r < 16; ++r) acc[i][j][r] = 0.f;
    for (int k0 = 0; k0 < K; k0 += 16) {
        for (int i = 0; i < 2; ++i) {
            const int idx = tid + i * 256;
            const int r = idx >> 2, c4 = idx & 3;
            const float4 v = *(const float4*)(A + (size_t)(m0 + r) * lda + k0 + c4 * 4);
            As[c4 * 4 + 0][r] = v.x; As[c4 * 4 + 1][r] = v.y; As[c4 * 4 + 2][r] = v.z; As[c4 * 4 + 3][r] = v.w;
            const int kr = idx >> 5, cb = idx & 31;
            const float4 w = *(const float4*)(B + (size_t)(k0 + kr) * ldb + n0 + cb * 4);
            *(float4*)&Bs[kr][cb * 4] = w;
        }
        __syncthreads();
        for (int kk = 0; kk < 16; kk += 2) {
            float a[2], b[2];
            for (int i = 0; i < 2; ++i) a[i] = As[kk + (lane >> 5)][wm * 64 + i * 32 + (lane & 31)];
            for (int j = 0; j < 2; ++j) b[j] = Bs[kk + (lane >> 5)][wn * 64 + j * 32 + (lane & 31)];
            for (int i = 0; i < 2; ++i) for (int j = 0; j < 2; ++j) acc[i][j] = __builtin_amdgcn_mfma_f32_32x32x2f32(a[i], b[j], acc[i][j], 0, 0, 0);
        }
        __syncthreads();
    }
    for (int i = 0; i < 2; ++i) for (int j = 0; j < 2; ++j) for (int r = 0; r < 16; ++r) {
        const int row = m0 + wm * 64 + i * 32 + (r & 3) + 8 * (r >> 2) + 4 * (lane >> 5);
        const int col = n0 + wn * 64 + j * 32 + (lane & 31);
        float v = acc[i][j][r];
        if (R) v += alpha * R[(size_t)row * ldr + col];
        C[(size_t)row * ldc + col] = v;
    }
}

__global__ void transpose_f32(const float* __restrict__ in, int ld_in, float* __restrict__ out, int ld_out) {
    __shared__ float tile[32][33];
    const int tx = threadIdx.x & 31, ty = threadIdx.x >> 5;
    const int r0 = blockIdx.y * 32, c0 = blockIdx.x * 32;
    for (int i = ty; i < 32; i += 8) tile[i][tx] = in[(size_t)(r0 + i) * ld_in + c0 + tx];
    __syncthreads();
    for (int i = ty; i < 32; i += 8) out[(size_t)(c0 + i) * ld_out + r0 + tx] = tile[tx][i];
}

__global__ void kmean_kernel(const float* __restrict__ mk, float* __restrict__ kmean) {
    const int j = blockIdx.x, h = blockIdx.y, d = threadIdx.x;
    float s = 0.f;
    for (int i = 0; i < 256; ++i) s += mk[(size_t)(j * 256 + i) * 2048 + h * 128 + d];
    kmean[(h * 32 + j) * 128 + d] = s * (1.0f / 256.0f);
}

__device__ __forceinline__ float block_reduce(float v, float* red, bool is_max) {
    const int t = threadIdx.x;
    for (int o = 32; o >= 1; o >>= 1) { const float w = __shfl_xor(v, o); v = is_max ? fmaxf(v, w) : v + w; }
    __syncthreads();
    if ((t & 63) == 0) red[t >> 6] = v;
    __syncthreads();
    float r = red[0];
    for (int i = 1; i < (int)(blockDim.x >> 6); ++i) r = is_max ? fmaxf(r, red[i]) : r + red[i];
    __syncthreads();
    return r;
}

__global__ void __launch_bounds__(256) moba_naive(const float* __restrict__ mq, const float* __restrict__ mkT, const float* __restrict__ mv, const float* __restrict__ kmean,
                                                  const float* __restrict__ rel_bias, float* __restrict__ ya) {
    const int q = blockIdx.x, h = blockIdx.y, t = threadIdx.x;
    __shared__ float qs[128]; __shared__ float gate[32]; __shared__ int blk[4]; __shared__ int okf[4]; __shared__ float sc[1024]; __shared__ float red[8]; __shared__ float biasl[32];
    __shared__ float part[256];
    if (t < 128) qs[t] = mq[(size_t)q * 2048 + h * 128 + t];
    if (t < 32) biasl[t] = rel_bias[t * 24 + h];
    __syncthreads();
    const int qb = q >> 8;
    if (t < 32) { float g = -1e30f; if (t < qb) { g = 0.f; const float* km = kmean + (h * 32 + t) * 128; for (int d = 0; d < 128; ++d) g += qs[d] * km[d]; } gate[t] = g; }
    __syncthreads();
    if (t == 0) {
        unsigned used = 0;
        for (int r = 0; r < 3; ++r) { int best = -1; for (int j = 0; j < 32; ++j) if (!((used >> j) & 1u) && (best < 0 || gate[j] > gate[best])) best = j;
            used |= 1u << best; blk[r] = best; okf[r] = best < qb ? 1 : 0; }
        blk[3] = qb; okf[3] = 1;
    }
    __syncthreads();
    float lmax = -1e30f;
    for (int r = 0; r < 4; ++r) {
        const int kpos = blk[r] * 256 + t, dist = q - kpos; float s = -1e30f;
        if (okf[r] && dist >= 0) { float dot = 0.f; const float* kp = mkT + (size_t)(h * 128) * S + kpos; for (int d = 0; d < 128; ++d) dot += qs[d] * kp[(size_t)d * S];
            s = dot * SCALE + biasl[t5_bucket(dist)]; }
        sc[r * 256 + t] = s; lmax = fmaxf(lmax, s);
    }
    const float mx = block_reduce(lmax, red, true);
    float lsum = 0.f;
    for (int r = 0; r < 4; ++r) { const float e = expf(sc[r * 256 + t] - mx); sc[r * 256 + t] = e; lsum += e; }
    const float sum = block_reduce(lsum, red, false);
    const int d = t & 127, half = t >> 7; float a = 0.f;
    for (int i = half * 512; i < half * 512 + 512; ++i) { const float p = sc[i]; if (p != 0.f) { const int kpos = blk[i >> 8] * 256 + (i & 255); a += p * mv[(size_t)kpos * 2048 + h * 128 + d]; } }
    part[t] = a; __syncthreads();
    if (t < 128) ya[(size_t)q * 2048 + h * 128 + t] = (part[t] + part[t + 128]) / sum;
}

__global__ void __launch_bounds__(256) diff_naive(const float* __restrict__ dq, const float* __restrict__ dkT, const float* __restrict__ dv, const float* __restrict__ rel_bias,
                                                  const float* __restrict__ lq1, const float* __restrict__ lk1, const float* __restrict__ lq2, const float* __restrict__ lk2,
                                                  const float* __restrict__ subln_g, float* __restrict__ yb) {
    __shared__ float sc[S];
    __shared__ float qs[256]; __shared__ float red[8]; __shared__ float biasl[32]; __shared__ float lamsh;
    const int q = blockIdx.x, h = blockIdx.y, t = threadIdx.x;
    qs[t] = dq[(size_t)q * 2048 + h * 256 + t];
    if (t < 32) biasl[t] = rel_bias[t * 24 + 16 + h];
    if (t == 0) { float a = 0.f, b = 0.f; for (int d = 0; d < 128; ++d) { a += lq1[d] * lk1[d]; b += lq2[d] * lk2[d]; } lamsh = expf(a) - expf(b) + LAMBDA_INIT; }
    __syncthreads();
    const float lam = lamsh; const int nk = q + 1;
    float acc = 0.f;
    for (int mp = 0; mp < 2; ++mp) {
        float lmax = -1e30f;
        for (int kpos = t; kpos < nk; kpos += 256) { float dot = 0.f; const float* kp = dkT + (size_t)(h * 256 + mp * 128) * S + kpos;
            for (int d = 0; d < 128; ++d) dot += qs[mp * 128 + d] * kp[(size_t)d * S];
            const float s = dot * SCALE + biasl[t5_bucket(q - kpos)]; sc[kpos] = s; lmax = fmaxf(lmax, s); }
        const float mx = block_reduce(lmax, red, true);
        float lsum = 0.f;
        for (int kpos = t; kpos < nk; kpos += 256) { const float e = expf(sc[kpos] - mx); sc[kpos] = e; lsum += e; }
        const float inv = 1.0f / block_reduce(lsum, red, false);
        float a = 0.f;
        for (int i = 0; i < nk; ++i) a += sc[i] * dv[(size_t)i * 2048 + h * 256 + t];
        acc += (mp == 0 ? inv : -lam * inv) * a;
        __syncthreads();
    }
    const float ss = block_reduce(acc * acc, red, false);
    yb[(size_t)q * 2048 + h * 256 + t] = acc * rsqrtf(ss * (1.0f / 256.0f) + LN_EPS) * subln_g[t] * (1.0f - LAMBDA_INIT);
}

__global__ void merge_kernel(const float* __restrict__ ga, const float* __restrict__ gb, const float* __restrict__ gate_b, const float* __restrict__ ta, const float* __restrict__ tb, float* __restrict__ merged) {
    const size_t i = (size_t)blockIdx.x * blockDim.x + threadIdx.x; const int c = (int)(i & (DM - 1));
    const float a = 1.0f / (1.0f + expf(-(ga[i] + gate_b[c]))), b = 1.0f / (1.0f + expf(-(gb[i] + gate_b[DM + c])));
    merged[i] = a * ta[i] + b * tb[i];
}

__global__ void __launch_bounds__(256) ln_kernel(const float* __restrict__ in, const float* __restrict__ g, const float* __restrict__ b, float* __restrict__ out) {
    __shared__ float red[8];
    const int row = blockIdx.x, t = threadIdx.x; float v[16]; float s = 0.f;
    for (int i = 0; i < 16; ++i) { v[i] = in[(size_t)row * DM + i * 256 + t]; s += v[i]; }
    const float mu = block_reduce(s, red, false) * (1.0f / DM); float q = 0.f;
    for (int i = 0; i < 16; ++i) { v[i] -= mu; q += v[i] * v[i]; }
    const float rstd = rsqrtf(block_reduce(q, red, false) * (1.0f / DM) + LN_EPS);
    for (int i = 0; i < 16; ++i) out[(size_t)row * DM + i * 256 + t] = v[i] * rstd * g[i * 256 + t] + b[i * 256 + t];
}

__global__ void __launch_bounds__(256) peer_route_naive(const float* __restrict__ pq, const float* __restrict__ keys1, const float* __restrict__ keys2, int* __restrict__ eidx, float* __restrict__ gates) {
    __shared__ float qh[256]; __shared__ float sc[2][128]; __shared__ float tv[2][16]; __shared__ int ti[2][16];
    const int tok = blockIdx.x, t = threadIdx.x;
    for (int h = 0; h < 8; ++h) {
        qh[t] = pq[(size_t)tok * 2048 + h * 256 + t];
        __syncthreads();
        { const int side = t >> 7, k = t & 127; const float* kr = (side ? keys2 : keys1) + k * 128; float d = 0.f; for (int i = 0; i < 128; ++i) d += qh[side * 128 + i] * kr[i]; sc[side][k] = d; }
        __syncthreads();
        if (t == 0 || t == 128) { const int side = t >> 7; unsigned used[4] = {0, 0, 0, 0};
            for (int r = 0; r < 16; ++r) { int best = -1; for (int j = 0; j < 128; ++j) if (!((used[j >> 5] >> (j & 31)) & 1u) && (best < 0 || sc[side][j] > sc[side][best])) best = j;
                used[best >> 5] |= 1u << (best & 31); tv[side][r] = sc[side][best]; ti[side][r] = best; } }
        __syncthreads();
        if (t == 0) { unsigned used[8] = {0, 0, 0, 0, 0, 0, 0, 0}; float ts[16]; int tp[16];
            for (int r = 0; r < 16; ++r) { int best = -1; float bv = 0.f; for (int j = 0; j < 256; ++j) { if ((used[j >> 5] >> (j & 31)) & 1u) continue; const float c = tv[0][j >> 4] + tv[1][j & 15]; if (best < 0 || c > bv) { best = j; bv = c; } }
                used[best >> 5] |= 1u << (best & 31); ts[r] = bv; tp[r] = best; }
            float sum = 0.f; const float tmax = ts[0]; for (int r = 0; r < 16; ++r) { ts[r] = expf(ts[r] - tmax); sum += ts[r]; }
            for (int r = 0; r < 16; ++r) { eidx[(size_t)tok * 128 + h * 16 + r] = ti[0][tp[r] >> 4] * 128 + ti[1][tp[r] & 15]; gates[(size_t)tok * 128 + h * 16 + r] = ts[r] / sum; } }
        __syncthreads();
    }
}

__global__ void __launch_bounds__(256) peer_expert_naive(const float* __restrict__ x1, const int* __restrict__ eidx, const float* __restrict__ gates, const float* __restrict__ U, const float* __restrict__ V,
                                                         const float* __restrict__ g2, const float* __restrict__ b2, float* __restrict__ out) {
    __shared__ float xs[DM]; __shared__ float wts[128]; __shared__ int es[128]; __shared__ float red[8];
    const int tok = blockIdx.x, t = threadIdx.x, lane = t & 63, wid = t >> 6;
    for (int i = t; i < DM; i += 256) xs[i] = x1[(size_t)tok * DM + i];
    if (t < 128) es[t] = eidx[(size_t)tok * 128 + t];
    __syncthreads();
    for (int e = wid; e < 128; e += 4) { const float* u = U + (size_t)es[e] * DM; float d = 0.f;
        for (int j = 0; j < 16; ++j) { const float4 w = *(const float4*)(u + j * 256 + lane * 4); const float* xp = xs + j * 256 + lane * 4; d += w.x * xp[0] + w.y * xp[1] + w.z * xp[2] + w.w * xp[3]; }
        for (int o = 32; o >= 1; o >>= 1) d += __shfl_xor(d, o);
        if (lane == 0) wts[e] = gates[(size_t)tok * 128 + e] * 0.5f * d * (1.0f + erff(d * 0.7071067811865476f)); }
    __syncthreads();
    float acc[16];
    for (int i = 0; i < 16; ++i) acc[i] = 0.f;
    for (int e = 0; e < 128; ++e) { const float w = wts[e]; const float* v = V + (size_t)es[e] * DM; for (int i = 0; i < 16; ++i) acc[i] += w * v[i * 256 + t]; }
    float s = 0.f;
    for (int i = 0; i < 16; ++i) { acc[i] += ALPHA * xs[i * 256 + t]; s += acc[i]; }
    const float mu = block_reduce(s, red, false) * (1.0f / DM); float qq = 0.f;
    for (int i = 0; i < 16; ++i) { acc[i] -= mu; qq += acc[i] * acc[i]; }
    const float rstd = rsqrtf(block_reduce(qq, red, false) * (1.0f / DM) + LN_EPS);
    for (int i = 0; i < 16; ++i) out[(size_t)tok * DM + i * 256 + t] = acc[i] * rstd * g2[i * 256 + t] + b2[i * 256 + t];
}

void gemm(hipStream_t st, const float* A, int lda, const float* B, int ldb, float* C, int ldc, int M, int N, int K, const float* R = nullptr, int ldr = 0, float alpha = 0.f) {
    hipLaunchKernelGGL(gemm_f32, dim3(N / 128, M / 128), dim3(256), 0, st, A, lda, B, ldb, C, ldc, K, R, ldr, alpha);
}
#define GAS __attribute__((address_space(1)))
#define LAS __attribute__((address_space(3)))
typedef unsigned short bf16;
typedef unsigned v4u __attribute__((ext_vector_type(4)));
typedef unsigned v2u __attribute__((ext_vector_type(2)));
typedef float f32x4 __attribute__((ext_vector_type(4)));
typedef short bf16x8 __attribute__((ext_vector_type(8)));
typedef GAS unsigned gu32;
#define RLX_AGENT __ATOMIC_RELAXED, __HIP_MEMORY_SCOPE_AGENT
#define LDS_WAIT() asm volatile("s_waitcnt lgkmcnt(0)" ::: "memory")
#define VM_WAIT() asm volatile("s_waitcnt vmcnt(0)" ::: "memory")
__device__ __forceinline__ int lane_id() { int r; asm volatile("v_mbcnt_lo_u32_b32 %0, -1, 0\n\tv_mbcnt_hi_u32_b32 %0, -1, %0" : "=v"(r)); return r; }
__device__ __forceinline__ unsigned f2bf(float f) { unsigned u = __builtin_bit_cast(unsigned, f); return (u + 0x7fffu + ((u >> 16) & 1u)) >> 16; }
__device__ __forceinline__ unsigned pk2(float lo, float hi) { return f2bf(lo) | (f2bf(hi) << 16); }
__device__ __forceinline__ float bf2f(unsigned short b) { return __builtin_bit_cast(float, (unsigned)b << 16); }
__device__ __forceinline__ float bflo(unsigned w) { return __builtin_bit_cast(float, w << 16); }
__device__ __forceinline__ float bfhi(unsigned w) { return __builtin_bit_cast(float, w & 0xffff0000u); }

namespace pg8 {
#define PG8_LAS __attribute__((address_space(3)))
typedef unsigned short bf16_t;
typedef short bf16x8 __attribute__((ext_vector_type(8)));
typedef float f32x4 __attribute__((ext_vector_type(4)));
typedef unsigned u32x4 __attribute__((ext_vector_type(4)));
constexpr int BM = 256, BK = 64, HALF = 128, HTB = HALF * BK * 2  , STAGE_BYTES = 8 * HTB, NXCD = 8, WGM = 8;

__host__ __device__ __forceinline__ int lds_byte(int r, int c) { const int st = (r >> 4) * 2 + (c >> 5), rr = r & 15, cc = c & 31, ob = rr * 64 + cc * 2; return st * 1024 + (ob ^ (((ob >> 9) & 1) << 5)); }
__host__ __device__ __forceinline__ void stage_rc(int b, int& R, int& C) { const int st = b / 1024, sb = b % 1024, swz = sb ^ (((sb >> 9) & 1) << 5); R = (st >> 1) * 16 + swz / 64; C = (st & 1) * 32 + (swz % 64) / 2; }
__host__ __device__ __forceinline__ int perm32(int rho) { const int n = rho >> 4, i = rho & 15; return 8 * (i >> 2) + 4 * n + (i & 3); }

struct Unit { int pm, pn, part; };
struct Gemm { const bf16_t* A; const bf16_t* Bt; const bf16_t* A2; const bf16_t* Bt2; int M, N, K; int sc; };

struct StaticOrder {
    int nM, nN, nwg, G, c;
    __host__ __device__ void init(int M, int N, int G_, int c_) { nM = M / BM; nN = N / BM; nwg = nM * nN; G = G_; c = c_; }
    __host__ __device__ bool next(int i, Unit& u) const {
        const long L = (long)i * G + c; if (L >= nwg) return false;
        int wgid = (int)L; { const int q = nwg / NXCD, r = nwg % NXCD, xcd = wgid % NXCD, off = wgid / NXCD; wgid = (xcd < r ? xcd * (q + 1) : r * (q + 1) + (xcd - r) * q) + off; }
        const int nig = WGM * nN, gid = wgid / nig, fm = gid * WGM, gsz = (nM - fm) < WGM ? (nM - fm) : WGM;
        u.pm = fm + ((wgid % nig) % gsz); u.pn = (wgid % nig) / gsz; u.part = 0; return true;
    }
    __device__ __forceinline__ void a_ready(const Unit&) const {}
    __device__ __forceinline__ void done(const Unit&) const {}
};


typedef int v4i_t __attribute__((ext_vector_type(4))); typedef int v8i_t __attribute__((ext_vector_type(8)));
__device__ __forceinline__ v8i_t cat8(bf16x8 a, bf16x8 b) { return __builtin_shufflevector(__builtin_bit_cast(v4i_t, a), __builtin_bit_cast(v4i_t, b), 0, 1, 2, 3, 4, 5, 6, 7); }
template <class Epi, class Sched, bool ALIGN_EPI = false, bool SP2 = false, bool F8 = false>
__device__ __forceinline__ void gemm_phase(PG8_LAS unsigned char* lds, const Gemm g, const Sched& S, const Epi& E, const int wave_id) {
    int lane_; asm volatile("v_mbcnt_lo_u32_b32 %0, -1, 0\n\tv_mbcnt_hi_u32_b32 %0, -1, %0" : "=v"(lane_));
    const int lane = lane_, wid = wave_id, tid = wid * 64 + lane, wr = wid >> 2, wc = wid & 3, fr = lane & 15, fq = lane >> 4;
    const int K = g.K, nt = K / BK;
    unsigned voffA[2], voffB[2];
#pragma unroll
    for (int i = 0; i < 2; ++i) { int R, C; stage_rc(tid * 16 + i * 8192, R, C); const int Rb = Epi::PERM ? ((R & ~31) + perm32(R & 31)) : R;
        voffA[i] = (unsigned)(R * K + C) * 2u; voffB[i] = (unsigned)(Rb * K + C) * 2u; }
    const size_t kstep = (size_t)(BK * 2);
    const size_t rstep64 = (size_t)64 * K * 2;
    const size_t hstep = (size_t)HALF * K * 2;
    const size_t tstep = 2 * hstep;
    const unsigned ldsw = (unsigned)wid * 1024u;
    const int aoff = lds_byte(wr * 64 + fr, fq * 8), boff = lds_byte(wc * 32 + fr, fq * 8);
#define PG8_SA(b, h) (((b) * 2 + (h)) * HTB)
#define PG8_SB(b, h) ((4 + (b) * 2 + (h)) * HTB)
#define PG8_STAGE(bufoff, gbase, voff) do { _Pragma("unroll") for (int _i = 0; _i < 2; ++_i) \
        __builtin_amdgcn_global_load_lds((const unsigned*)((const char*)(gbase) + (size_t)_i * rstep64 + (voff)[0]), (PG8_LAS unsigned*)(lds + (bufoff) + ldsw + _i * 8192), 16, 0, 0); } while (0)
#define PG8_LDA(dst, b, h) do { _Pragma("unroll") for (int m = 0; m < 4; ++m) _Pragma("unroll") for (int k = 0; k < 2; ++k) dst[m][k] = *(const PG8_LAS bf16x8*)(lds + PG8_SA(b, h) + aoff + m * 2048 + k * 1024); } while (0)
#define PG8_LDB(dst, b, h) do { _Pragma("unroll") for (int n = 0; n < 2; ++n) _Pragma("unroll") for (int k = 0; k < 2; ++k) dst[n][k] = *(const PG8_LAS bf16x8*)(lds + PG8_SB(b, h) + boff + n * 2048 + k * 1024); } while (0)
#define PG8_MMA(ai, bj, At, Bt) do { __builtin_amdgcn_s_setprio(1); if constexpr (F8) { _Pragma("unroll") for (int m = 0; m < 4; ++m) _Pragma("unroll") for (int n = 0; n < 2; ++n) \
        acc[ai][bj][m][n] = __builtin_amdgcn_mfma_scale_f32_16x16x128_f8f6f4(cat8(Bt[n][0], Bt[n][1]), cat8(At[m][0], At[m][1]), acc[ai][bj][m][n], 0, 0, 0, g.sc, 0, 0x7f7f7f7f); } else { \
        _Pragma("unroll") for (int m = 0; m < 4; ++m) _Pragma("unroll") for (int n = 0; n < 2; ++n) _Pragma("unroll") for (int k = 0; k < 2; ++k) \
        acc[ai][bj][m][n] = __builtin_amdgcn_mfma_f32_16x16x32_bf16(Bt[n][k], At[m][k], acc[ai][bj][m][n], 0, 0, 0); } __builtin_amdgcn_s_setprio(0); } while (0)
#define PG8_WAIT_V(n) asm volatile("s_waitcnt vmcnt(" #n ")" ::: "memory")
#define PG8_WAIT_L(n) asm volatile("s_waitcnt lgkmcnt(" #n ")" ::: "memory")
#define PG8_BAR __builtin_amdgcn_s_barrier()
#define PG8_SCHED __builtin_amdgcn_sched_barrier(0)
    Unit cur, nxt; int ui = 0;
    if (!S.next(0, cur)) return;
    f32x4 acc[2][2][4][2];
#pragma unroll
    for (int a = 0; a < 2; ++a)
#pragma unroll
        for (int b = 0; b < 2; ++b)
#pragma unroll
            for (int m = 0; m < 4; ++m)
#pragma unroll
                for (int n = 0; n < 2; ++n) acc[a][b][m][n] = (f32x4){0.f, 0.f, 0.f, 0.f};
    bf16x8 At[4][2], B0[2][2], B1[2][2];
    const char* cA = (const char*)(cur.part ? g.A2 : g.A) + (size_t)cur.pm * tstep; const char* cB = (const char*)(cur.part ? g.Bt2 : g.Bt) + (size_t)cur.pn * tstep;
    S.a_ready(cur);
    if constexpr (SP2) {
        PG8_STAGE(PG8_SB(0, 0), cB, voffB); PG8_STAGE(PG8_SB(0, 1), cB + hstep, voffB); PG8_STAGE(PG8_SA(0, 0), cA, voffA); PG8_STAGE(PG8_SA(0, 1), cA + hstep, voffA);
        if (wr == 1) PG8_BAR;
        PG8_WAIT_V(2); PG8_BAR;
        PG8_STAGE(PG8_SB(1, 0), cB + kstep, voffB); PG8_STAGE(PG8_SA(1, 0), cA + kstep, voffA); PG8_STAGE(PG8_SB(1, 1), cB + hstep + kstep, voffB);
        PG8_WAIT_V(6); PG8_BAR;
    } else {
        PG8_STAGE(PG8_SB(0, 0), cB, voffB); PG8_STAGE(PG8_SA(0, 0), cA, voffA); PG8_STAGE(PG8_SB(0, 1), cB + hstep, voffB); PG8_STAGE(PG8_SA(0, 1), cA + hstep, voffA);
        if (wr == 1) PG8_BAR;
        PG8_WAIT_V(4); PG8_BAR;
        PG8_STAGE(PG8_SB(1, 0), cB + kstep, voffB); PG8_STAGE(PG8_SA(1, 0), cA + kstep, voffA); PG8_STAGE(PG8_SB(1, 1), cB + hstep + kstep, voffB);
        PG8_WAIT_V(6); PG8_BAR;
    }
    for (;;) {
        const bool has_next = S.next(ui + 1, nxt);
        const char* nA = has_next ? (const char*)(nxt.part ? g.A2 : g.A) + (size_t)nxt.pm * tstep : cA; const char* nB = has_next ? (const char*)(nxt.part ? g.Bt2 : g.Bt) + (size_t)nxt.pn * tstep : cB;
        for (int t = 0; t < nt; t += 2) {
            const bool last = (t == nt - 2);
            const char* a1 = cA + (size_t)(t + 1) * kstep;
            const char* a2 = last ? nA : cA + (size_t)(t + 2) * kstep; const char* b2 = last ? nB : cB + (size_t)(t + 2) * kstep;
            const char* a3 = a2 + kstep; const char* b3 = b2 + kstep;
            if (last && has_next) S.a_ready(nxt);
            if constexpr (SP2) {
            PG8_LDB(B0, 0, 0); PG8_LDB(B1, 0, 1); PG8_SCHED; PG8_LDA(At, 0, 0); PG8_STAGE(PG8_SA(1, 1), a1 + hstep, voffA);
            PG8_WAIT_V(8); PG8_WAIT_L(0); PG8_BAR; PG8_MMA(0, 0, At, B0); PG8_MMA(0, 1, At, B1); PG8_BAR; PG8_SCHED;
            PG8_LDA(At, 0, 1); PG8_STAGE(PG8_SB(0, 0), b2, voffB); PG8_STAGE(PG8_SB(0, 1), b2 + hstep, voffB); PG8_STAGE(PG8_SA(0, 0), a2, voffA);
            PG8_WAIT_V(8); PG8_WAIT_L(0); PG8_BAR; PG8_MMA(1, 0, At, B0); PG8_MMA(1, 1, At, B1); PG8_BAR; PG8_SCHED;
            PG8_LDB(B0, 1, 0); PG8_LDB(B1, 1, 1); PG8_SCHED; PG8_LDA(At, 1, 0); PG8_STAGE(PG8_SA(0, 1), a2 + hstep, voffA);
            PG8_WAIT_V(8); PG8_WAIT_L(0); PG8_BAR; PG8_MMA(0, 0, At, B0); PG8_MMA(0, 1, At, B1); PG8_BAR; PG8_SCHED;
            PG8_LDA(At, 1, 1); PG8_STAGE(PG8_SB(1, 0), b3, voffB); PG8_STAGE(PG8_SB(1, 1), b3 + hstep, voffB); PG8_STAGE(PG8_SA(1, 0), a3, voffA);
            PG8_WAIT_V(8); PG8_WAIT_L(0); PG8_BAR; PG8_MMA(1, 0, At, B0); PG8_MMA(1, 1, At, B1); PG8_BAR; PG8_SCHED;
            } else {
            PG8_LDB(B0, 0, 0); PG8_SCHED; PG8_LDA(At, 0, 0); PG8_STAGE(PG8_SA(1, 1), a1 + hstep, voffA);
            PG8_WAIT_L(8); PG8_BAR; PG8_WAIT_L(0); PG8_MMA(0, 0, At, B0); PG8_BAR; PG8_SCHED;
            PG8_LDB(B1, 0, 1); PG8_STAGE(PG8_SB(0, 0), b2, voffB);
            PG8_BAR; PG8_WAIT_L(0); PG8_MMA(0, 1, At, B1); PG8_BAR;
            PG8_LDA(At, 0, 1); PG8_STAGE(PG8_SA(0, 0), a2, voffA);
            PG8_BAR; PG8_WAIT_L(0); PG8_MMA(1, 0, At, B0); PG8_BAR; PG8_SCHED;
            PG8_STAGE(PG8_SB(0, 1), b2 + hstep, voffB);
            PG8_WAIT_V(6); PG8_BAR; PG8_MMA(1, 1, At, B1); PG8_BAR;
            PG8_LDB(B0, 1, 0); PG8_SCHED; PG8_LDA(At, 1, 0); PG8_STAGE(PG8_SA(0, 1), a2 + hstep, voffA);
            PG8_WAIT_L(8); PG8_BAR; PG8_WAIT_L(0); PG8_MMA(0, 0, At, B0); PG8_BAR; PG8_SCHED;
            PG8_LDB(B1, 1, 1); PG8_STAGE(PG8_SB(1, 0), b3, voffB);
            PG8_BAR; PG8_WAIT_L(0); PG8_MMA(0, 1, At, B1); PG8_BAR;
            PG8_LDA(At, 1, 1); PG8_STAGE(PG8_SA(1, 0), a3, voffA);
            PG8_BAR; PG8_WAIT_L(0); PG8_MMA(1, 0, At, B0); PG8_BAR; PG8_SCHED;
            PG8_STAGE(PG8_SB(1, 1), b3 + hstep, voffB);
            PG8_WAIT_V(6); PG8_BAR; PG8_MMA(1, 1, At, B1); PG8_BAR;
            }
        }
        if constexpr (ALIGN_EPI) { if (wr == 0) PG8_BAR; }
        if constexpr (!Epi::AFTER_DRAIN) { int l_; asm volatile("v_mbcnt_lo_u32_b32 %0, -1, 0\n\tv_mbcnt_hi_u32_b32 %0, -1, %0" : "=v"(l_));
            E(acc, cur, wr, wc, l_ & 15, l_ >> 4); S.done(cur); }
        if (!has_next) break;
#pragma unroll
        for (int a = 0; a < 2; ++a)
#pragma unroll
            for (int b = 0; b < 2; ++b)
#pragma unroll
                for (int m = 0; m < 4; ++m)
#pragma unroll
                    for (int n = 0; n < 2; ++n) acc[a][b][m][n] = (f32x4){0.f, 0.f, 0.f, 0.f};
        cur = nxt; cA = nA; cB = nB; ++ui;
        if constexpr (ALIGN_EPI) { if (wr == 1) PG8_BAR; }
    }
    PG8_WAIT_V(0);
    if constexpr (!ALIGN_EPI) { if (wr == 0) PG8_BAR; }
    PG8_BAR;
    if constexpr (Epi::AFTER_DRAIN) { E.fused(acc, cur, wr, wc, fr, fq, lds, wid, lane); S.done(cur); }
#undef PG8_SA
#undef PG8_SB
#undef PG8_STAGE
#undef PG8_LDA
#undef PG8_LDB
#undef PG8_MMA
#undef PG8_WAIT_V
#undef PG8_WAIT_L
#undef PG8_BAR
#undef PG8_SCHED
}
}

#define XB_TMO      128
#define XB_XCNT(j)  (256  + 64 * (j))
#define XB_XSUB(j)  (1280 + 64 * (j))
#define XB_XGEN(j)  (2304 + 64 * (j))
#define XB_TOP      3328
#define XB_TOPGEN   3392
#define XCD_BAR_WORDS 3456
#define XB_SPIN_CAP (1u << 18)

__device__ __forceinline__ unsigned xb_ld(unsigned* p)              { return __hip_atomic_load(p, __ATOMIC_RELAXED, __HIP_MEMORY_SCOPE_AGENT); }
__device__ __forceinline__ unsigned xb_add(unsigned* p, unsigned v) { return __hip_atomic_fetch_add(p, v, __ATOMIC_RELAXED, __HIP_MEMORY_SCOPE_AGENT); }
__device__ __forceinline__ unsigned xb_xcc_id() { return (unsigned)__builtin_amdgcn_s_getreg((3 << 11) | 20) & 0xFu; }
#define XB_SPIN(cond, bar) do { unsigned _sp = 0; while (cond) { __builtin_amdgcn_s_sleep(1); \
    if ((++_sp & 255u) == 0u) { if (xb_ld(&(bar)[XB_TMO])) break; if (_sp > XB_SPIN_CAP) { atomicAdd(&(bar)[XB_TMO], 1u); break; } } } } while (0)

struct XcdBarrier {
    unsigned* bar; unsigned x;
    volatile LAS unsigned* st;
};

__device__ __forceinline__ XcdBarrier xcd_barrier_post(unsigned* bar, volatile LAS unsigned* st) {
    XcdBarrier b; b.bar = bar; b.x = xb_xcc_id(); b.st = st;
    if (threadIdx.x == 0) (void)xb_add(&bar[XB_XCNT(b.x)], 1u);
    return b;
}
__device__ __forceinline__ void xcd_barrier_complete(unsigned* bar, unsigned x, unsigned& nloc, unsigned& nx) {
    const unsigned G = gridDim.x * gridDim.y * gridDim.z;
    unsigned sum, cnt, mine, sp = 0u;
    for (;;) {
        sum = 0u; cnt = 0u; mine = 0u;
#pragma unroll
        for (unsigned j = 0; j < 16; ++j) { const unsigned c = xb_ld(&bar[XB_XCNT(j)]); sum += c; cnt += (c > 0u) ? 1u : 0u; mine = (j == x) ? c : mine; }
        if (sum == G) break;
        __builtin_amdgcn_s_sleep(1);
        if ((++sp & 255u) == 0u) { if (xb_ld(&bar[XB_TMO])) break; if (sp > XB_SPIN_CAP) { atomicAdd(&bar[XB_TMO], 1u); break; } }
    }
    nloc = mine > 0u ? mine : 1u; nx = cnt > 0u ? cnt : 1u;
}

__device__ __forceinline__ void xcd_barrier(const XcdBarrier& b) {
    asm volatile("s_waitcnt vmcnt(0)" ::: "memory");
    __syncthreads();
    if (threadIdx.x == 0) {
        unsigned* bar = b.bar;
        __builtin_amdgcn_s_waitcnt(0);
        unsigned nloc = b.st[0], nx = b.st[1];
        if (nloc == 0u) { xcd_barrier_complete(bar, b.x, nloc, nx); b.st[0] = nloc; b.st[1] = nx; }
        const unsigned old = xb_add(&bar[XB_XSUB(b.x)], 1u);
        const unsigned gen = old / nloc;
        if (old + 1u == (gen + 1u) * nloc) {
            __builtin_amdgcn_fence(__ATOMIC_RELEASE, "agent");
            asm volatile("s_waitcnt vmcnt(0)" ::: "memory");
            const unsigned og = xb_add(&bar[XB_TOP], 1u);
            const unsigned tg = og / nx;
            if (og + 1u == (tg + 1u) * nx) xb_add(&bar[XB_TOPGEN], 1u);
            else XB_SPIN(xb_ld(&bar[XB_TOPGEN]) == tg, bar);
            __builtin_amdgcn_fence(__ATOMIC_ACQUIRE, "agent");
            xb_add(&bar[XB_XGEN(b.x)], 1u);
            asm volatile("s_waitcnt vmcnt(0)" ::: "memory");
        } else {
            XB_SPIN(xb_ld(&bar[XB_XGEN(b.x)]) == gen, bar);
            __builtin_amdgcn_fence(__ATOMIC_ACQUIRE, "agent");
            asm volatile("s_waitcnt vmcnt(0)" ::: "memory");
        }
    }
    __syncthreads();
}

constexpr int NWAVES = 8;
constexpr size_t MiB = 1u << 20;
constexpr int RING_BYTES = 131072, LDSCTL_OFF = RING_BYTES, MISC_OFF = LDSCTL_OFF + 320, LDS_BYTES = 147456;
constexpr int CW_BAR = 4096;
constexpr size_t CTL_ZERO_BYTES = 1 * MiB;

namespace pg8 {
__device__ __forceinline__ unsigned cvt_pk_bf16(float lo, float hi) { unsigned r; asm volatile("v_cvt_pk_bf16_f32 %0, %1, %2" : "=v"(r) : "v"(lo), "v"(hi)); return r; }
typedef float f32x2 __attribute__((ext_vector_type(2)));
struct EpiStoreBf16 {
    static constexpr bool PERM = true, AFTER_DRAIN = false;
    bf16_t* O; int ldc;
    __device__ __forceinline__ void operator()(const f32x4 (&acc)[2][2][4][2], const Unit& u, int wr, int wc, int fr, int fq) const {
        const int row0 = u.pm * BM + wr * 64 + fr, col0 = u.pn * BM + wc * 32 + 8 * fq;
#pragma unroll
        for (int ai = 0; ai < 2; ++ai)
#pragma unroll
            for (int m = 0; m < 4; ++m) { bf16_t* rowp = O + (size_t)(row0 + ai * HALF + m * 16) * ldc + col0;
#pragma unroll
                for (int bj = 0; bj < 2; ++bj) { const f32x4 v0 = acc[ai][bj][m][0], v1 = acc[ai][bj][m][1];
                    u32x4 w; w.x = cvt_pk_bf16(v0[0], v0[1]); w.y = cvt_pk_bf16(v0[2], v0[3]); w.z = cvt_pk_bf16(v1[0], v1[1]); w.w = cvt_pk_bf16(v1[2], v1[3]);
                    *(u32x4*)(rowp + bj * HALF) = w; } }
    }
};

struct EpiMerge {
    static constexpr bool PERM = true, AFTER_DRAIN = false;
    bf16_t* Mg; const bf16_t* proj; const float* gate_b;
    __device__ __forceinline__ void operator()(const f32x4 (&acc)[2][2][4][2], const Unit& u, int wr, int wc, int fr, int fq) const {
        const int row0 = u.pm * BM + wr * 64 + fr, col0 = u.pn * BM + wc * 32 + 8 * fq; const int part = u.part;
        const bf16_t* gsrc = proj + (part ? 16384 : 12288); const float* gbp = gate_b + (part ? 4096 : 0);
        f32x4 gbv[2][2];
#pragma unroll
        for (int bj = 0; bj < 2; ++bj)
#pragma unroll
            for (int n = 0; n < 2; ++n) gbv[bj][n] = *(const f32x4*)(gbp + col0 + bj * HALF + 4 * n);
#pragma unroll
        for (int ai = 0; ai < 2; ++ai)
#pragma unroll
            for (int m = 0; m < 4; ++m) { const int row = row0 + ai * HALF + m * 16;
#pragma unroll
                for (int bj = 0; bj < 2; ++bj) { const int col = col0 + bj * HALF;
                    const u32x4 gw = *(const u32x4*)(gsrc + (size_t)row * 20480 + col);
                    float z[8]; z[0] = __uint_as_float(gw.x << 16); z[1] = __uint_as_float(gw.x & 0xffff0000u); z[2] = __uint_as_float(gw.y << 16); z[3] = __uint_as_float(gw.y & 0xffff0000u);
                    z[4] = __uint_as_float(gw.z << 16); z[5] = __uint_as_float(gw.z & 0xffff0000u); z[6] = __uint_as_float(gw.w << 16); z[7] = __uint_as_float(gw.w & 0xffff0000u);
                    float v[8];
#pragma unroll
                    for (int k = 0; k < 8; ++k) { const float zz = z[k] + gbv[bj][k >> 2][k & 3]; const float sg = __builtin_amdgcn_rcpf(1.0f + __builtin_amdgcn_exp2f(-1.4426950408889634f * zz)); v[k] = sg * acc[ai][bj][m][k >> 2][k & 3]; }
                    bf16_t* dst = Mg + (size_t)row * 4096 + col;
                    if (part) { const u32x4 pw = *(const u32x4*)dst;
                        v[0] += __uint_as_float(pw.x << 16); v[1] += __uint_as_float(pw.x & 0xffff0000u); v[2] += __uint_as_float(pw.y << 16); v[3] += __uint_as_float(pw.y & 0xffff0000u);
                        v[4] += __uint_as_float(pw.z << 16); v[5] += __uint_as_float(pw.z & 0xffff0000u); v[6] += __uint_as_float(pw.w << 16); v[7] += __uint_as_float(pw.w & 0xffff0000u); }
                    u32x4 w; w.x = cvt_pk_bf16(v[0], v[1]); w.y = cvt_pk_bf16(v[2], v[3]); w.z = cvt_pk_bf16(v[4], v[5]); w.w = cvt_pk_bf16(v[6], v[7]);
                    *(u32x4*)dst = w; } }
    }
};
struct DualOrder : StaticOrder { __device__ bool next(int i, Unit& u) const { if (!StaticOrder::next(i >> 1, u)) return false; u.part = i & 1; return true; } };
struct EpiResF32 {
    static constexpr bool PERM = false, AFTER_DRAIN = false;
    float* C; const float* R; float alpha;
    __device__ __forceinline__ void operator()(const f32x4 (&acc)[2][2][4][2], const Unit& u, int wr, int wc, int fr, int fq) const {
        const int row0 = u.pm * BM + wr * 64 + fr, col0 = u.pn * BM + wc * 32 + 4 * fq;
#pragma unroll
        for (int ai = 0; ai < 2; ++ai)
#pragma unroll
            for (int m = 0; m < 4; ++m) { const size_t off = (size_t)(row0 + ai * HALF + m * 16) * 4096 + col0;
#pragma unroll
                for (int bj = 0; bj < 2; ++bj)
#pragma unroll
                    for (int n = 0; n < 2; ++n) { const f32x4 r = *(const f32x4*)(R + off + bj * HALF + n * 16); *(f32x4*)(C + off + bj * HALF + n * 16) = r * alpha + acc[ai][bj][m][n]; } }
    }
};
struct EpiPeerAct {
    static constexpr bool PERM = true, AFTER_DRAIN = false;
    unsigned char* Gd;
    __device__ __forceinline__ void operator()(const f32x4 (&acc)[2][2][4][2], const Unit& u, int wr, int wc, int fr, int fq) const {
        typedef unsigned u32x2v __attribute__((ext_vector_type(2)));
        const int row0 = u.pm * BM + wr * 64 + fr, col0 = u.pn * BM + wc * 32 + 8 * fq;
#pragma unroll
        for (int ai = 0; ai < 2; ++ai)
#pragma unroll
            for (int m = 0; m < 4; ++m) { unsigned char* rowp = Gd + (size_t)(row0 + ai * HALF + m * 16) * 16384 + col0;
#pragma unroll
                for (int bj = 0; bj < 2; ++bj) { const u32x2v gw = *(const u32x2v*)(rowp + bj * HALF);
                    if ((gw.x | gw.y) != 0u) {
                        float v[8];
#pragma unroll
                        for (int k = 0; k < 8; ++k) { const unsigned word = k < 4 ? gw.x : gw.y; const float gk = (k & 3) == 0 ? __builtin_amdgcn_cvt_f32_fp8((int)word, 0) : (k & 3) == 1 ? __builtin_amdgcn_cvt_f32_fp8((int)word, 1) : (k & 3) == 2 ? __builtin_amdgcn_cvt_f32_fp8((int)word, 2) : __builtin_amdgcn_cvt_f32_fp8((int)word, 3);
                            const float a = acc[ai][bj][m][k >> 2][k & 3]; v[k] = gk != 0.f ? __builtin_amdgcn_fmed3f(gk * 0.125f * a * (1.0f + erff(a * 0.7071067811865476f)), -448.f, 448.f) : 0.f; }
                        u32x2v w; int t0 = 0, t1 = 0; t0 = __builtin_amdgcn_cvt_pk_fp8_f32(v[0], v[1], t0, false); t0 = __builtin_amdgcn_cvt_pk_fp8_f32(v[2], v[3], t0, true);
                        t1 = __builtin_amdgcn_cvt_pk_fp8_f32(v[4], v[5], t1, false); t1 = __builtin_amdgcn_cvt_pk_fp8_f32(v[6], v[7], t1, true); w.x = (unsigned)t0; w.y = (unsigned)t1;
                        *(u32x2v*)(rowp + bj * HALF) = w; } } }
    }
};
}

__device__ __forceinline__ void p0_transpose_item(const float* W, int K, int N, bf16* WT, LAS float* scr, int item, int lane) {
    const int nblk = N / 32, kb = item / nblk, nb = item % nblk, k0 = 64 * kb, n0 = 32 * nb;
#pragma unroll 8
    for (int i = 0; i < 32; ++i) { const int kk = 2 * i + (lane >> 5); scr[kk * 33 + (lane & 31)] = W[(size_t)(k0 + kk) * N + n0 + (lane & 31)]; }
    LDS_WAIT(); asm volatile("" ::: "memory");
    const int c = lane & 7;
#pragma unroll
    for (int j = 0; j < 4; ++j) { const int n = (lane >> 3) + 8 * j; const LAS float* s = scr + (8 * c) * 33 + n;
        v4u o; o.x = pk2(s[0 * 33], s[1 * 33]); o.y = pk2(s[2 * 33], s[3 * 33]); o.z = pk2(s[4 * 33], s[5 * 33]); o.w = pk2(s[6 * 33], s[7 * 33]);
        *(GAS v4u*)(WT + (size_t)(n0 + n) * K + k0 + 8 * c) = o; }
    LDS_WAIT(); asm volatile("" ::: "memory");
}
__device__ __forceinline__ void p0_convert(const float* src, bf16* dst, size_t n8, size_t gtid, size_t gthreads) {
    for (size_t i = gtid; i < n8; i += gthreads) { const f32x4 a = *(const GAS f32x4*)(src + i * 8), b = *(const GAS f32x4*)(src + i * 8 + 4);
        v4u o; o.x = pk2(a.x, a.y); o.y = pk2(a.z, a.w); o.z = pk2(b.x, b.y); o.w = pk2(b.z, b.w); *(GAS v4u*)(dst + i * 8) = o; }
}

namespace att {
using s16x4  = __attribute__((ext_vector_type(4))) short;
using f32x16 = __attribute__((ext_vector_type(16))) float;
using u32x4  = __attribute__((ext_vector_type(4))) unsigned;
constexpr int NW = 8, QBLK = 32, KVBLK = 64, LDP = INW;
constexpr float LOG2E = 1.4426950408889634f, CQK = SCALE * LOG2E, THRL = 11.5f, NEGBIG = -1e30f;
constexpr int SHM_V = 16384, SHM_K = 16384;
constexpr int OFF_V = 0, OFF_K = 2 * SHM_V, OFF_WS = OFF_K + 2 * SHM_K, OFF_LUT = OFF_WS + NW * 64 * 4, OFF_GATE = OFF_LUT + 2176, GATE_W = 33 * 32 * 4, OFF_END = OFF_GATE + NW * GATE_W;
static_assert(OFF_END <= RING_BYTES, "attention LDS");
#define KSWZ(row, colB) ((row) * 256 + ((colB) ^ (((row) & 7) << 4)))
#define SBAR() __builtin_amdgcn_sched_barrier(0)
__device__ __forceinline__ int crow(int r, int hi) { return (r & 3) + 8 * (r >> 2) + 4 * hi; }
__device__ __forceinline__ unsigned cvtpk(float lo, float hi) { unsigned r; asm volatile("v_cvt_pk_bf16_f32 %0, %1, %2" : "=v"(r) : "v"(lo), "v"(hi)); return r; }

__device__ __forceinline__ void bias_far(f32x16& p0, f32x16& p1, float rowoff) {
#pragma unroll
  for (int r = 0; r < 16; ++r) { p0[r] = fmaf(p0[r], CQK, rowoff); p1[r] = fmaf(p1[r], CQK, rowoff); }
}
constexpr int LUT_DMAX = 207, LUT_N = 528;
__device__ __forceinline__ void bias_near(f32x16& p0, f32x16& p1, const LAS float* rl, int dist0  , int hi) {
  const LAS float* b = rl + (LUT_DMAX - dist0 + 4 * hi);
#pragma unroll
  for (int r = 0; r < 16; ++r) { const int c = (r & 3) + 8 * (r >> 2); p0[r] = fmaf(p0[r], CQK, b[c]); p1[r] = fmaf(p1[r], CQK, b[c + 32]); }
}
__device__ __forceinline__ void partialSM(f32x16& p0, f32x16& p1, float& m_reg, float& mn, float& alpha) {
  float pmax = p0[0];
#pragma unroll
  for (int r = 1; r < 16; ++r) pmax = fmaxf(pmax, p0[r]);
#pragma unroll
  for (int r = 0; r < 16; ++r) pmax = fmaxf(pmax, p1[r]);
  { auto rr = __builtin_amdgcn_permlane32_swap(__float_as_uint(pmax), __float_as_uint(pmax), false, false);
    pmax = fmaxf(__uint_as_float(rr[0]), __uint_as_float(rr[1])); }
  if (__builtin_expect(__all(pmax - m_reg <= THRL), 1)) { mn = m_reg; alpha = 1.f; }
  else { mn = fmaxf(m_reg, pmax); alpha = __builtin_amdgcn_exp2f(m_reg - mn); m_reg = mn; }
#pragma unroll
  for (int r = 0; r < 16; ++r) { p0[r] -= mn; p1[r] -= mn; }
#pragma unroll
  for (int r = 0; r < 16; ++r) p0[r] = __builtin_amdgcn_exp2f(p0[r]);
}
__device__ __forceinline__ void finishSM(f32x16& p0, f32x16& p1, float alpha, float& l_reg, bf16x8& pa0, bf16x8& pa1, bf16x8& pa2, bf16x8& pa3) {
#pragma unroll
  for (int r = 0; r < 16; ++r) p1[r] = __builtin_amdgcn_exp2f(p1[r]);
  float ps = 0;
#pragma unroll
  for (int r = 0; r < 16; ++r) ps += p0[r];
#pragma unroll
  for (int r = 0; r < 16; ++r) ps += p1[r];
  { auto rr = __builtin_amdgcn_permlane32_swap(__float_as_uint(ps), __float_as_uint(ps), false, false);
    ps = __uint_as_float(rr[0]) + __uint_as_float(rr[1]); }
  l_reg = l_reg * alpha + ps;
#define PK4(P, BASE, OUT) do { unsigned a0 = cvtpk(P[BASE + 0], P[BASE + 1]), a1 = cvtpk(P[BASE + 2], P[BASE + 3]);   \
    unsigned b0 = cvtpk(P[BASE + 4], P[BASE + 5]), b1 = cvtpk(P[BASE + 6], P[BASE + 7]);                              \
    auto r0 = __builtin_amdgcn_permlane32_swap(a0, b0, false, false); auto r1 = __builtin_amdgcn_permlane32_swap(a1, b1, false, false); \
    u32x4 w = {r0[0], r1[0], r0[1], r1[1]}; OUT = *reinterpret_cast<bf16x8*>(&w); } while (0)
  PK4(p0, 0, pa0); PK4(p0, 8, pa1); PK4(p1, 0, pa2); PK4(p1, 8, pa3);
#undef PK4
}
__device__ __forceinline__ void qkt(f32x16& p0, f32x16& p1, const LAS char* Ks, const bf16x8* qr, int r32, int hi) {
  p0 = f32x16{}; p1 = f32x16{};
#pragma unroll
  for (int d0 = 0; d0 < 8; ++d0) { const int cb = (d0 * 16 + hi * 8) * 2;
    const bf16x8 b0 = *reinterpret_cast<const LAS bf16x8*>(Ks + KSWZ(r32, cb));
    const bf16x8 b1 = *reinterpret_cast<const LAS bf16x8*>(Ks + KSWZ(32 + r32, cb));
    p0 = __builtin_amdgcn_mfma_f32_32x32x16_bf16(b0, qr[d0], p0, 0, 0, 0);
    p1 = __builtin_amdgcn_mfma_f32_32x32x16_bf16(b1, qr[d0], p1, 0, 0, 0); }
}
__device__ __forceinline__ int v_st(int k, int c) { const int kk = (k & ~0xC) | ((k & 4) << 1) | ((k & 8) >> 1); return ((kk >> 3) * 4 + (c >> 5)) * 512 + ((kk & 7) * 32 + (c & 31)) * 2; }
__device__ __forceinline__ int v_rd_base(int lane) { return ((lane & 3) << 3) | (((lane >> 2) & 3) << 6) | (((lane >> 4) & 1) << 5) | (((lane >> 5) & 1) << 8); }
constexpr int v_rd_off(int d0, int ks, int half) { return d0 * 512 + ks * 4096 + half * 2048; }
template <int OFF> __device__ __forceinline__ s16x4 tr_read(int vb) {
  s16x4 r; asm volatile("ds_read_b64_tr_b16 %0, %1 offset:%2" : "=&v"(r) : "v"(vb), "i"(OFF) : "memory"); return r;
}
template <int D0> __device__ __forceinline__ void pv_one(f32x16& od, int vb, bf16x8 pa0, bf16x8 pa1, bf16x8 pa2, bf16x8 pa3) {
  const s16x4 l0 = tr_read<v_rd_off(D0, 0, 0)>(vb), h0 = tr_read<v_rd_off(D0, 0, 1)>(vb), l1 = tr_read<v_rd_off(D0, 1, 0)>(vb), h1 = tr_read<v_rd_off(D0, 1, 1)>(vb);
  const s16x4 l2 = tr_read<v_rd_off(D0, 2, 0)>(vb), h2 = tr_read<v_rd_off(D0, 2, 1)>(vb), l3 = tr_read<v_rd_off(D0, 3, 0)>(vb), h3 = tr_read<v_rd_off(D0, 3, 1)>(vb);
  asm volatile("s_waitcnt lgkmcnt(0)" ::: "memory"); SBAR();
#define PK(L, H) (bf16x8){L[0], L[1], L[2], L[3], H[0], H[1], H[2], H[3]}
  od = __builtin_amdgcn_mfma_f32_32x32x16_bf16(pa0, PK(l0, h0), od, 0, 0, 0);
  od = __builtin_amdgcn_mfma_f32_32x32x16_bf16(pa1, PK(l1, h1), od, 0, 0, 0);
  od = __builtin_amdgcn_mfma_f32_32x32x16_bf16(pa2, PK(l2, h2), od, 0, 0, 0);
  od = __builtin_amdgcn_mfma_f32_32x32x16_bf16(pa3, PK(l3, h3), od, 0, 0, 0);
#undef PK
}
__device__ __forceinline__ void pv_d0(f32x16* o, int vb, bf16x8 pa0, bf16x8 pa1, bf16x8 pa2, bf16x8 pa3) {
  pv_one<0>(o[0], vb, pa0, pa1, pa2, pa3); pv_one<1>(o[1], vb, pa0, pa1, pa2, pa3); pv_one<2>(o[2], vb, pa0, pa1, pa2, pa3); pv_one<3>(o[3], vb, pa0, pa1, pa2, pa3);
}

struct UnitDesc { const bf16* Q; const bf16* K; const bf16* V; bf16* O; int ldo; int qb; int bias_head; const bf16* kmean;   };

__device__ __forceinline__ void attn_unit(const UnitDesc& u, const float* __restrict__ rel_bias, LAS char* lds, const int wave_id) {
  int tid_ = wave_id * 64 + lane_id(); asm volatile("" : "+v"(tid_));
  const int tid = tid_, wid = tid >> 6, lane = tid & 63, r32 = lane & 31, hi = lane >> 5;
  LAS char* V_lds = lds + OFF_V; LAS char* K_lds = lds + OFF_K;
  LAS float* wsl = (LAS float*)(lds + OFF_WS) + wid * 64; LAS float* li_l = wsl; LAS float* al_l = wsl + 32;
  LAS float* lut = (LAS float*)(lds + OFF_LUT);
  const int q0 = u.qb * 256, qw0 = q0 + wid * QBLK, qpos = qw0 + r32;
  __syncthreads();
  for (int i = tid; i < LUT_N; i += 512) { const int d = LUT_DMAX - i; lut[i] = d < 0 ? NEGBIG : rel_bias[t5_bucket(d > 127 ? 127 : d) * 24 + u.bias_head] * LOG2E; }
  float m_reg = NEGBIG, l_reg = 0; f32x16 o[4] = {}; bf16x8 qr[8];
  const bf16* Qw = u.Q + (size_t)(qw0 + r32) * LDP + hi * 8;
#pragma unroll
  for (int d0 = 0; d0 < 8; ++d0) qr[d0] = *reinterpret_cast<const bf16x8*>(Qw + d0 * 16);
  unsigned rowmask = 0xffffffffu;
  if (u.kmean) {
    { const int r = tid >> 4, c = (tid & 15) * 8;
      *reinterpret_cast<LAS bf16x8*>(K_lds + KSWZ(r, c * 2)) = *reinterpret_cast<const bf16x8*>(u.kmean + r * 128 + c); }
    __syncthreads();
    f32x16 g0 = f32x16{};
#pragma unroll
    for (int d0 = 0; d0 < 8; ++d0) { const int cb = (d0 * 16 + hi * 8) * 2;
      const bf16x8 b0 = *reinterpret_cast<const LAS bf16x8*>(K_lds + KSWZ(r32, cb));
      g0 = __builtin_amdgcn_mfma_f32_32x32x16_bf16(b0, qr[d0], g0, 0, 0, 0); }
    LAS float* gs = (LAS float*)(lds + OFF_GATE + wid * GATE_W);
#pragma unroll
    for (int r = 0; r < 16; ++r) gs[r32 * 33 + crow(r, hi)] = g0[r];
    asm volatile("s_waitcnt lgkmcnt(0)" ::: "memory");
    __builtin_amdgcn_wave_barrier();
    float b1v = NEGBIG, b2v = NEGBIG, b3v = NEGBIG; int b1i = -1, b2i = -1, b3i = -1;
    for (int j = 0; j < u.qb; ++j) { const float g = gs[r32 * 33 + j];
      if (g > b1v) { b3v = b2v; b3i = b2i; b2v = b1v; b2i = b1i; b1v = g; b1i = j; }
      else if (g > b2v) { b3v = b2v; b3i = b2i; b2v = g; b2i = j; }
      else if (g > b3v) { b3v = g; b3i = j; } }
    rowmask = 1u << u.qb;
    if (b1i >= 0) rowmask |= 1u << b1i; if (b2i >= 0) rowmask |= 1u << b2i; if (b3i >= 0) rowmask |= 1u << b3i;
    __syncthreads();
  }
  const int sr = tid >> 4, sc = (tid & 15) * 8, vst0 = v_st(sr, sc), vst1 = v_st(32 + sr, sc);
  const int vb0 = (int)(uintptr_t)V_lds + v_rd_base(lane);
  struct { bf16x8 vs0, vs1, ks0, ks1; } sr_[2];
  const bf16* Kh = u.K; const bf16* Vh = u.V;
#define SLOAD(i, k0) do { sr_[i].vs0 = *reinterpret_cast<const bf16x8*>(&Vh[(size_t)((k0) + sr) * LDP + sc]); sr_[i].vs1 = *reinterpret_cast<const bf16x8*>(&Vh[(size_t)((k0) + 32 + sr) * LDP + sc]); \
    sr_[i].ks0 = *reinterpret_cast<const bf16x8*>(&Kh[(size_t)((k0) + sr) * LDP + sc]); sr_[i].ks1 = *reinterpret_cast<const bf16x8*>(&Kh[(size_t)((k0) + 32 + sr) * LDP + sc]); } while (0)
#define SWRITE(b, i) do { *(LAS bf16x8*)(V_lds + (b) * SHM_V + vst0) = sr_[i].vs0; *(LAS bf16x8*)(V_lds + (b) * SHM_V + vst1) = sr_[i].vs1; const int kc = sc * 2; \
    *(LAS bf16x8*)(K_lds + (b) * SHM_K + KSWZ(sr, kc)) = sr_[i].ks0; *(LAS bf16x8*)(K_lds + (b) * SHM_K + KSWZ(32 + sr, kc)) = sr_[i].ks1; } while (0)
#define SWAIT() asm volatile("s_waitcnt vmcnt(4)" ::: "memory")
#define RESC(a) do { if (__any((a) < 1.f)) { if (hi == 0) al_l[r32] = (a); asm volatile("s_waitcnt lgkmcnt(0)" ::: "memory"); \
    _Pragma("unroll") for (int d = 0; d < 4; ++d) _Pragma("unroll") for (int r = 0; r < 16; ++r) o[d][r] *= al_l[crow(r, hi)]; } } while (0)
#define BIAS(P0, P1, j) do { const int k0_ = (j) * KVBLK; const bool allowed_ = (rowmask >> ((j) >> 2)) & 1u; \
    if (qw0 - k0_ - 63 >= 113) bias_far(P0, P1, allowed_ ? b31c : NEGBIG); else bias_near(P0, P1, lut, allowed_ ? qpos - k0_ : -64, hi); } while (0)
  f32x16 pA0, pA1, pB0, pB1; float mnA, mnB, alA, alB; bf16x8 pa0, pa1, pa2, pa3; const int NT = 4 * (u.qb + 1);
  constexpr int SE = 0, SO = 1;
  SLOAD(SE, 0); asm volatile("s_waitcnt vmcnt(0)" ::: "memory"); SWRITE(0, SE); __syncthreads();
  const float b31c = lut[LUT_DMAX - 127];
  qkt(pA0, pA1, K_lds, qr, r32, hi); BIAS(pA0, pA1, 0); partialSM(pA0, pA1, m_reg, mnA, alA);
  SLOAD(SO, KVBLK); if (2 < NT) SLOAD(SE, 2 * KVBLK);
  SWAIT(); SWRITE(1, SO); __syncthreads();
  for (int j = 1; j + 1 < NT; j += 2) {
    SBAR(); qkt(pB0, pB1, K_lds + SHM_K, qr, r32, hi);
    finishSM(pA0, pA1, alA, l_reg, pa0, pa1, pa2, pa3); SBAR();
    SLOAD(SO, (j + 2) * KVBLK); SBAR();
    pv_d0(o, vb0, pa0, pa1, pa2, pa3); BIAS(pB0, pB1, j); partialSM(pB0, pB1, m_reg, mnB, alB);
    __syncthreads(); SWAIT(); SWRITE(0, SE);
    RESC(alB); __syncthreads();
    SBAR(); qkt(pA0, pA1, K_lds, qr, r32, hi);
    finishSM(pB0, pB1, alB, l_reg, pa0, pa1, pa2, pa3); SBAR();
    if (j + 3 < NT) SLOAD(SE, (j + 3) * KVBLK); SBAR();
    pv_d0(o, vb0 + SHM_V, pa0, pa1, pa2, pa3); BIAS(pA0, pA1, j + 1); partialSM(pA0, pA1, m_reg, mnA, alA);
    __syncthreads(); SWAIT(); SWRITE(1, SO);
    RESC(alA); __syncthreads();
  }
  SBAR(); qkt(pB0, pB1, K_lds + SHM_K, qr, r32, hi);
  finishSM(pA0, pA1, alA, l_reg, pa0, pa1, pa2, pa3); SBAR();
  pv_d0(o, vb0, pa0, pa1, pa2, pa3); BIAS(pB0, pB1, NT - 1); partialSM(pB0, pB1, m_reg, mnB, alB);
  __syncthreads(); RESC(alB);
  finishSM(pB0, pB1, alB, l_reg, pa0, pa1, pa2, pa3); SBAR();
  pv_d0(o, vb0 + SHM_V, pa0, pa1, pa2, pa3);
  if (hi == 0) li_l[r32] = l_reg; asm volatile("s_waitcnt lgkmcnt(0)" ::: "memory");
  float rli[16];
#pragma unroll
  for (int r = 0; r < 16; ++r) rli[r] = __builtin_amdgcn_rcpf(li_l[crow(r, hi)]);
  bf16* Ow = u.O + (size_t)qw0 * u.ldo;
#pragma unroll
  for (int r = 0; r < 16; ++r) { const int orow = crow(r, hi);
#pragma unroll
    for (int d0 = 0; d0 < 4; ++d0) Ow[(size_t)orow * u.ldo + d0 * 32 + r32] = (bf16)f2bf(o[d0][r] * rli[r]); }
#undef SLOAD
#undef SWRITE
#undef SWAIT
#undef RESC
#undef BIAS
}
}

__device__ __forceinline__ float clamp8(float x) { return __builtin_amdgcn_fmed3f(x, -448.f, 448.f); }
__device__ __forceinline__ unsigned pk4_fp8(float a, float b, float c, float d) { int w = 0; w = __builtin_amdgcn_cvt_pk_fp8_f32(clamp8(a), clamp8(b), w, false); w = __builtin_amdgcn_cvt_pk_fp8_f32(clamp8(c), clamp8(d), w, true); return (unsigned)w; }
__device__ __forceinline__ void p0_transpose_item8(const float* W, int K, int N, unsigned char* WT, float scale, LAS float* scr, int item, int lane) {
    const int nblk = N / 32, kb = item / nblk, nb = item % nblk, k0 = 64 * kb, n0 = 32 * nb;
#pragma unroll 8
    for (int i = 0; i < 32; ++i) { const int kk = 2 * i + (lane >> 5); scr[kk * 33 + (lane & 31)] = W[(size_t)(k0 + kk) * N + n0 + (lane & 31)]; }
    LDS_WAIT(); asm volatile("" ::: "memory");
    const int n = lane >> 1, kh = (lane & 1) * 32; const LAS float* sp = scr + kh * 33 + n;
    v4u o0, o1;
    o0.x = pk4_fp8(sp[0 * 33] * scale, sp[1 * 33] * scale, sp[2 * 33] * scale, sp[3 * 33] * scale); o0.y = pk4_fp8(sp[4 * 33] * scale, sp[5 * 33] * scale, sp[6 * 33] * scale, sp[7 * 33] * scale);
    o0.z = pk4_fp8(sp[8 * 33] * scale, sp[9 * 33] * scale, sp[10 * 33] * scale, sp[11 * 33] * scale); o0.w = pk4_fp8(sp[12 * 33] * scale, sp[13 * 33] * scale, sp[14 * 33] * scale, sp[15 * 33] * scale);
    o1.x = pk4_fp8(sp[16 * 33] * scale, sp[17 * 33] * scale, sp[18 * 33] * scale, sp[19 * 33] * scale); o1.y = pk4_fp8(sp[20 * 33] * scale, sp[21 * 33] * scale, sp[22 * 33] * scale, sp[23 * 33] * scale);
    o1.z = pk4_fp8(sp[24 * 33] * scale, sp[25 * 33] * scale, sp[26 * 33] * scale, sp[27 * 33] * scale); o1.w = pk4_fp8(sp[28 * 33] * scale, sp[29 * 33] * scale, sp[30 * 33] * scale, sp[31 * 33] * scale);
    GAS v4u* dst = (GAS v4u*)(WT + (size_t)(n0 + n) * K + k0 + kh); dst[0] = o0; dst[1] = o1;
    LDS_WAIT(); asm volatile("" ::: "memory");
}
__device__ __forceinline__ void p0_convert8(const float* src, unsigned char* dst, float scale, size_t n16, size_t gtid, size_t gthreads) {
    for (size_t i = gtid; i < n16; i += gthreads) { const GAS f32x4* p = (const GAS f32x4*)(src + i * 16); const f32x4 a = p[0] * scale, b = p[1] * scale, c = p[2] * scale, d = p[3] * scale;
        v4u o; o.x = pk4_fp8(a.x, a.y, a.z, a.w); o.y = pk4_fp8(b.x, b.y, b.z, b.w); o.z = pk4_fp8(c.x, c.y, c.z, c.w); o.w = pk4_fp8(d.x, d.y, d.z, d.w); *(GAS v4u*)(dst + i * 16) = o; }
}

namespace rt {
using f32x16 = __attribute__((ext_vector_type(16))) float;
__device__ __forceinline__ void ins16(float (&val)[16], int (&idx)[16], float v, int i) {
#pragma unroll
    for (int s = 0; s < 16; ++s) { const bool gt = v > val[s]; const float tv = gt ? val[s] : v; const int ti = gt ? idx[s] : i; val[s] = gt ? v : val[s]; idx[s] = gt ? i : idx[s]; v = tv; i = ti; }
}
__device__ __forceinline__ void side_top16(const bf16* q, const bf16* keys, int r32, int hi, float (&val)[16], int (&idx)[16]) {
    bf16x8 qf[8];
#pragma unroll
    for (int d0 = 0; d0 < 8; ++d0) qf[d0] = *reinterpret_cast<const bf16x8*>(q + d0 * 16 + hi * 8);
    f32x16 acc[4];
#pragma unroll
    for (int nb = 0; nb < 4; ++nb) { acc[nb] = f32x16{};
#pragma unroll
        for (int d0 = 0; d0 < 8; ++d0) { const bf16x8 kf = *reinterpret_cast<const bf16x8*>(keys + (32 * nb + r32) * 128 + d0 * 16 + hi * 8);
            acc[nb] = __builtin_amdgcn_mfma_f32_32x32x16_bf16(kf, qf[d0], acc[nb], 0, 0, 0); } }
#pragma unroll
    for (int s = 0; s < 16; ++s) { val[s] = -3.0e38f; idx[s] = 0; }
#pragma unroll
    for (int nb = 0; nb < 4; ++nb)
#pragma unroll
        for (int r = 0; r < 16; ++r) ins16(val, idx, acc[nb][r], 32 * nb + (r & 3) + 8 * (r >> 2) + 4 * hi);
    float pv[16]; int pi[16];
#pragma unroll
    for (int s = 0; s < 16; ++s) { pv[s] = __shfl_xor(val[s], 32); pi[s] = __shfl_xor(idx[s], 32); }
#pragma unroll
    for (int s = 0; s < 16; ++s) ins16(val, idx, pv[s], pi[s]);
}
template <int I, int J> struct Cand {
    static __device__ __forceinline__ void run(float (&cv)[16], int (&ci)[16], const float (&v1)[16], const float (&v2)[16], const int (&i1)[16], const int (&i2)[16]) {
        if constexpr ((I + 1) * (J + 1) <= 16) { ins16(cv, ci, v1[I] + v2[J], i1[I] * 128 + i2[J]); Cand<I, J + 1>::run(cv, ci, v1, v2, i1, i2); }
        else if constexpr (I + 1 < 16) Cand<I + 1, 0>::run(cv, ci, v1, v2, i1, i2);
    }
};
template <int I> struct Cand<I, 16> { static __device__ __forceinline__ void run(float (&cv)[16], int (&ci)[16], const float (&v1)[16], const float (&v2)[16], const int (&i1)[16], const int (&i2)[16]) {
        if constexpr (I + 1 < 16) Cand<I + 1, 0>::run(cv, ci, v1, v2, i1, i2); } };
constexpr int OFF_E = 0, OFF_G = 16384;
__device__ __forceinline__ void route_block(int t0, const bf16* PQ, const bf16* KEYSB, unsigned char* GD, int* EIDX, float* GATES, LAS char* lds, const int wave_id) {
    int tid_ = wave_id * 64 + lane_id(); asm volatile("" : "+v"(tid_));
    const int tid = tid_, h = tid >> 6, lane = tid & 63, r32 = lane & 31, hi = lane >> 5;
    LAS int* ent_e = (LAS int*)(lds + OFF_E); LAS float* ent_g = (LAS float*)(lds + OFF_G);
    __syncthreads();
    const bf16* q = PQ + (size_t)(t0 + r32) * 2048 + h * 256;
    float v1[16], v2[16], cv[16]; int i1[16], i2[16], ci[16];
    side_top16(q, KEYSB, r32, hi, v1, i1);
    side_top16(q + 128, KEYSB + 128 * 128, r32, hi, v2, i2);
#pragma unroll
    for (int s = 0; s < 16; ++s) { cv[s] = -3.0e38f; ci[s] = 0; }
    Cand<0, 0>::run(cv, ci, v1, v2, i1, i2);
    const float mx = cv[0]; float sum = 0.f;
#pragma unroll
    for (int s = 0; s < 16; ++s) { cv[s] = __expf(cv[s] - mx); sum += cv[s]; }
    const float inv = 1.0f / sum;
    if (hi == 0) {
#pragma unroll
        for (int s = 0; s < 16; ++s) { ent_e[r32 * 128 + h * 16 + s] = ci[s]; ent_g[r32 * 128 + h * 16 + s] = cv[s] * inv; }
        if (EIDX) {
#pragma unroll
            for (int s = 0; s < 16; ++s) { EIDX[(size_t)(t0 + r32) * 128 + h * 16 + s] = ci[s]; GATES[(size_t)(t0 + r32) * 128 + h * 16 + s] = cv[s] * inv; } }
    }
    __syncthreads();
    { const int tok = tid >> 4, s0 = (tid & 15) * 8;
        for (int k = 0; k < 8; ++k) { const int sidx = s0 + k, e = ent_e[tok * 128 + sidx]; float g = 0.f; bool first = true;
            for (int s2 = 0; s2 < 128; ++s2) { if (ent_e[tok * 128 + s2] == e) { g += ent_g[tok * 128 + s2]; if (s2 < sidx) first = false; } }
            if (first) GD[(size_t)(t0 + tok) * 16384 + e] = (unsigned char)(pk4_fp8(g * 256.f, 0.f, 0.f, 0.f) & 0xffu); } }
}
}

__device__ __forceinline__ float wave_sum(float v) {
#pragma unroll
    for (int o = 1; o < 64; o <<= 1) v += __shfl_xor(v, o);
    return v;
}
__device__ __forceinline__ void ln_row(const float* in, const float* g, const float* b, float* outf, bf16* outb, unsigned char* outq, int lane) {
    f32x4 v[16]; float s = 0.f;
#pragma unroll
    for (int j = 0; j < 16; ++j) { v[j] = *(const GAS f32x4*)(in + 256 * j + 4 * lane); s += (v[j].x + v[j].y) + (v[j].z + v[j].w); }
    const float mean = wave_sum(s) * (1.0f / DM); float s2 = 0.f;
#pragma unroll
    for (int j = 0; j < 16; ++j) { v[j] = v[j] - mean; s2 += (v[j].x * v[j].x + v[j].y * v[j].y) + (v[j].z * v[j].z + v[j].w * v[j].w); }
    const float rstd = rsqrtf(wave_sum(s2) * (1.0f / DM) + LN_EPS);
#pragma unroll
    for (int j = 0; j < 16; ++j) { const f32x4 gv = *(const GAS f32x4*)(g + 256 * j + 4 * lane), bv = *(const GAS f32x4*)(b + 256 * j + 4 * lane); const f32x4 y = v[j] * rstd * gv + bv;
        *(GAS f32x4*)(outf + 256 * j + 4 * lane) = y;
        if (outb) { v2u o; o.x = pk2(y.x, y.y); o.y = pk2(y.z, y.w); *(GAS v2u*)(outb + 256 * j + 4 * lane) = o; }
        if (outq) *(GAS unsigned*)(outq + 256 * j + 4 * lane) = pk4_fp8(y.x, y.y, y.z, y.w); }
}

struct Args { const float* in[21]; float* out; unsigned char* ws; int ph_lo, ph_hi; };
constexpr size_t WS_CTL = 0, WS_KMEANB = 1 * MiB, WS_KEYSB = 1 * MiB + 512 * 1024;
constexpr size_t WS_WINT = 2 * MiB, WS_MERGED = 2 * MiB, WS_X1B = 66 * MiB, WS_PQ = 130 * MiB;
constexpr size_t WS_XB = 162 * MiB, WS_YA = 162 * MiB, WS_YB = 194 * MiB;
constexpr size_t WS_PROJ = 226 * MiB, WS_G = 226 * MiB;
constexpr size_t WS_OP0 = 546 * MiB, WS_OP1 = 578 * MiB, WS_WOA = 610 * MiB, WS_WOB = 626 * MiB, WS_WOUT = 642 * MiB, WS_WQ = 674 * MiB, WS_UB = 690 * MiB, WS_VT = 818 * MiB, WS_X1F = 946 * MiB;
constexpr size_t WS_EIDX = 1074 * MiB, WS_GATES = 1078 * MiB, WS_NEED = 1082 * MiB;

__global__ void __launch_bounds__(NWAVES * 64, 2) mega_fwd(Args args) {
    extern __shared__ __attribute__((aligned(16))) unsigned char lds_raw[];
    LAS unsigned char* lds = (LAS unsigned char*)lds_raw;
    volatile LAS unsigned* MISC = (volatile LAS unsigned*)(lds + MISC_OFF);
    const int wave = __builtin_amdgcn_readfirstlane((int)threadIdx.x >> 6);
#define lane (lane_id())
#define tid (wave * 64 + lane_id())
    const int G = gridDim.x; const int vcu = (G % 8 == 0) ? ((int)blockIdx.x % 8) * (G / 8) + (int)blockIdx.x / 8 : (int)blockIdx.x;
    unsigned char* ws = args.ws;
    gu32* ctl = (gu32*)(ws + WS_CTL);
    for (int u = tid; u < (LDS_BYTES - LDSCTL_OFF) / 4; u += NWAVES * 64) ((LAS unsigned*)(lds + LDSCTL_OFF))[u] = 0u;
    __syncthreads();
    XcdBarrier bar = xcd_barrier_post((unsigned*)(ctl + CW_BAR), MISC + 8);
    const int lo = args.ph_lo, hi = args.ph_hi;
#define IN(k) (lo <= (k) && (k) < hi)
#define BOTH(k) (IN(k) && IN((k) + 1))
#define WINT ((bf16*)(ws + WS_WINT))
#define XB ((bf16*)(ws + WS_XB))
#define PROJ ((bf16*)(ws + WS_PROJ))

#define MERGED ((bf16*)(ws + WS_MERGED))
#define X1B ((bf16*)(ws + WS_X1B))
#define PQ ((bf16*)(ws + WS_PQ))
#define GD ((bf16*)(ws + WS_G))
#define WOA ((bf16*)(ws + WS_WOA))
#define WOB ((bf16*)(ws + WS_WOB))
#define WOUT ((bf16*)(ws + WS_WOUT))
#define WQ ((bf16*)(ws + WS_WQ))
#define UB ((bf16*)(ws + WS_UB))
#define VT ((bf16*)(ws + WS_VT))
#define KEYSB ((bf16*)(ws + WS_KEYSB))
#define X1F ((float*)(ws + WS_X1F))
#define X1Q ((unsigned char*)(ws + WS_OP0))
    if (IN(0)) {
        LAS float* scr = (LAS float*)(lds + wave * 16384);
        const int gw = vcu * NWAVES + wave, NGW = G * NWAVES;
        constexpr int I_IN = (DM / 64) * (INW / 32), I_OA = (2048 / 64) * (DM / 32), I_OUT = (DM / 64) * (DM / 32), I_WQ = (DM / 64) * (2048 / 32), I_V = (16384 / 64) * (DM / 32);
        for (int it = gw; it < I_IN + 2 * I_OA + I_OUT + I_WQ + I_V; it += NGW) { int r = it;
            if (r < I_IN) { p0_transpose_item8(args.in[1], DM, INW, (unsigned char*)WINT, 64.0f, scr, r, lane); continue; } r -= I_IN;
            if (r < I_OA) { p0_transpose_item(args.in[9], 2048, DM, WOA, scr, r, lane); continue; } r -= I_OA;
            if (r < I_OA) { p0_transpose_item(args.in[10], 2048, DM, WOB, scr, r, lane); continue; } r -= I_OA;
            if (r < I_OUT) { p0_transpose_item(args.in[11], DM, DM, WOUT, scr, r, lane); continue; } r -= I_OUT;
            if (r < I_WQ) { p0_transpose_item(args.in[14], DM, 2048, WQ, scr, r, lane); continue; } r -= I_WQ;
            p0_transpose_item8(args.in[18], 16384, DM, (unsigned char*)VT, 8.0f, scr, r, lane); }
        const size_t gtid = (size_t)blockIdx.x * 512 + tid, gth = (size_t)G * 512;
        p0_convert8(args.in[0], (unsigned char*)XB, 1.0f, (size_t)S * DM / 16, gtid, gth);
        p0_convert8(args.in[17], (unsigned char*)UB, 64.0f, (size_t)16384 * DM / 16, gtid, gth);
        p0_convert(args.in[15], KEYSB, 128 * 128 / 8, gtid, gth);
        p0_convert(args.in[16], KEYSB + 128 * 128, 128 * 128 / 8, gtid, gth);
        if (BOTH(0)) xcd_barrier(bar);
    }
    if (IN(1)) {
        pg8::Gemm g{XB, WINT, XB, WINT, S, INW, DM / 2, (int)(0x01010101u * (127 - 6))}; pg8::StaticOrder So; So.init(S, INW, G, (int)blockIdx.x);
        pg8::EpiStoreBf16 E{PROJ, INW};
        pg8::gemm_phase<pg8::EpiStoreBf16, pg8::StaticOrder, true, false, true>(lds, g, So, E, wave);
        if (BOTH(1)) xcd_barrier(bar);
    }

#define KMEANB ((bf16*)(ws + WS_KMEANB))
#define YA ((bf16*)(ws + WS_YA))
#define YB ((bf16*)(ws + WS_YB))
#define OP0 ((bf16*)(ws + WS_OP0))
#define OP1 ((bf16*)(ws + WS_OP1))
    if (IN(2)) {
        for (int it = vcu * NWAVES + wave; it < 16 * 32; it += G * NWAVES) { const int h = it >> 5, j = it & 31;
            const bf16* kp = PROJ + (size_t)(j * 256) * INW + 2048 + h * 128 + 2 * lane; float s0 = 0.f, s1 = 0.f;
            for (int i = 0; i < 256; ++i) { const unsigned w = *(const unsigned*)(kp + (size_t)i * INW); s0 += bflo(w); s1 += bfhi(w); }
            *(unsigned*)(KMEANB + (size_t)it * 128 + 2 * lane) = pk2(s0 * (1.0f / 256.0f), s1 * (1.0f / 256.0f)); }
        if (BOTH(2)) xcd_barrier(bar);
    }
    if (IN(3)) {
#pragma nounroll
        for (int p = (int)blockIdx.x; p < 768; p += G) {
            const int xcd = p & 7, rank = (p >> 3) & 31, slot = p >> 8, t = rank & 15, gsel = rank >> 4;
#pragma nounroll
            for (int sub = 0; sub < 2; ++sub) {
                att::UnitDesc u; u.qb = sub == 0 ? 31 - t : t; u.ldo = 2048;
                if (slot == 0) { const int h = 2 * xcd + gsel; u.Q = PROJ + h * 128; u.K = PROJ + 2048 + h * 128; u.V = PROJ + 4096 + h * 128; u.O = YA + h * 128; u.bias_head = h; u.kmean = KMEANB + (size_t)h * 32 * 128; }
                else { const int pm = slot - 1, h = xcd; u.Q = PROJ + 6144 + h * 256 + pm * 128; u.K = PROJ + 8192 + h * 256 + pm * 128; u.V = PROJ + 10240 + h * 256 + gsel * 128;
                       u.O = (pm ? OP1 : OP0) + h * 256 + gsel * 128; u.bias_head = 16 + h; u.kmean = nullptr; }
                att::attn_unit(u, args.in[3], (LAS char*)lds, wave);
            }
        }
        if (BOTH(3)) xcd_barrier(bar);
    }
    if (IN(4)) {
        float a = args.in[4][lane] * args.in[5][lane] + args.in[4][lane + 64] * args.in[5][lane + 64], b = args.in[6][lane] * args.in[7][lane] + args.in[6][lane + 64] * args.in[7][lane + 64];
#pragma unroll
        for (int o = 1; o < 64; o <<= 1) { a += __shfl_xor(a, o); b += __shfl_xor(b, o); }
        const float lam = expf(a) - expf(b) + LAMBDA_INIT;
        const f32x4 gsub = *(const GAS f32x4*)(args.in[8] + 4 * lane);
        for (int it = vcu * NWAVES + wave; it < S * 8; it += G * NWAVES) { const size_t off = (size_t)(it >> 3) * 2048 + (it & 7) * 256 + 4 * lane;
            const v2u w0 = *(const GAS v2u*)(OP0 + off), w1 = *(const GAS v2u*)(OP1 + off);
            const float y0 = bflo(w0.x) - lam * bflo(w1.x), y1 = bfhi(w0.x) - lam * bfhi(w1.x), y2 = bflo(w0.y) - lam * bflo(w1.y), y3 = bfhi(w0.y) - lam * bfhi(w1.y);
            float ss = (y0 * y0 + y1 * y1) + (y2 * y2 + y3 * y3);
#pragma unroll
            for (int o = 1; o < 64; o <<= 1) ss += __shfl_xor(ss, o);
            const float rs = rsqrtf(ss * (1.0f / 256.0f) + LN_EPS) * (1.0f - LAMBDA_INIT);
            v2u o2; o2.x = pk2(y0 * rs * gsub.x, y1 * rs * gsub.y); o2.y = pk2(y2 * rs * gsub.z, y3 * rs * gsub.w); *(GAS v2u*)(YB + off) = o2; }
        if (BOTH(4)) xcd_barrier(bar);
    }

    if (IN(5)) {
        pg8::Gemm g{YA, WOA, YB, WOB, S, DM, 2048, 0}; pg8::DualOrder So; So.init(S, DM, G, (int)blockIdx.x);
        pg8::EpiMerge E{MERGED, PROJ, args.in[2]};
        pg8::gemm_phase<pg8::EpiMerge, pg8::DualOrder, true, true>(lds, g, So, E, wave);
        if (BOTH(5)) xcd_barrier(bar);
    }
    if (IN(6)) {
        pg8::Gemm g{MERGED, WOUT, MERGED, WOUT, S, DM, DM, 0}; pg8::StaticOrder So; So.init(S, DM, G, (int)blockIdx.x);
        pg8::EpiResF32 E{args.out, args.in[0], ALPHA};
        pg8::gemm_phase<pg8::EpiResF32, pg8::StaticOrder, true, true>(lds, g, So, E, wave);
        if (BOTH(6)) xcd_barrier(bar);
    }
    if (IN(7)) {
        for (int m = vcu * NWAVES + wave; m < S; m += G * NWAVES) ln_row(args.out + (size_t)m * DM, args.in[12], args.in[13], X1F + (size_t)m * DM, X1B + (size_t)m * DM, X1Q + (size_t)m * DM, lane);
        { GAS v4u* gz = (GAS v4u*)GD; const v4u z = {0u, 0u, 0u, 0u}; for (size_t i = (size_t)blockIdx.x * 512 + tid; i < (size_t)S * 16384 / 16; i += (size_t)G * 512) gz[i] = z; }
        if (BOTH(7)) xcd_barrier(bar);
    }
    if (IN(8)) {
        pg8::Gemm g{X1B, WQ, X1B, WQ, S, 2048, DM, 0}; pg8::StaticOrder So; So.init(S, 2048, G, (int)blockIdx.x);
        pg8::EpiStoreBf16 E{PQ, 2048};
        pg8::gemm_phase<pg8::EpiStoreBf16, pg8::StaticOrder, true, true>(lds, g, So, E, wave);
        if (BOTH(8)) xcd_barrier(bar);
    }
    if (IN(9)) {
#pragma nounroll
        for (int b = (int)blockIdx.x; b < S / 32; b += G) rt::route_block(b * 32, PQ, KEYSB, (unsigned char*)GD, nullptr, nullptr, (LAS char*)lds, wave);
        if (BOTH(9)) xcd_barrier(bar);
    }
    if (IN(10)) {
        pg8::Gemm g{(const bf16*)X1Q, UB, (const bf16*)X1Q, UB, S, 16384, DM / 2, (int)(0x01010101u * (127 - 6))}; pg8::StaticOrder So; So.init(S, 16384, G, (int)blockIdx.x);
        pg8::EpiPeerAct E{(unsigned char*)GD};
        pg8::gemm_phase<pg8::EpiPeerAct, pg8::StaticOrder, true, true, true>(lds, g, So, E, wave);
        if (BOTH(10)) xcd_barrier(bar);
    }
    if (IN(11)) {
        pg8::Gemm g{GD, VT, GD, VT, S, DM, 16384 / 2, (int)(0x01010101u * (127 - 9))}; pg8::StaticOrder So; So.init(S, DM, G, (int)blockIdx.x);
        pg8::EpiResF32 E{args.out, X1F, ALPHA};
        pg8::gemm_phase<pg8::EpiResF32, pg8::StaticOrder, true, true, true>(lds, g, So, E, wave);
        if (BOTH(11)) xcd_barrier(bar);
    }
    if (IN(12)) {
        for (int m = vcu * NWAVES + wave; m < S; m += G * NWAVES) ln_row(args.out + (size_t)m * DM, args.in[19], args.in[20], args.out + (size_t)m * DM, nullptr, nullptr, lane);
    }
#undef IN
#undef BOTH
#undef lane
#undef tid
#undef WINT
#undef XB
#undef PROJ
#undef MERGED
#undef X1B
#undef PQ
#undef GD
#undef WOA
#undef WOB
#undef WOUT
#undef WQ
#undef UB
#undef VT
#undef KEYSB
#undef X1F
#undef X1Q
#undef KMEANB
#undef YA
#undef YB
#undef OP0
#undef OP1
}

__global__ void shim_proj(const bf16* __restrict__ PROJ, float* __restrict__ ws) {
    const size_t U64 = (size_t)S * 2048;
    const size_t i = (size_t)blockIdx.x * blockDim.x + threadIdx.x; const int row = (int)(i / INW), col = (int)(i % INW);
    const float v = bf2f(PROJ[i]);
    if (col < 12288) { const int t = col >> 11, c = col & 2047; ws[(size_t)t * U64 + (size_t)row * 2048 + c] = v; }
    else { const int t = (col - 12288) >> 12, c = (col - 12288) & 4095; ws[(size_t)(6 + 2 * t) * U64 + (size_t)row * 4096 + c] = v; }
}

__global__ void shim_bf16_f32(const bf16* __restrict__ src, float* __restrict__ dst) { const size_t i = (size_t)blockIdx.x * blockDim.x + threadIdx.x; dst[i] = bf2f(src[i]); }
}

extern "C" void kernel_launch(void* const* d_in, const int* in_sizes, int n_in, void* d_out, int out_size, void* d_ws, size_t ws_size, hipStream_t stream) {
    if (ws_size < WS_NEED) return;
    static int grid = 0;
    if (grid == 0) {
        int dev = 0, cus = 0;
        if (hipGetDevice(&dev) != hipSuccess || hipDeviceGetAttribute(&cus, hipDeviceAttributeMultiprocessorCount, dev) != hipSuccess) { grid = -1; return; }
        if (hipFuncSetAttribute((const void*)mega_fwd, hipFuncAttributeMaxDynamicSharedMemorySize, LDS_BYTES) != hipSuccess) { grid = -1; return; }
        grid = cus;
    }
    if (grid < 0) return;
    (void)hipMemsetAsync((char*)d_ws + WS_CTL, 0, CTL_ZERO_BYTES, stream);
    Args a{};
    for (int i = 0; i < 21; ++i) a.in[i] = (const float*)d_in[i];
    a.out = (float*)d_out; a.ws = (unsigned char*)d_ws;
    const int cuts[] = {0, 13};
    for (int li = 0; li + 1 < (int)(sizeof(cuts) / sizeof(int)); ++li) { a.ph_lo = cuts[li]; a.ph_hi = cuts[li + 1];
        hipLaunchKernelGGL(mega_fwd, dim3(grid), dim3(NWAVES * 64), LDS_BYTES, stream, a); }
}
```

```cpp
#include <hip/hip_runtime.h>
#include <math.h>
#include <cstdio>
#include <cstdint>

namespace {
constexpr int S = 8192, DM = 4096, INW = 20480;
constexpr float SCALE = 0.08838834764831845f;
constexpr float ALPHA = 1.189207115002721f;
constexpr float LN_EPS = 1e-5f;
constexpr float LAMBDA_INIT = 0.2f;
typedef float f32x16 __attribute__((ext_vector_type(16)));

__device__ __forceinline__ int t5_bucket(int n) {
    if (n < 16) return n;
    int b = 16;
    b += (n >= 19); b += (n >= 21); b += (n >= 24); b += (n >= 27); b += (n >= 31); b += (n >= 35); b += (n >= 40); b += (n >= 46);
    b += (n >= 52); b += (n >= 59); b += (n >= 67); b += (n >= 77); b += (n >= 87); b += (n >= 99); b += (n >= 113);
    return b;
}

__global__ void __launch_bounds__(256) gemm_f32(const float* __restrict__ A, int lda, const float* __restrict__ B, int ldb, float* __restrict__ C, int ldc, int K,
                                                const float* __restrict__ R, int ldr, float alpha) {
    __shared__ float As[16][132];
    __shared__ float Bs[16][132];
    const int tid = threadIdx.x, lane = tid & 63, wid = tid >> 6, wm = wid >> 1, wn = wid & 1;
    const int m0 = blockIdx.y * 128, n0 = blockIdx.x * 128;
    f32x16 acc[2][2];
    for (int i = 0; i < 2; ++i) for (int j = 0; j < 2; ++j) for (int r = 0; r < 16; ++r) acc[i][j][r] = 0.f;
    for (int k0 = 0; k0 < K; k0 += 16) {
        for (int i = 0; i < 2; ++i) {
            const int idx = tid + i * 256;
            const int r = idx >> 2, c4 = idx & 3;
            const float4 v = *(const float4*)(A + (size_t)(m0 + r) * lda + k0 + c4 * 4);
            As[c4 * 4 + 0][r] = v.x; As[c4 * 4 + 1][r] = v.y; As[c4 * 4 + 2][r] = v.z; As[c4 * 4 + 3][r] = v.w;
            const int kr = idx >> 5, cb = idx & 31;
            const float4 w = *(const float4*)(B + (size_t)(k0 + kr) * ldb + n0 + cb * 4);
            *(float4*)&Bs[kr][cb * 4] = w;
        }
        __syncthreads();
        for (int kk = 0; kk < 16; kk += 2) {
            float a[2], b[2];
            for (int i = 0; i < 2; ++i) a[i] = As[kk + (lane >> 5)][wm * 64 + i * 32 + (lane & 31)];
            for (int j = 0; j < 2; ++j) b[j] = Bs[kk + (lane >> 5)][wn * 64 + j * 32 + (lane & 31)];
            for (int i = 0; i < 2; ++i) for (int j = 0; j < 2; ++j) acc[i][j] = __builtin_amdgcn_mfma_f32_32x32x2f32(a[i], b[j], acc[i][j], 0, 0, 0);
        }
        __syncthreads();
    }
    for (int i = 0; i < 2; ++i) for (int j = 0; j < 2; ++j) for (int r = 0; r < 16; ++r) {
        const int row = m0 + wm * 64 + i * 32 + (r & 3) + 8 * (r >> 2) + 4 * (lane >> 5);
        const int col = n0 + wn * 64 + j * 32 + (lane & 31);
        float v = acc[i][j][r];
        if (R) v += alpha * R[(size_t)row * ldr + col];
        C[(size_t)row * ldc + col] = v;
    }
}

__global__ void transpose_f32(const float* __restrict__ in, int ld_in, float* __restrict__ out, int ld_out) {
    __shared__ float tile[32][33];
    const int tx = threadIdx.x & 31, ty = threadIdx.x >> 5;
    const int r0 = blockIdx.y * 32, c0 = blockIdx.x * 32;
    for (int i = ty; i < 32; i += 8) tile[i][tx] = in[(size_t)(r0 + i) * ld_in + c0 + tx];
    __syncthreads();
    for (int i = ty; i < 32; i += 8) out[(size_t)(c0 + i) * ld_out + r0 + tx] = tile[tx][i];
}

__global__ void kmean_kernel(const float* __restrict__ mk, float* __restrict__ kmean) {
    const int j = blockIdx.x, h = blockIdx.y, d = threadIdx.x;
    float s = 0.f;
    for (int i = 0; i < 256; ++i) s += mk[(size_t)(j * 256 + i) * 2048 + h * 128 + d];
    kmean[(h * 32 + j) * 128 + d] = s * (1.0f / 256.0f);
}

__device__ __forceinline__ float block_reduce(float v, float* red, bool is_max) {
    const int t = threadIdx.x;
    for (int o = 32; o >= 1; o >>= 1) { const float w = __shfl_xor(v, o); v = is_max ? fmaxf(v, w) : v + w; }
    __syncthreads();
    if ((t & 63) == 0) red[t >> 6] = v;
    __syncthreads();
    float r = red[0];
    for (int i = 1; i < (int)(blockDim.x >> 6); ++i) r = is_max ? fmaxf(r, red[i]) : r + red[i];
    __syncthreads();
    return r;
}

__global__ void __launch_bounds__(256) moba_naive(const float* __restrict__ mq, const float* __restrict__ mkT, const float* __restrict__ mv, const float* __restrict__ kmean,
                                                  const float* __restrict__ rel_bias, float* __restrict__ ya) {
    const int q = blockIdx.x, h = blockIdx.y, t = threadIdx.x;
    __shared__ float qs[128]; __shared__ float gate[32]; __shared__ int blk[4]; __shared__ int okf[4]; __shared__ float sc[1024]; __shared__ float red[8]; __shared__ float biasl[32];
    __shared__ float part[256];
    if (t < 128) qs[t] = mq[(size_t)q * 2048 + h * 128 + t];
    if (t < 32) biasl[t] = rel_bias[t * 24 + h];
    __syncthreads();
    const int qb = q >> 8;
    if (t < 32) { float g = -1e30f; if (t < qb) { g = 0.f; const float* km = kmean + (h * 32 + t) * 128; for (int d = 0; d < 128; ++d) g += qs[d] * km[d]; } gate[t] = g; }
    __syncthreads();
    if (t == 0) {
        unsigned used = 0;
        for (int r = 0; r < 3; ++r) { int best = -1; for (int j = 0; j < 32; ++j) if (!((used >> j) & 1u) && (best < 0 || gate[j] > gate[best])) best = j;
            used |= 1u << best; blk[r] = best; okf[r] = best < qb ? 1 : 0; }
        blk[3] = qb; okf[3] = 1;
    }
    __syncthreads();
    float lmax = -1e30f;
    for (int r = 0; r < 4; ++r) {
        const int kpos = blk[r] * 256 + t, dist = q - kpos; float s = -1e30f;
        if (okf[r] && dist >= 0) { float dot = 0.f; const float* kp = mkT + (size_t)(h * 128) * S + kpos; for (int d = 0; d < 128; ++d) dot += qs[d] * kp[(size_t)d * S];
            s = dot * SCALE + biasl[t5_bucket(dist)]; }
        sc[r * 256 + t] = s; lmax = fmaxf(lmax, s);
    }
    const float mx = block_reduce(lmax, red, true);
    float lsum = 0.f;
    for (int r = 0; r < 4; ++r) { const float e = expf(sc[r * 256 + t] - mx); sc[r * 256 + t] = e; lsum += e; }
    const float sum = block_reduce(lsum, red, false);
    const int d = t & 127, half = t >> 7; float a = 0.f;
    for (int i = half * 512; i < half * 512 + 512; ++i) { const float p = sc[i]; if (p != 0.f) { const int kpos = blk[i >> 8] * 256 + (i & 255); a += p * mv[(size_t)kpos * 2048 + h * 128 + d]; } }
    part[t] = a; __syncthreads();
    if (t < 128) ya[(size_t)q * 2048 + h * 128 + t] = (part[t] + part[t + 128]) / sum;
}

__global__ void __launch_bounds__(256) diff_naive(const float* __restrict__ dq, const float* __restrict__ dkT, const float* __restrict__ dv, const float* __restrict__ rel_bias,
                                                  const float* __restrict__ lq1, const float* __restrict__ lk1, const float* __restrict__ lq2, const float* __restrict__ lk2,
                                                  const float* __restrict__ subln_g, float* __restrict__ yb) {
    __shared__ float sc[S];
    __shared__ float qs[256]; __shared__ float red[8]; __shared__ float biasl[32]; __shared__ float lamsh;
    const int q = blockIdx.x, h = blockIdx.y, t = threadIdx.x;
    qs[t] = dq[(size_t)q * 2048 + h * 256 + t];
    if (t < 32) biasl[t] = rel_bias[t * 24 + 16 + h];
    if (t == 0) { float a = 0.f, b = 0.f; for (int d = 0; d < 128; ++d) { a += lq1[d] * lk1[d]; b += lq2[d] * lk2[d]; } lamsh = expf(a) - expf(b) + LAMBDA_INIT; }
    __syncthreads();
    const float lam = lamsh; const int nk = q + 1;
    float acc = 0.f;
    for (int mp = 0; mp < 2; ++mp) {
        float lmax = -1e30f;
        for (int kpos = t; kpos < nk; kpos += 256) { float dot = 0.f; const float* kp = dkT + (size_t)(h * 256 + mp * 128) * S + kpos;
            for (int d = 0; d < 128; ++d) dot += qs[mp * 128 + d] * kp[(size_t)d * S];
            const float s = dot * SCALE + biasl[t5_bucket(q - kpos)]; sc[kpos] = s; lmax = fmaxf(lmax, s); }
        const float mx = block_reduce(lmax, red, true);
        float lsum = 0.f;
        for (int kpos = t; kpos < nk; kpos += 256) { const float e = expf(sc[kpos] - mx); sc[kpos] = e; lsum += e; }
        const float inv = 1.0f / block_reduce(lsum, red, false);
        float a = 0.f;
        for (int i = 0; i < nk; ++i) a += sc[i] * dv[(size_t)i * 2048 + h * 256 + t];
        acc += (mp == 0 ? inv : -lam * inv) * a;
        __syncthreads();
    }
    const float ss = block_reduce(acc * acc, red, false);
    yb[(size_t)q * 2048 + h * 256 + t] = acc * rsqrtf(ss * (1.0f / 256.0f) + LN_EPS) * subln_g[t] * (1.0f - LAMBDA_INIT);
}

__global__ void merge_kernel(const float* __restrict__ ga, const float* __restrict__ gb, const float* __restrict__ gate_b, const float* __restrict__ ta, const float* __restrict__ tb, float* __restrict__ merged) {
    const size_t i = (size_t)blockIdx.x * blockDim.x + threadIdx.x; const int c = (int)(i & (DM - 1));
    const float a = 1.0f / (1.0f + expf(-(ga[i] + gate_b[c]))), b = 1.0f / (1.0f + expf(-(gb[i] + gate_b[DM + c])));
    merged[i] = a * ta[i] + b * tb[i];
}

__global__ void __launch_bounds__(256) ln_kernel(const float* __restrict__ in, const float* __restrict__ g, const float* __restrict__ b, float* __restrict__ out) {
    __shared__ float red[8];
    const int row = blockIdx.x, t = threadIdx.x; float v[16]; float s = 0.f;
    for (int i = 0; i < 16; ++i) { v[i] = in[(size_t)row * DM + i * 256 + t]; s += v[i]; }
    const float mu = block_reduce(s, red, false) * (1.0f / DM); float q = 0.f;
    for (int i = 0; i < 16; ++i) { v[i] -= mu; q += v[i] * v[i]; }
    const float rstd = rsqrtf(block_reduce(q, red, false) * (1.0f / DM) + LN_EPS);
    for (int i = 0; i < 16; ++i) out[(size_t)row * DM + i * 256 + t] = v[i] * rstd * g[i * 256 + t] + b[i * 256 + t];
}

__global__ void __launch_bounds__(256) peer_route_naive(const float* __restrict__ pq, const float* __restrict__ keys1, const float* __restrict__ keys2, int* __restrict__ eidx, float* __restrict__ gates) {
    __shared__ float qh[256]; __shared__ float sc[2][128]; __shared__ float tv[2][16]; __shared__ int ti[2][16];
    const int tok = blockIdx.x, t = threadIdx.x;
    for (int h = 0; h < 8; ++h) {
        qh[t] = pq[(size_t)tok * 2048 + h * 256 + t];
        __syncthreads();
        { const int side = t >> 7, k = t & 127; const float* kr = (side ? keys2 : keys1) + k * 128; float d = 0.f; for (int i = 0; i < 128; ++i) d += qh[side * 128 + i] * kr[i]; sc[side][k] = d; }
        __syncthreads();
        if (t == 0 || t == 128) { const int side = t >> 7; unsigned used[4] = {0, 0, 0, 0};
            for (int r = 0; r < 16; ++r) { int best = -1; for (int j = 0; j < 128; ++j) if (!((used[j >> 5] >> (j & 31)) & 1u) && (best < 0 || sc[side][j] > sc[side][best])) best = j;
                used[best >> 5] |= 1u << (best & 31); tv[side][r] = sc[side][best]; ti[side][r] = best; } }
        __syncthreads();
        if (t == 0) { unsigned used[8] = {0, 0, 0, 0, 0, 0, 0, 0}; float ts[16]; int tp[16];
            for (int r = 0; r < 16; ++r) { int best = -1; float bv = 0.f; for (int j = 0; j < 256; ++j) { if ((used[j >> 5] >> (j & 31)) & 1u) continue; const float c = tv[0][j >> 4] + tv[1][j & 15]; if (best < 0 || c > bv) { best = j; bv = c; } }
                used[best >> 5] |= 1u << (best & 31); ts[r] = bv; tp[r] = best; }
            float sum = 0.f; const float tmax = ts[0]; for (int r = 0; r < 16; ++r) { ts[r] = expf(ts[r] - tmax); sum += ts[r]; }
            for (int r = 0; r < 16; ++r) { eidx[(size_t)tok * 128 + h * 16 + r] = ti[0][tp[r] >> 4] * 128 + ti[1][tp[r] & 15]; gates[(size_t)tok * 128 + h * 16 + r] = ts[r] / sum; } }
        __syncthreads();
    }
}

__global__ void __launch_bounds__(256) peer_expert_naive(const float* __restrict__ x1, const int* __restrict__ eidx, const float* __restrict__ gates, const float* __restrict__ U, const float* __restrict__ V,
                                                         const float* __restrict__ g2, const float* __restrict__ b2, float* __restrict__ out) {
    __shared__ float xs[DM]; __shared__ float wts[128]; __shared__ int es[128]; __shared__ float red[8];
    const int tok = blockIdx.x, t = threadIdx.x, lane = t & 63, wid = t >> 6;
    for (int i = t; i < DM; i += 256) xs[i] = x1[(size_t)tok * DM + i];
    if (t < 128) es[t] = eidx[(size_t)tok * 128 + t];
    __syncthreads();
    for (int e = wid; e < 128; e += 4) { const float* u = U + (size_t)es[e] * DM; float d = 0.f;
        for (int j = 0; j < 16; ++j) { const float4 w = *(const float4*)(u + j * 256 + lane * 4); const float* xp = xs + j * 256 + lane * 4; d += w.x * xp[0] + w.y * xp[1] + w.z * xp[2] + w.w * xp[3]; }
        for (int o = 32; o >= 1; o >>= 1) d += __shfl_xor(d, o);
        if (lane == 0) wts[e] = gates[(size_t)tok * 128 + e] * 0.5f * d * (1.0f + erff(d * 0.7071067811865476f)); }
    __syncthreads();
    float acc[16];
    for (int i = 0; i < 16; ++i) acc[i] = 0.f;
    for (int e = 0; e < 128; ++e) { const float w = wts[e]; const float* v = V + (size_t)es[e] * DM; for (int i = 0; i < 16; ++i) acc[i] += w * v[i * 256 + t]; }
    float s = 0.f;
    for (int i = 0; i < 16; ++i) { acc[i] += ALPHA * xs[i * 256 + t]; s += acc[i]; }
    const float mu = block_reduce(s, red, false) * (1.0f / DM); float qq = 0.f;
    for (int i = 0; i < 16; ++i) { acc[i] -= mu; qq += acc[i] * acc[i]; }
    const float rstd = rsqrtf(block_reduce(qq, red, false) * (1.0f / DM) + LN_EPS);
    for (int i = 0; i < 16; ++i) out[(size_t)tok * DM + i * 256 + t] = acc[i] * rstd * g2[i * 256 + t] + b2[i * 256 + t];
}

void gemm(hipStream_t st, const float* A, int lda, const float* B, int ldb, float* C, int ldc, int M, int N, int K, const float* R = nullptr, int ldr = 0, float alpha = 0.f) {
    hipLaunchKernelGGL(gemm_f32, dim3(N / 128, M / 128), dim3(256), 0, st, A, lda, B, ldb, C, ldc, K, R, ldr, alpha);
}
#define GAS __attribute__((address_space(1)))
#define LAS __attribute__((address_space(3)))
typedef unsigned short bf16;
typedef unsigned v4u __attribute__((ext_vector_type(4)));
typedef unsigned v2u __attribute__((ext_vector_type(2)));
typedef float f32x4 __attribute__((ext_vector_type(4)));
typedef short bf16x8 __attribute__((ext_vector_type(8)));
typedef GAS unsigned gu32;
#define RLX_AGENT __ATOMIC_RELAXED, __HIP_MEMORY_SCOPE_AGENT
#define LDS_WAIT() asm volatile("s_waitcnt lgkmcnt(0)" ::: "memory")
#define VM_WAIT() asm volatile("s_waitcnt vmcnt(0)" ::: "memory")
__device__ __forceinline__ int lane_id() { int r; asm volatile("v_mbcnt_lo_u32_b32 %0, -1, 0\n\tv_mbcnt_hi_u32_b32 %0, -1, %0" : "=v"(r)); return r; }
__device__ __forceinline__ unsigned f2bf(float f) { unsigned u = __builtin_bit_cast(unsigned, f); return (u + 0x7fffu + ((u >> 16) & 1u)) >> 16; }
__device__ __forceinline__ unsigned pk2(float lo, float hi) { return f2bf(lo) | (f2bf(hi) << 16); }
__device__ __forceinline__ float bf2f(unsigned short b) { return __builtin_bit_cast(float, (unsigned)b << 16); }
__device__ __forceinline__ float bflo(unsigned w) { return __builtin_bit_cast(float, w << 16); }
__device__ __forceinline__ float bfhi(unsigned w) { return __builtin_bit_cast(float, w & 0xffff0000u); }
__device__ __forceinline__ float clamp8(float x) { return __builtin_amdgcn_fmed3f(x, -448.f, 448.f); }
__device__ __forceinline__ unsigned pk4_fp8(float a, float b, float c, float d) { int w = 0; w = __builtin_amdgcn_cvt_pk_fp8_f32(clamp8(a), clamp8(b), w, false); w = __builtin_amdgcn_cvt_pk_fp8_f32(clamp8(c), clamp8(d), w, true); return (unsigned)w; }

namespace pg8 {
#define PG8_LAS __attribute__((address_space(3)))
typedef unsigned short bf16_t;
typedef short bf16x8 __attribute__((ext_vector_type(8)));
typedef float f32x4 __attribute__((ext_vector_type(4)));
typedef unsigned u32x4 __attribute__((ext_vector_type(4)));
constexpr int BM = 256, BK = 64, HALF = 128, HTB = HALF * BK * 2  , STAGE_BYTES = 8 * HTB, NXCD = 8, WGM = 8;

__host__ __device__ __forceinline__ int lds_byte(int r, int c) { const int st = (r >> 4) * 2 + (c >> 5), rr = r & 15, cc = c & 31, ob = rr * 64 + cc * 2; return st * 1024 + (ob ^ (((ob >> 9) & 1) << 5)); }
__host__ __device__ __forceinline__ void stage_rc(int b, int& R, int& C) { const int st = b / 1024, sb = b % 1024, swz = sb ^ (((sb >> 9) & 1) << 5); R = (st >> 1) * 16 + swz / 64; C = (st & 1) * 32 + (swz % 64) / 2; }
__host__ __device__ __forceinline__ int perm32(int rho) { const int n = rho >> 4, i = rho & 15; return 8 * (i >> 2) + 4 * n + (i & 3); }

struct Unit { int pm, pn, part; };
struct Gemm { const bf16_t* A; const bf16_t* Bt; const bf16_t* A2; const bf16_t* Bt2; int M, N, K; int sc; int sc2; };

struct StaticOrder {
    int nM, nN, nwg, G, c;
    __host__ __device__ void init(int M, int N, int G_, int c_) { nM = M / BM; nN = N / BM; nwg = nM * nN; G = G_; c = c_; }
    __host__ __device__ bool next(int i, Unit& u) const {
        const long L = (long)i * G + c; if (L >= nwg) return false;
        int wgid = (int)L; { const int q = nwg / NXCD, r = nwg % NXCD, xcd = wgid % NXCD, off = wgid / NXCD; wgid = (xcd < r ? xcd * (q + 1) : r * (q + 1) + (xcd - r) * q) + off; }
        const int nig = WGM * nN, gid = wgid / nig, fm = gid * WGM, gsz = (nM - fm) < WGM ? (nM - fm) : WGM;
        u.pm = fm + ((wgid % nig) % gsz); u.pn = (wgid % nig) / gsz; u.part = 0; return true;
    }
    __device__ __forceinline__ void a_ready(const Unit&) const {}
    __device__ __forceinline__ void done(const Unit&) const {}
};


typedef int v4i_t __attribute__((ext_vector_type(4))); typedef int v8i_t __attribute__((ext_vector_type(8)));
__device__ __forceinline__ v8i_t cat8(bf16x8 a, bf16x8 b) { return __builtin_shufflevector(__builtin_bit_cast(v4i_t, a), __builtin_bit_cast(v4i_t, b), 0, 1, 2, 3, 4, 5, 6, 7); }
template <class Epi, class Sched, bool ALIGN_EPI = false, bool SP2 = false, bool F8 = false>
__device__ __forceinline__ void gemm_phase(PG8_LAS unsigned char* lds, const Gemm g, const Sched& S, const Epi& E, const int wave_id) {
    int lane_; asm volatile("v_mbcnt_lo_u32_b32 %0, -1, 0\n\tv_mbcnt_hi_u32_b32 %0, -1, %0" : "=v"(lane_));
    const int lane = lane_, wid = wave_id, tid = wid * 64 + lane, wr = wid >> 2, wc = wid & 3, fr = lane & 15, fq = lane >> 4;
    const int K = g.K, nt = K / BK;
    unsigned voffA[2], voffB[2];
#pragma unroll
    for (int i = 0; i < 2; ++i) { int R, C; stage_rc(tid * 16 + i * 8192, R, C); const int Rb = Epi::PERM ? ((R & ~31) + perm32(R & 31)) : R;
        voffA[i] = (unsigned)(R * K + C) * 2u; voffB[i] = (unsigned)(Rb * K + C) * 2u; }
    const size_t kstep = (size_t)(BK * 2);
    const size_t rstep64 = (size_t)64 * K * 2;
    const size_t hstep = (size_t)HALF * K * 2;
    const size_t tstep = 2 * hstep;
    const unsigned ldsw = (unsigned)wid * 1024u;
    const int aoff = lds_byte(wr * 64 + fr, fq * 8), boff = lds_byte(wc * 32 + fr, fq * 8);
#define PG8_SA(b, h) (((b) * 2 + (h)) * HTB)
#define PG8_SB(b, h) ((4 + (b) * 2 + (h)) * HTB)
#define PG8_STAGE(bufoff, gbase, voff) do { _Pragma("unroll") for (int _i = 0; _i < 2; ++_i) \
        __builtin_amdgcn_global_load_lds((const unsigned*)((const char*)(gbase) + (size_t)_i * rstep64 + (voff)[0]), (PG8_LAS unsigned*)(lds + (bufoff) + ldsw + _i * 8192), 16, 0, 0); } while (0)
#define PG8_LDA(dst, b, h) do { _Pragma("unroll") for (int m = 0; m < 4; ++m) _Pragma("unroll") for (int k = 0; k < 2; ++k) dst[m][k] = *(const PG8_LAS bf16x8*)(lds + PG8_SA(b, h) + aoff + m * 2048 + k * 1024); } while (0)
#define PG8_LDB(dst, b, h) do { _Pragma("unroll") for (int n = 0; n < 2; ++n) _Pragma("unroll") for (int k = 0; k < 2; ++k) dst[n][k] = *(const PG8_LAS bf16x8*)(lds + PG8_SB(b, h) + boff + n * 2048 + k * 1024); } while (0)
#define PG8_MMA(ai, bj, At, Bt) do { __builtin_amdgcn_s_setprio(1); if constexpr (F8) { _Pragma("unroll") for (int m = 0; m < 4; ++m) _Pragma("unroll") for (int n = 0; n < 2; ++n) \
        acc[ai][bj][m][n] = __builtin_amdgcn_mfma_scale_f32_16x16x128_f8f6f4(cat8(Bt[n][0], Bt[n][1]), cat8(At[m][0], At[m][1]), acc[ai][bj][m][n], 0, 0, 0, (cur.part ? g.sc2 : g.sc), 0, 0x7f7f7f7f); } else { \
        _Pragma("unroll") for (int m = 0; m < 4; ++m) _Pragma("unroll") for (int n = 0; n < 2; ++n) _Pragma("unroll") for (int k = 0; k < 2; ++k) \
        acc[ai][bj][m][n] = __builtin_amdgcn_mfma_f32_16x16x32_bf16(Bt[n][k], At[m][k], acc[ai][bj][m][n], 0, 0, 0); } __builtin_amdgcn_s_setprio(0); } while (0)
#define PG8_WAIT_V(n) asm volatile("s_waitcnt vmcnt(" #n ")" ::: "memory")
#define PG8_WAIT_L(n) asm volatile("s_waitcnt lgkmcnt(" #n ")" ::: "memory")
#define PG8_BAR __builtin_amdgcn_s_barrier()
#define PG8_SCHED __builtin_amdgcn_sched_barrier(0)
    Unit cur, nxt; int ui = 0;
    if (!S.next(0, cur)) return;
    f32x4 acc[2][2][4][2];
#pragma unroll
    for (int a = 0; a < 2; ++a)
#pragma unroll
        for (int b = 0; b < 2; ++b)
#pragma unroll
            for (int m = 0; m < 4; ++m)
#pragma unroll
                for (int n = 0; n < 2; ++n) acc[a][b][m][n] = (f32x4){0.f, 0.f, 0.f, 0.f};
    bf16x8 At[4][2], B0[2][2], B1[2][2];
    const char* cA = (const char*)(cur.part ? g.A2 : g.A) + (size_t)cur.pm * tstep; const char* cB = (const char*)(cur.part ? g.Bt2 : g.Bt) + (size_t)cur.pn * tstep;
    S.a_ready(cur);
    if constexpr (SP2) {
        PG8_STAGE(PG8_SB(0, 0), cB, voffB); PG8_STAGE(PG8_SB(0, 1), cB + hstep, voffB); PG8_STAGE(PG8_SA(0, 0), cA, voffA); PG8_STAGE(PG8_SA(0, 1), cA + hstep, voffA);
        if (wr == 1) PG8_BAR;
        PG8_WAIT_V(2); PG8_BAR;
        PG8_STAGE(PG8_SB(1, 0), cB + kstep, voffB); PG8_STAGE(PG8_SA(1, 0), cA + kstep, voffA); PG8_STAGE(PG8_SB(1, 1), cB + hstep + kstep, voffB);
        PG8_WAIT_V(6); PG8_BAR;
    } else {
        PG8_STAGE(PG8_SB(0, 0), cB, voffB); PG8_STAGE(PG8_SA(0, 0), cA, voffA); PG8_STAGE(PG8_SB(0, 1), cB + hstep, voffB); PG8_STAGE(PG8_SA(0, 1), cA + hstep, voffA);
        if (wr == 1) PG8_BAR;
        PG8_WAIT_V(4); PG8_BAR;
        PG8_STAGE(PG8_SB(1, 0), cB + kstep, voffB); PG8_STAGE(PG8_SA(1, 0), cA + kstep, voffA); PG8_STAGE(PG8_SB(1, 1), cB + hstep + kstep, voffB);
        PG8_WAIT_V(6); PG8_BAR;
    }
    for (;;) {
        const bool has_next = S.next(ui + 1, nxt);
        const char* nA = has_next ? (const char*)(nxt.part ? g.A2 : g.A) + (size_t)nxt.pm * tstep : cA; const char* nB = has_next ? (const char*)(nxt.part ? g.Bt2 : g.Bt) + (size_t)nxt.pn * tstep : cB;
        for (int t = 0; t < nt; t += 2) {
            const bool last = (t == nt - 2);
            const char* a1 = cA + (size_t)(t + 1) * kstep;
            const char* a2 = last ? nA : cA + (size_t)(t + 2) * kstep; const char* b2 = last ? nB : cB + (size_t)(t + 2) * kstep;
            const char* a3 = a2 + kstep; const char* b3 = b2 + kstep;
            if (last && has_next) S.a_ready(nxt);
            if constexpr (SP2) {
            PG8_LDB(B0, 0, 0); PG8_LDB(B1, 0, 1); PG8_SCHED; PG8_LDA(At, 0, 0); PG8_STAGE(PG8_SA(1, 1), a1 + hstep, voffA);
            PG8_WAIT_V(8); PG8_WAIT_L(0); PG8_BAR; PG8_MMA(0, 0, At, B0); PG8_MMA(0, 1, At, B1); PG8_BAR; PG8_SCHED;
            PG8_LDA(At, 0, 1); PG8_STAGE(PG8_SB(0, 0), b2, voffB); PG8_STAGE(PG8_SB(0, 1), b2 + hstep, voffB); PG8_STAGE(PG8_SA(0, 0), a2, voffA);
            PG8_WAIT_V(8); PG8_WAIT_L(0); PG8_BAR; PG8_MMA(1, 0, At, B0); PG8_MMA(1, 1, At, B1); PG8_BAR; PG8_SCHED;
            PG8_LDB(B0, 1, 0); PG8_LDB(B1, 1, 1); PG8_SCHED; PG8_LDA(At, 1, 0); PG8_STAGE(PG8_SA(0, 1), a2 + hstep, voffA);
            PG8_WAIT_V(8); PG8_WAIT_L(0); PG8_BAR; PG8_MMA(0, 0, At, B0); PG8_MMA(0, 1, At, B1); PG8_BAR; PG8_SCHED;
            PG8_LDA(At, 1, 1); PG8_STAGE(PG8_SB(1, 0), b3, voffB); PG8_STAGE(PG8_SB(1, 1), b3 + hstep, voffB); PG8_STAGE(PG8_SA(1, 0), a3, voffA);
            PG8_WAIT_V(8); PG8_WAIT_L(0); PG8_BAR; PG8_MMA(1, 0, At, B0); PG8_MMA(1, 1, At, B1); PG8_BAR; PG8_SCHED;
            } else {
            PG8_LDB(B0, 0, 0); PG8_SCHED; PG8_LDA(At, 0, 0); PG8_STAGE(PG8_SA(1, 1), a1 + hstep, voffA);
            PG8_WAIT_L(8); PG8_BAR; PG8_WAIT_L(0); PG8_MMA(0, 0, At, B0); PG8_BAR; PG8_SCHED;
            PG8_LDB(B1, 0, 1); PG8_STAGE(PG8_SB(0, 0), b2, voffB);
            PG8_BAR; PG8_WAIT_L(0); PG8_MMA(0, 1, At, B1); PG8_BAR;
            PG8_LDA(At, 0, 1); PG8_STAGE(PG8_SA(0, 0), a2, voffA);
            PG8_BAR; PG8_WAIT_L(0); PG8_MMA(1, 0, At, B0); PG8_BAR; PG8_SCHED;
            PG8_STAGE(PG8_SB(0, 1), b2 + hstep, voffB);
            PG8_WAIT_V(6); PG8_BAR; PG8_MMA(1, 1, At, B1); PG8_BAR;
            PG8_LDB(B0, 1, 0); PG8_SCHED; PG8_LDA(At, 1, 0); PG8_STAGE(PG8_SA(0, 1), a2 + hstep, voffA);
            PG8_WAIT_L(8); PG8_BAR; PG8_WAIT_L(0); PG8_MMA(0, 0, At, B0); PG8_BAR; PG8_SCHED;
            PG8_LDB(B1, 1, 1); PG8_STAGE(PG8_SB(1, 0), b3, voffB);
            PG8_BAR; PG8_WAIT_L(0); PG8_MMA(0, 1, At, B1); PG8_BAR;
            PG8_LDA(At, 1, 1); PG8_STAGE(PG8_SA(1, 0), a3, voffA);
            PG8_BAR; PG8_WAIT_L(0); PG8_MMA(1, 0, At, B0); PG8_BAR; PG8_SCHED;
            PG8_STAGE(PG8_SB(1, 1), b3 + hstep, voffB);
            PG8_WAIT_V(6); PG8_BAR; PG8_MMA(1, 1, At, B1); PG8_BAR;
            }
        }
        if constexpr (ALIGN_EPI) { if (wr == 0) PG8_BAR; }
        if constexpr (!Epi::AFTER_DRAIN) { int l_; asm volatile("v_mbcnt_lo_u32_b32 %0, -1, 0\n\tv_mbcnt_hi_u32_b32 %0, -1, %0" : "=v"(l_));
            E(acc, cur, wr, wc, l_ & 15, l_ >> 4); S.done(cur); }
        if (!has_next) break;
#pragma unroll
        for (int a = 0; a < 2; ++a)
#pragma unroll
            for (int b = 0; b < 2; ++b)
#pragma unroll
                for (int m = 0; m < 4; ++m)
#pragma unroll
                    for (int n = 0; n < 2; ++n) acc[a][b][m][n] = (f32x4){0.f, 0.f, 0.f, 0.f};
        cur = nxt; cA = nA; cB = nB; ++ui;
        if constexpr (ALIGN_EPI) { if (wr == 1) PG8_BAR; }
    }
    PG8_WAIT_V(0);
    if constexpr (!ALIGN_EPI) { if (wr == 0) PG8_BAR; }
    PG8_BAR;
    if constexpr (Epi::AFTER_DRAIN) { E.fused(acc, cur, wr, wc, fr, fq, lds, wid, lane); S.done(cur); }
#undef PG8_SA
#undef PG8_SB
#undef PG8_STAGE
#undef PG8_LDA
#undef PG8_LDB
#undef PG8_MMA
#undef PG8_WAIT_V
#undef PG8_WAIT_L
#undef PG8_BAR
#undef PG8_SCHED
}
}

#define XB_TMO      128
#define XB_XCNT(j)  (256  + 64 * (j))
#define XB_XSUB(j)  (1280 + 64 * (j))
#define XB_XGEN(j)  (2304 + 64 * (j))
#define XB_TOP      3328
#define XB_TOPGEN   3392
#define XCD_BAR_WORDS 3456
#define XB_SPIN_CAP (1u << 18)

__device__ __forceinline__ unsigned xb_ld(unsigned* p)              { return __hip_atomic_load(p, __ATOMIC_RELAXED, __HIP_MEMORY_SCOPE_AGENT); }
__device__ __forceinline__ unsigned xb_add(unsigned* p, unsigned v) { return __hip_atomic_fetch_add(p, v, __ATOMIC_RELAXED, __HIP_MEMORY_SCOPE_AGENT); }
__device__ __forceinline__ unsigned xb_xcc_id() { return (unsigned)__builtin_amdgcn_s_getreg((3 << 11) | 20) & 0xFu; }
#define XB_SPIN(cond, bar) do { unsigned _sp = 0; while (cond) { __builtin_amdgcn_s_sleep(1); \
    if ((++_sp & 255u) == 0u) { if (xb_ld(&(bar)[XB_TMO])) break; if (_sp > XB_SPIN_CAP) { atomicAdd(&(bar)[XB_TMO], 1u); break; } } } } while (0)

struct XcdBarrier {
    unsigned* bar; unsigned x;
    volatile LAS unsigned* st;
};

__device__ __forceinline__ XcdBarrier xcd_barrier_post(unsigned* bar, volatile LAS unsigned* st) {
    XcdBarrier b; b.bar = bar; b.x = xb_xcc_id(); b.st = st;
    if (threadIdx.x == 0) (void)xb_add(&bar[XB_XCNT(b.x)], 1u);
    return b;
}
__device__ __forceinline__ void xcd_barrier_complete(unsigned* bar, unsigned x, unsigned& nloc, unsigned& nx) {
    const unsigned G = gridDim.x * gridDim.y * gridDim.z;
    unsigned sum, cnt, mine, sp = 0u;
    for (;;) {
        sum = 0u; cnt = 0u; mine = 0u;
#pragma unroll
        for (unsigned j = 0; j < 16; ++j) { const unsigned c = xb_ld(&bar[XB_XCNT(j)]); sum += c; cnt += (c > 0u) ? 1u : 0u; mine = (j == x) ? c : mine; }
        if (sum == G) break;
        __builtin_amdgcn_s_sleep(1);
        if ((++sp & 255u) == 0u) { if (xb_ld(&bar[XB_TMO])) break; if (sp > XB_SPIN_CAP) { atomicAdd(&bar[XB_TMO], 1u); break; } }
    }
    nloc = mine > 0u ? mine : 1u; nx = cnt > 0u ? cnt : 1u;
}

__device__ __forceinline__ void xcd_barrier(const XcdBarrier& b) {
    asm volatile("s_waitcnt vmcnt(0)" ::: "memory");
    __syncthreads();
    if (threadIdx.x == 0) {
        unsigned* bar = b.bar;
        __builtin_amdgcn_s_waitcnt(0);
        unsigned nloc = b.st[0], nx = b.st[1];
        if (nloc == 0u) { xcd_barrier_complete(bar, b.x, nloc, nx); b.st[0] = nloc; b.st[1] = nx; }
        const unsigned old = xb_add(&bar[XB_XSUB(b.x)], 1u);
        const unsigned gen = old / nloc;
        if (old + 1u == (gen + 1u) * nloc) {
            __builtin_amdgcn_fence(__ATOMIC_RELEASE, "agent");
            asm volatile("s_waitcnt vmcnt(0)" ::: "memory");
            const unsigned og = xb_add(&bar[XB_TOP], 1u);
            const unsigned tg = og / nx;
            if (og + 1u == (tg + 1u) * nx) xb_add(&bar[XB_TOPGEN], 1u);
            else XB_SPIN(xb_ld(&bar[XB_TOPGEN]) == tg, bar);
            __builtin_amdgcn_fence(__ATOMIC_ACQUIRE, "agent");
            xb_add(&bar[XB_XGEN(b.x)], 1u);
            asm volatile("s_waitcnt vmcnt(0)" ::: "memory");
        } else {
            XB_SPIN(xb_ld(&bar[XB_XGEN(b.x)]) == gen, bar);
            __builtin_amdgcn_fence(__ATOMIC_ACQUIRE, "agent");
            asm volatile("s_waitcnt vmcnt(0)" ::: "memory");
        }
    }
    __syncthreads();
}

constexpr int NWAVES = 8;
#ifndef P5_SP2
#define P5_SP2 true
#endif
#ifndef P6_SP2
#define P6_SP2 true
#endif
constexpr size_t MiB = 1u << 20;
constexpr int RING_BYTES = 131072, LDSCTL_OFF = RING_BYTES, MISC_OFF = LDSCTL_OFF + 320, LDS_BYTES = 147456;
constexpr int CW_BAR = 4096;
constexpr size_t CTL_ZERO_BYTES = 1 * MiB;

namespace pg8 {
__device__ __forceinline__ unsigned cvt_pk_bf16(float lo, float hi) { unsigned r; asm volatile("v_cvt_pk_bf16_f32 %0, %1, %2" : "=v"(r) : "v"(lo), "v"(hi)); return r; }
typedef float f32x2 __attribute__((ext_vector_type(2)));
struct EpiStoreBf16 {
    static constexpr bool PERM = true, AFTER_DRAIN = false;
    bf16_t* O; int ldc;
    __device__ __forceinline__ void operator()(const f32x4 (&acc)[2][2][4][2], const Unit& u, int wr, int wc, int fr, int fq) const {
        const int row0 = u.pm * BM + wr * 64 + fr, col0 = u.pn * BM + wc * 32 + 8 * fq;
#pragma unroll
        for (int ai = 0; ai < 2; ++ai)
#pragma unroll
            for (int m = 0; m < 4; ++m) { bf16_t* rowp = O + (size_t)(row0 + ai * HALF + m * 16) * ldc + col0;
#pragma unroll
                for (int bj = 0; bj < 2; ++bj) { const f32x4 v0 = acc[ai][bj][m][0], v1 = acc[ai][bj][m][1];
                    u32x4 w; w.x = cvt_pk_bf16(v0[0], v0[1]); w.y = cvt_pk_bf16(v0[2], v0[3]); w.z = cvt_pk_bf16(v1[0], v1[1]); w.w = cvt_pk_bf16(v1[2], v1[3]);
                    *(u32x4*)(rowp + bj * HALF) = w; } }
    }
};

struct EpiMerge {
    static constexpr bool PERM = true, AFTER_DRAIN = false;
    unsigned char* Mg; const bf16_t* proj; const float* gate_b;
    __device__ __forceinline__ void operator()(const f32x4 (&acc)[2][2][4][2], const Unit& u, int wr, int wc, int fr, int fq) const {
        const int row0 = u.pm * BM + wr * 64 + fr, col0 = u.pn * BM + wc * 32 + 8 * fq; const int part = u.part;
        const bf16_t* gsrc = proj + (part ? 16384 : 12288); const float* gbp = gate_b + (part ? 4096 : 0);
#pragma unroll
        for (int bj = 0; bj < 2; ++bj) { const int col = col0 + bj * HALF;
            f32x4 gbv[2]; gbv[0] = *(const f32x4*)(gbp + col); gbv[1] = *(const f32x4*)(gbp + col + 4);
            asm volatile("" : "+v"(gbv[0]), "+v"(gbv[1]));
#pragma unroll
        for (int ai = 0; ai < 2; ++ai)
#pragma unroll
            for (int m = 0; m < 4; ++m) { const int row = row0 + ai * HALF + m * 16;
                {
                    const u32x4 gw = *(const u32x4*)(gsrc + (size_t)row * 20480 + col);
                    float z[8]; z[0] = __uint_as_float(gw.x << 16); z[1] = __uint_as_float(gw.x & 0xffff0000u); z[2] = __uint_as_float(gw.y << 16); z[3] = __uint_as_float(gw.y & 0xffff0000u);
                    z[4] = __uint_as_float(gw.z << 16); z[5] = __uint_as_float(gw.z & 0xffff0000u); z[6] = __uint_as_float(gw.w << 16); z[7] = __uint_as_float(gw.w & 0xffff0000u);
                    float v[8];
#pragma unroll
                    for (int k = 0; k < 8; ++k) { const float zz = z[k] + gbv[k >> 2][k & 3]; const float sg = __builtin_amdgcn_rcpf(1.0f + __builtin_amdgcn_exp2f(-1.4426950408889634f * zz)); v[k] = sg * acc[ai][bj][m][k >> 2][k & 3]; }
                    typedef unsigned u32x2v __attribute__((ext_vector_type(2)));
                    unsigned char* dst = Mg + (size_t)row * 4096 + col;
                    if (part) { const u32x2v pw = *(const u32x2v*)dst;
                        v[0] += 0.0625f * __builtin_amdgcn_cvt_f32_fp8((int)pw.x, 0); v[1] += 0.0625f * __builtin_amdgcn_cvt_f32_fp8((int)pw.x, 1); v[2] += 0.0625f * __builtin_amdgcn_cvt_f32_fp8((int)pw.x, 2); v[3] += 0.0625f * __builtin_amdgcn_cvt_f32_fp8((int)pw.x, 3);
                        v[4] += 0.0625f * __builtin_amdgcn_cvt_f32_fp8((int)pw.y, 0); v[5] += 0.0625f * __builtin_amdgcn_cvt_f32_fp8((int)pw.y, 1); v[6] += 0.0625f * __builtin_amdgcn_cvt_f32_fp8((int)pw.y, 2); v[7] += 0.0625f * __builtin_amdgcn_cvt_f32_fp8((int)pw.y, 3); }
                    u32x2v w; int t0 = 0, t1 = 0;
#define C8(x) __builtin_amdgcn_fmed3f((x) * 16.0f, -448.f, 448.f)
                    t0 = __builtin_amdgcn_cvt_pk_fp8_f32(C8(v[0]), C8(v[1]), t0, false); t0 = __builtin_amdgcn_cvt_pk_fp8_f32(C8(v[2]), C8(v[3]), t0, true);
                    t1 = __builtin_amdgcn_cvt_pk_fp8_f32(C8(v[4]), C8(v[5]), t1, false); t1 = __builtin_amdgcn_cvt_pk_fp8_f32(C8(v[6]), C8(v[7]), t1, true);
#undef C8
                    w.x = (unsigned)t0; w.y = (unsigned)t1; *(u32x2v*)dst = w; } } }
    }
};
struct DualOrder : StaticOrder { __device__ bool next(int i, Unit& u) const { if (!StaticOrder::next(i >> 1, u)) return false; u.part = i & 1; return true; } };
struct EpiResF32 {
    static constexpr bool PERM = false, AFTER_DRAIN = false;
    float* C; const float* R; float alpha;
    __device__ __forceinline__ void operator()(const f32x4 (&acc)[2][2][4][2], const Unit& u, int wr, int wc, int fr, int fq) const {
        const int row0 = u.pm * BM + wr * 64 + fr, col0 = u.pn * BM + wc * 32 + 4 * fq;
#pragma unroll
        for (int ai = 0; ai < 2; ++ai)
#pragma unroll
            for (int m = 0; m < 4; ++m) { const size_t off = (size_t)(row0 + ai * HALF + m * 16) * 4096 + col0;
#pragma unroll
                for (int bj = 0; bj < 2; ++bj)
#pragma unroll
                    for (int n = 0; n < 2; ++n) { const f32x4 r = *(const f32x4*)(R + off + bj * HALF + n * 16); *(f32x4*)(C + off + bj * HALF + n * 16) = r * alpha + acc[ai][bj][m][n]; } }
    }
};
struct EpiPeerAct {
    static constexpr bool PERM = true, AFTER_DRAIN = false;
    unsigned char* Gd;
    __device__ __forceinline__ void operator()(const f32x4 (&acc)[2][2][4][2], const Unit& u, int wr, int wc, int fr, int fq) const {
        typedef unsigned u32x2v __attribute__((ext_vector_type(2)));
        const int row0 = u.pm * BM + wr * 64 + fr, col0 = u.pn * BM + wc * 32 + 8 * fq;
#pragma unroll
        for (int ai = 0; ai < 2; ++ai)
#pragma unroll
            for (int m = 0; m < 4; ++m) { unsigned char* rowp = Gd + (size_t)(row0 + ai * HALF + m * 16) * 16384 + col0;
#pragma unroll
                for (int bj = 0; bj < 2; ++bj) { const u32x2v gw = *(const u32x2v*)(rowp + bj * HALF);
                    if ((gw.x | gw.y) != 0u) {
                        float v[8];
#pragma unroll
                        for (int k = 0; k < 8; ++k) { const unsigned word = k < 4 ? gw.x : gw.y; const float gk = (k & 3) == 0 ? __builtin_amdgcn_cvt_f32_fp8((int)word, 0) : (k & 3) == 1 ? __builtin_amdgcn_cvt_f32_fp8((int)word, 1) : (k & 3) == 2 ? __builtin_amdgcn_cvt_f32_fp8((int)word, 2) : __builtin_amdgcn_cvt_f32_fp8((int)word, 3);
                            const float a = acc[ai][bj][m][k >> 2][k & 3]; v[k] = gk != 0.f ? __builtin_amdgcn_fmed3f(gk * 0.125f * a * (1.0f + erff(a * 0.7071067811865476f)), -448.f, 448.f) : 0.f; }
                        u32x2v w; int t0 = 0, t1 = 0; t0 = __builtin_amdgcn_cvt_pk_fp8_f32(v[0], v[1], t0, false); t0 = __builtin_amdgcn_cvt_pk_fp8_f32(v[2], v[3], t0, true);
                        t1 = __builtin_amdgcn_cvt_pk_fp8_f32(v[4], v[5], t1, false); t1 = __builtin_amdgcn_cvt_pk_fp8_f32(v[6], v[7], t1, true); w.x = (unsigned)t0; w.y = (unsigned)t1;
                        *(u32x2v*)(rowp + bj * HALF) = w; } } }
    }
};
}

__device__ __forceinline__ void p0_transpose_item(const float* W, int K, int N, bf16* WT, LAS float* scr, int item, int lane) {
    const int nblk = N / 32, kb = item / nblk, nb = item % nblk, k0 = 64 * kb, n0 = 32 * nb;
#pragma unroll 8
    for (int i = 0; i < 32; ++i) { const int kk = 2 * i + (lane >> 5); scr[kk * 33 + (lane & 31)] = W[(size_t)(k0 + kk) * N + n0 + (lane & 31)]; }
    LDS_WAIT(); asm volatile("" ::: "memory");
    const int c = lane & 7;
#pragma unroll
    for (int j = 0; j < 4; ++j) { const int n = (lane >> 3) + 8 * j; const LAS float* s = scr + (8 * c) * 33 + n;
        v4u o; o.x = pk2(s[0 * 33], s[1 * 33]); o.y = pk2(s[2 * 33], s[3 * 33]); o.z = pk2(s[4 * 33], s[5 * 33]); o.w = pk2(s[6 * 33], s[7 * 33]);
        *(GAS v4u*)(WT + (size_t)(n0 + n) * K + k0 + 8 * c) = o; }
    LDS_WAIT(); asm volatile("" ::: "memory");
}
__device__ __forceinline__ void p0_convert(const float* src, bf16* dst, size_t n8, size_t gtid, size_t gthreads) {
    for (size_t i = gtid; i < n8; i += gthreads) { const f32x4 a = *(const GAS f32x4*)(src + i * 8), b = *(const GAS f32x4*)(src + i * 8 + 4);
        v4u o; o.x = pk2(a.x, a.y); o.y = pk2(a.z, a.w); o.z = pk2(b.x, b.y); o.w = pk2(b.z, b.w); *(GAS v4u*)(dst + i * 8) = o; }
}

namespace att {
using s16x4  = __attribute__((ext_vector_type(4))) short;
using f32x16 = __attribute__((ext_vector_type(16))) float;
using u32x4  = __attribute__((ext_vector_type(4))) unsigned;
constexpr int NW = 8, QBLK = 32, KVBLK = 64, LDP = INW;
constexpr float LOG2E = 1.4426950408889634f, CQK = SCALE * LOG2E, THRL = 11.5f, NEGBIG = -1e30f;
constexpr int SHM_V = 16384, SHM_K = 16384;
constexpr int OFF_V = 0, OFF_K = 2 * SHM_V, OFF_WS = OFF_K + 2 * SHM_K, OFF_LUT = OFF_WS + NW * 64 * 4, OFF_GATE = OFF_LUT + 2176, GATE_W = 33 * 32 * 4, OFF_END = OFF_GATE + NW * GATE_W;
static_assert(OFF_END <= RING_BYTES, "attention LDS");
#define KSWZ(row, colB) ((row) * 256 + ((colB) ^ (((row) & 7) << 4)))
#define SBAR() __builtin_amdgcn_sched_barrier(0)
__device__ __forceinline__ int crow(int r, int hi) { return (r & 3) + 8 * (r >> 2) + 4 * hi; }
__device__ __forceinline__ unsigned cvtpk(float lo, float hi) { unsigned r; asm volatile("v_cvt_pk_bf16_f32 %0, %1, %2" : "=v"(r) : "v"(lo), "v"(hi)); return r; }

__device__ __forceinline__ void bias_far(f32x16& p0, f32x16& p1, float rowoff) {
#pragma unroll
  for (int r = 0; r < 16; ++r) { p0[r] = fmaf(p0[r], CQK, rowoff); p1[r] = fmaf(p1[r], CQK, rowoff); }
}
constexpr int LUT_DMAX = 207, LUT_N = 528;
__device__ __forceinline__ void bias_near(f32x16& p0, f32x16& p1, const LAS float* rl, int dist0  , int hi) {
  const LAS float* b = rl + (LUT_DMAX - dist0 + 4 * hi);
#pragma unroll
  for (int r = 0; r < 16; ++r) { const int c = (r & 3) + 8 * (r >> 2); p0[r] = fmaf(p0[r], CQK, b[c]); p1[r] = fmaf(p1[r], CQK, b[c + 32]); }
}
__device__ __forceinline__ void partialSM(f32x16& p0, f32x16& p1, float& m_reg, float& mn, float& alpha) {
  float pmax = p0[0];
#pragma unroll
  for (int r = 1; r < 16; ++r) pmax = fmaxf(pmax, p0[r]);
#pragma unroll
  for (int r = 0; r < 16; ++r) pmax = fmaxf(pmax, p1[r]);
  { auto rr = __builtin_amdgcn_permlane32_swap(__float_as_uint(pmax), __float_as_uint(pmax), false, false);
    pmax = fmaxf(__uint_as_float(rr[0]), __uint_as_float(rr[1])); }
  if (__builtin_expect(__all(pmax - m_reg <= THRL), 1)) { mn = m_reg; alpha = 1.f; }
  else { mn = fmaxf(m_reg, pmax); alpha = __builtin_amdgcn_exp2f(m_reg - mn); m_reg = mn; }
#pragma unroll
  for (int r = 0; r < 16; ++r) { p0[r] -= mn; p1[r] -= mn; }
#pragma unroll
  for (int r = 0; r < 16; ++r) p0[r] = __builtin_amdgcn_exp2f(p0[r]);
}
__device__ __forceinline__ void finishSM(f32x16& p0, f32x16& p1, float alpha, float& l_reg, bf16x8& pa0, bf16x8& pa1, bf16x8& pa2, bf16x8& pa3) {
#pragma unroll
  for (int r = 0; r < 16; ++r) p1[r] = __builtin_amdgcn_exp2f(p1[r]);
  float ps = 0;
#pragma unroll
  for (int r = 0; r < 16; ++r) ps += p0[r];
#pragma unroll
  for (int r = 0; r < 16; ++r) ps += p1[r];
  { auto rr = __builtin_amdgcn_permlane32_swap(__float_as_uint(ps), __float_as_uint(ps), false, false);
    ps = __uint_as_float(rr[0]) + __uint_as_float(rr[1]); }
  l_reg = l_reg * alpha + ps;
#define PK4(P, BASE, OUT) do { unsigned a0 = cvtpk(P[BASE + 0], P[BASE + 1]), a1 = cvtpk(P[BASE + 2], P[BASE + 3]);   \
    unsigned b0 = cvtpk(P[BASE + 4], P[BASE + 5]), b1 = cvtpk(P[BASE + 6], P[BASE + 7]);                              \
    auto r0 = __builtin_amdgcn_permlane32_swap(a0, b0, false, false); auto r1 = __builtin_amdgcn_permlane32_swap(a1, b1, false, false); \
    u32x4 w = {r0[0], r1[0], r0[1], r1[1]}; OUT = *reinterpret_cast<bf16x8*>(&w); } while (0)
  PK4(p0, 0, pa0); PK4(p0, 8, pa1); PK4(p1, 0, pa2); PK4(p1, 8, pa3);
#undef PK4
}
__device__ __forceinline__ void qkt(f32x16& p0, f32x16& p1, const LAS char* Ks, const bf16x8* qr, int r32, int hi) {
  p0 = f32x16{}; p1 = f32x16{};
#pragma unroll
  for (int d0 = 0; d0 < 8; ++d0) { const int cb = (d0 * 16 + hi * 8) * 2;
    const bf16x8 b0 = *reinterpret_cast<const LAS bf16x8*>(Ks + KSWZ(r32, cb));
    const bf16x8 b1 = *reinterpret_cast<const LAS bf16x8*>(Ks + KSWZ(32 + r32, cb));
    p0 = __builtin_amdgcn_mfma_f32_32x32x16_bf16(b0, qr[d0], p0, 0, 0, 0);
    p1 = __builtin_amdgcn_mfma_f32_32x32x16_bf16(b1, qr[d0], p1, 0, 0, 0); }
}
__device__ __forceinline__ int v_st(int k, int c) { const int kk = (k & ~0xC) | ((k & 4) << 1) | ((k & 8) >> 1); return ((kk >> 3) * 4 + (c >> 5)) * 512 + ((kk & 7) * 32 + (c & 31)) * 2; }
__device__ __forceinline__ int v_rd_base(int lane) { return ((lane & 3) << 3) | (((lane >> 2) & 3) << 6) | (((lane >> 4) & 1) << 5) | (((lane >> 5) & 1) << 8); }
constexpr int v_rd_off(int d0, int ks, int half) { return d0 * 512 + ks * 4096 + half * 2048; }
template <int OFF> __device__ __forceinline__ s16x4 tr_read(int vb) {
  s16x4 r; asm volatile("ds_read_b64_tr_b16 %0, %1 offset:%2" : "=&v"(r) : "v"(vb), "i"(OFF) : "memory"); return r;
}
template <int D0> __device__ __forceinline__ void pv_one(f32x16& od, int vb, bf16x8 pa0, bf16x8 pa1, bf16x8 pa2, bf16x8 pa3) {
  const s16x4 l0 = tr_read<v_rd_off(D0, 0, 0)>(vb), h0 = tr_read<v_rd_off(D0, 0, 1)>(vb), l1 = tr_read<v_rd_off(D0, 1, 0)>(vb), h1 = tr_read<v_rd_off(D0, 1, 1)>(vb);
  const s16x4 l2 = tr_read<v_rd_off(D0, 2, 0)>(vb), h2 = tr_read<v_rd_off(D0, 2, 1)>(vb), l3 = tr_read<v_rd_off(D0, 3, 0)>(vb), h3 = tr_read<v_rd_off(D0, 3, 1)>(vb);
  asm volatile("s_waitcnt lgkmcnt(0)" ::: "memory"); SBAR();
#define PK(L, H) (bf16x8){L[0], L[1], L[2], L[3], H[0], H[1], H[2], H[3]}
  od = __builtin_amdgcn_mfma_f32_32x32x16_bf16(pa0, PK(l0, h0), od, 0, 0, 0);
  od = __builtin_amdgcn_mfma_f32_32x32x16_bf16(pa1, PK(l1, h1), od, 0, 0, 0);
  od = __builtin_amdgcn_mfma_f32_32x32x16_bf16(pa2, PK(l2, h2), od, 0, 0, 0);
  od = __builtin_amdgcn_mfma_f32_32x32x16_bf16(pa3, PK(l3, h3), od, 0, 0, 0);
#undef PK
}
__device__ __forceinline__ void pv_d0(f32x16* o, int vb, bf16x8 pa0, bf16x8 pa1, bf16x8 pa2, bf16x8 pa3) {
  pv_one<0>(o[0], vb, pa0, pa1, pa2, pa3); pv_one<1>(o[1], vb, pa0, pa1, pa2, pa3); pv_one<2>(o[2], vb, pa0, pa1, pa2, pa3); pv_one<3>(o[3], vb, pa0, pa1, pa2, pa3);
}

struct UnitDesc { const bf16* Q; const bf16* K; const bf16* V; bf16* O; int ldo; int o8;   int qb; int bias_head; const bf16* kmean;   };

__device__ __forceinline__ void attn_unit(const UnitDesc& u, const float* __restrict__ rel_bias, LAS char* lds, const int wave_id) {
  int tid_ = wave_id * 64 + lane_id(); asm volatile("" : "+v"(tid_));
  const int tid = tid_, wid = tid >> 6, lane = tid & 63, r32 = lane & 31, hi = lane >> 5;
  LAS char* V_lds = lds + OFF_V; LAS char* K_lds = lds + OFF_K;
  LAS float* wsl = (LAS float*)(lds + OFF_WS) + wid * 64; LAS float* li_l = wsl; LAS float* al_l = wsl + 32;
  LAS float* lut = (LAS float*)(lds + OFF_LUT);
  const int q0 = u.qb * 256, qw0 = q0 + wid * QBLK, qpos = qw0 + r32;
  __syncthreads();
  for (int i = tid; i < LUT_N; i += 512) { const int d = LUT_DMAX - i; lut[i] = d < 0 ? NEGBIG : rel_bias[t5_bucket(d > 127 ? 127 : d) * 24 + u.bias_head] * LOG2E; }
  float m_reg = NEGBIG, l_reg = 0; f32x16 o[4] = {}; bf16x8 qr[8];
  const bf16* Qw = u.Q + (size_t)(qw0 + r32) * LDP + hi * 8;
#pragma unroll
  for (int d0 = 0; d0 < 8; ++d0) qr[d0] = *reinterpret_cast<const bf16x8*>(Qw + d0 * 16);
  unsigned rowmask = 0xffffffffu;
  if (u.kmean) {
    { const int r = tid >> 4, c = (tid & 15) * 8;
      *reinterpret_cast<LAS bf16x8*>(K_lds + KSWZ(r, c * 2)) = *reinterpret_cast<const bf16x8*>(u.kmean + r * 128 + c); }
    __syncthreads();
    f32x16 g0 = f32x16{};
#pragma unroll
    for (int d0 = 0; d0 < 8; ++d0) { const int cb = (d0 * 16 + hi * 8) * 2;
      const bf16x8 b0 = *reinterpret_cast<const LAS bf16x8*>(K_lds + KSWZ(r32, cb));
      g0 = __builtin_amdgcn_mfma_f32_32x32x16_bf16(b0, qr[d0], g0, 0, 0, 0); }
    LAS float* gs = (LAS float*)(lds + OFF_GATE + wid * GATE_W);
#pragma unroll
    for (int r = 0; r < 16; ++r) gs[r32 * 33 + crow(r, hi)] = g0[r];
    asm volatile("s_waitcnt lgkmcnt(0)" ::: "memory");
    __builtin_amdgcn_wave_barrier();
    float b1v = NEGBIG, b2v = NEGBIG, b3v = NEGBIG; int b1i = -1, b2i = -1, b3i = -1;
    for (int j = 0; j < u.qb; ++j) { const float g = gs[r32 * 33 + j];
      if (g > b1v) { b3v = b2v; b3i = b2i; b2v = b1v; b2i = b1i; b1v = g; b1i = j; }
      else if (g > b2v) { b3v = b2v; b3i = b2i; b2v = g; b2i = j; }
      else if (g > b3v) { b3v = g; b3i = j; } }
    rowmask = 1u << u.qb;
    if (b1i >= 0) rowmask |= 1u << b1i; if (b2i >= 0) rowmask |= 1u << b2i; if (b3i >= 0) rowmask |= 1u << b3i;
    __syncthreads();
  }
  const int sr = tid >> 4, sc = (tid & 15) * 8, vst0 = v_st(sr, sc), vst1 = v_st(32 + sr, sc);
  const int vb0 = (int)(uintptr_t)V_lds + v_rd_base(lane);
  struct { bf16x8 vs0, vs1, ks0, ks1; } sr_[2];
  const bf16* Kh = u.K; const bf16* Vh = u.V;
#define SLOAD(i, k0) do { sr_[i].vs0 = *reinterpret_cast<const bf16x8*>(&Vh[(size_t)((k0) + sr) * LDP + sc]); sr_[i].vs1 = *reinterpret_cast<const bf16x8*>(&Vh[(size_t)((k0) + 32 + sr) * LDP + sc]); \
    sr_[i].ks0 = *reinterpret_cast<const bf16x8*>(&Kh[(size_t)((k0) + sr) * LDP + sc]); sr_[i].ks1 = *reinterpret_cast<const bf16x8*>(&Kh[(size_t)((k0) + 32 + sr) * LDP + sc]); } while (0)
#define SWRITE(b, i) do { *(LAS bf16x8*)(V_lds + (b) * SHM_V + vst0) = sr_[i].vs0; *(LAS bf16x8*)(V_lds + (b) * SHM_V + vst1) = sr_[i].vs1; const int kc = sc * 2; \
    *(LAS bf16x8*)(K_lds + (b) * SHM_K + KSWZ(sr, kc)) = sr_[i].ks0; *(LAS bf16x8*)(K_lds + (b) * SHM_K + KSWZ(32 + sr, kc)) = sr_[i].ks1; } while (0)
#define SWAIT() asm volatile("s_waitcnt vmcnt(4)" ::: "memory")
#define RESC(a) do { if (__any((a) < 1.f)) { if (hi == 0) al_l[r32] = (a); asm volatile("s_waitcnt lgkmcnt(0)" ::: "memory"); \
    _Pragma("unroll") for (int d = 0; d < 4; ++d) _Pragma("unroll") for (int r = 0; r < 16; ++r) o[d][r] *= al_l[crow(r, hi)]; } } while (0)
#define BIAS(P0, P1, j) do { const int k0_ = (j) * KVBLK; const bool allowed_ = (rowmask >> ((j) >> 2)) & 1u; \
    if (qw0 - k0_ - 63 >= 113) bias_far(P0, P1, allowed_ ? b31c : NEGBIG); else bias_near(P0, P1, lut, allowed_ ? qpos - k0_ : -64, hi); } while (0)
  f32x16 pA0, pA1, pB0, pB1; float mnA, mnB, alA, alB; bf16x8 pa0, pa1, pa2, pa3; const int NT = 4 * (u.qb + 1);
  constexpr int SE = 0, SO = 1;
  SLOAD(SE, 0); asm volatile("s_waitcnt vmcnt(0)" ::: "memory"); SWRITE(0, SE); __syncthreads();
  const float b31c = lut[LUT_DMAX - 127];
  qkt(pA0, pA1, K_lds, qr, r32, hi); BIAS(pA0, pA1, 0); partialSM(pA0, pA1, m_reg, mnA, alA);
  SLOAD(SO, KVBLK); if (2 < NT) SLOAD(SE, 2 * KVBLK);
  SWAIT(); SWRITE(1, SO); __syncthreads();
  for (int j = 1; j + 1 < NT; j += 2) {
    SBAR(); qkt(pB0, pB1, K_lds + SHM_K, qr, r32, hi);
    finishSM(pA0, pA1, alA, l_reg, pa0, pa1, pa2, pa3); SBAR();
    SLOAD(SO, (j + 2) * KVBLK); SBAR();
    pv_d0(o, vb0, pa0, pa1, pa2, pa3); BIAS(pB0, pB1, j); partialSM(pB0, pB1, m_reg, mnB, alB);
    __syncthreads(); SWAIT(); SWRITE(0, SE);
    RESC(alB); __syncthreads();
    SBAR(); qkt(pA0, pA1, K_lds, qr, r32, hi);
    finishSM(pB0, pB1, alB, l_reg, pa0, pa1, pa2, pa3); SBAR();
    if (j + 3 < NT) SLOAD(SE, (j + 3) * KVBLK); SBAR();
    pv_d0(o, vb0 + SHM_V, pa0, pa1, pa2, pa3); BIAS(pA0, pA1, j + 1); partialSM(pA0, pA1, m_reg, mnA, alA);
    __syncthreads(); SWAIT(); SWRITE(1, SO);
    RESC(alA); __syncthreads();
  }
  SBAR(); qkt(pB0, pB1, K_lds + SHM_K, qr, r32, hi);
  finishSM(pA0, pA1, alA, l_reg, pa0, pa1, pa2, pa3); SBAR();
  pv_d0(o, vb0, pa0, pa1, pa2, pa3); BIAS(pB0, pB1, NT - 1); partialSM(pB0, pB1, m_reg, mnB, alB);
  __syncthreads(); RESC(alB);
  finishSM(pB0, pB1, alB, l_reg, pa0, pa1, pa2, pa3); SBAR();
  pv_d0(o, vb0 + SHM_V, pa0, pa1, pa2, pa3);
  if (hi == 0) li_l[r32] = l_reg; asm volatile("s_waitcnt lgkmcnt(0)" ::: "memory");
  float rli[16];
#pragma unroll
  for (int r = 0; r < 16; ++r) rli[r] = __builtin_amdgcn_rcpf(li_l[crow(r, hi)]);
  if (u.o8) { unsigned char* Ow = (unsigned char*)u.O + (size_t)qw0 * u.ldo;
#pragma unroll
    for (int r = 0; r < 16; ++r) { const int orow = crow(r, hi);
#pragma unroll
      for (int d0 = 0; d0 < 4; ++d0) Ow[(size_t)orow * u.ldo + d0 * 32 + r32] = (unsigned char)(pk4_fp8(o[d0][r] * rli[r] * 64.0f, 0.f, 0.f, 0.f) & 0xffu); } }
  else { bf16* Ow = u.O + (size_t)qw0 * u.ldo;
#pragma unroll
    for (int r = 0; r < 16; ++r) { const int orow = crow(r, hi);
#pragma unroll
      for (int d0 = 0; d0 < 4; ++d0) Ow[(size_t)orow * u.ldo + d0 * 32 + r32] = (bf16)f2bf(o[d0][r] * rli[r]); } }
#undef SLOAD
#undef SWRITE
#undef SWAIT
#undef RESC
#undef BIAS
}
}

__device__ __forceinline__ void p0_transpose_item8(const float* W, int K, int N, unsigned char* WT, float scale, LAS float* scr, int item, int lane) {
    const int nblk = N / 32, kb = item / nblk, nb = item % nblk, k0 = 64 * kb, n0 = 32 * nb;
#pragma unroll 8
    for (int i = 0; i < 32; ++i) { const int kk = 2 * i + (lane >> 5); scr[kk * 33 + (lane & 31)] = W[(size_t)(k0 + kk) * N + n0 + (lane & 31)]; }
    LDS_WAIT(); asm volatile("" ::: "memory");
    const int n = lane >> 1, kh = (lane & 1) * 32; const LAS float* sp = scr + kh * 33 + n;
    v4u o0, o1;
    o0.x = pk4_fp8(sp[0 * 33] * scale, sp[1 * 33] * scale, sp[2 * 33] * scale, sp[3 * 33] * scale); o0.y = pk4_fp8(sp[4 * 33] * scale, sp[5 * 33] * scale, sp[6 * 33] * scale, sp[7 * 33] * scale);
    o0.z = pk4_fp8(sp[8 * 33] * scale, sp[9 * 33] * scale, sp[10 * 33] * scale, sp[11 * 33] * scale); o0.w = pk4_fp8(sp[12 * 33] * scale, sp[13 * 33] * scale, sp[14 * 33] * scale, sp[15 * 33] * scale);
    o1.x = pk4_fp8(sp[16 * 33] * scale, sp[17 * 33] * scale, sp[18 * 33] * scale, sp[19 * 33] * scale); o1.y = pk4_fp8(sp[20 * 33] * scale, sp[21 * 33] * scale, sp[22 * 33] * scale, sp[23 * 33] * scale);
    o1.z = pk4_fp8(sp[24 * 33] * scale, sp[25 * 33] * scale, sp[26 * 33] * scale, sp[27 * 33] * scale); o1.w = pk4_fp8(sp[28 * 33] * scale, sp[29 * 33] * scale, sp[30 * 33] * scale, sp[31 * 33] * scale);
    GAS v4u* dst = (GAS v4u*)(WT + (size_t)(n0 + n) * K + k0 + kh); dst[0] = o0; dst[1] = o1;
    LDS_WAIT(); asm volatile("" ::: "memory");
}
struct TrJob { const float* W; unsigned char* WT; int K, N; float scale; int f8; int item; };
__device__ __forceinline__ void tr_load(const TrJob& j, f32x4 (&v)[16], int lane) {
    const int nblk = j.N / 64, kb = j.item / nblk, nb = j.item % nblk; const float* p = j.W + (size_t)(64 * kb + (lane >> 4)) * j.N + 64 * nb + 4 * (lane & 15);
#pragma unroll
    for (int i = 0; i < 16; ++i) v[i] = *(const GAS f32x4*)(p + (size_t)(4 * i) * j.N);
}
__device__ __forceinline__ void tr_to_lds(const f32x4 (&v)[16], LAS float* scr, int lane) {
#pragma unroll
    for (int i = 0; i < 16; ++i) *(LAS f32x4*)(scr + (4 * i + (lane >> 4)) * 64 + 4 * (lane & 15)) = v[i];
}
__device__ __forceinline__ void tr_finish(const TrJob& j, LAS float* scr, int lane) {
    const int nblk = j.N / 64, kb = j.item / nblk, nb = j.item % nblk, k0 = 64 * kb, n0 = 64 * nb, part = lane & 3;
    LDS_WAIT(); asm volatile("" ::: "memory");
#pragma unroll
    for (int p = 0; p < 4; ++p) { const int n = 16 * p + (lane >> 2); const LAS float* sp = scr + (16 * part) * 64 + n; float x[16];
#pragma unroll
        for (int q = 0; q < 16; ++q) x[q] = sp[q * 64] * j.scale;
        if (j.f8) { v4u o; o.x = pk4_fp8(x[0], x[1], x[2], x[3]); o.y = pk4_fp8(x[4], x[5], x[6], x[7]); o.z = pk4_fp8(x[8], x[9], x[10], x[11]); o.w = pk4_fp8(x[12], x[13], x[14], x[15]);
            *(GAS v4u*)(j.WT + (size_t)(n0 + n) * j.K + k0 + 16 * part) = o; }
        else { v4u o0, o1; o0.x = pk2(x[0], x[1]); o0.y = pk2(x[2], x[3]); o0.z = pk2(x[4], x[5]); o0.w = pk2(x[6], x[7]); o1.x = pk2(x[8], x[9]); o1.y = pk2(x[10], x[11]); o1.z = pk2(x[12], x[13]); o1.w = pk2(x[14], x[15]);
            GAS v4u* d = (GAS v4u*)(j.WT + ((size_t)(n0 + n) * j.K + k0 + 16 * part) * 2); d[0] = o0; d[1] = o1; } }
    LDS_WAIT(); asm volatile("" ::: "memory");
}
__device__ __forceinline__ void p0_convert8(const float* src, unsigned char* dst, float scale, size_t n16, size_t gtid, size_t gthreads) {
    for (size_t i = gtid; i < n16; i += gthreads) { const GAS f32x4* p = (const GAS f32x4*)(src + i * 16); const f32x4 a = p[0] * scale, b = p[1] * scale, c = p[2] * scale, d = p[3] * scale;
        v4u o; o.x = pk4_fp8(a.x, a.y, a.z, a.w); o.y = pk4_fp8(b.x, b.y, b.z, b.w); o.z = pk4_fp8(c.x, c.y, c.z, c.w); o.w = pk4_fp8(d.x, d.y, d.z, d.w); *(GAS v4u*)(dst + i * 16) = o; }
}

namespace rt {
using f32x16 = __attribute__((ext_vector_type(16))) float;
__device__ __forceinline__ void ins16(float (&val)[16], int (&idx)[16], float v, int i) {
#pragma unroll
    for (int s = 0; s < 16; ++s) { const bool gt = v > val[s]; const float tv = gt ? val[s] : v; const int ti = gt ? idx[s] : i; val[s] = gt ? v : val[s]; idx[s] = gt ? i : idx[s]; v = tv; i = ti; }
}
__device__ __forceinline__ void side_top16(const bf16* q, const bf16* keys, int r32, int hi, float (&val)[16], int (&idx)[16]) {
    bf16x8 qf[8];
#pragma unroll
    for (int d0 = 0; d0 < 8; ++d0) qf[d0] = *reinterpret_cast<const bf16x8*>(q + d0 * 16 + hi * 8);
    f32x16 acc[4];
#pragma unroll
    for (int nb = 0; nb < 4; ++nb) { acc[nb] = f32x16{};
#pragma unroll
        for (int d0 = 0; d0 < 8; ++d0) { const bf16x8 kf = *reinterpret_cast<const bf16x8*>(keys + (32 * nb + r32) * 128 + d0 * 16 + hi * 8);
            acc[nb] = __builtin_amdgcn_mfma_f32_32x32x16_bf16(kf, qf[d0], acc[nb], 0, 0, 0); } }
#pragma unroll
    for (int s = 0; s < 16; ++s) { val[s] = -3.0e38f; idx[s] = 0; }
#pragma unroll
    for (int nb = 0; nb < 4; ++nb)
#pragma unroll
        for (int r = 0; r < 16; ++r) ins16(val, idx, acc[nb][r], 32 * nb + (r & 3) + 8 * (r >> 2) + 4 * hi);
    float pv[16]; int pi[16];
#pragma unroll
    for (int s = 0; s < 16; ++s) { pv[s] = __shfl_xor(val[s], 32); pi[s] = __shfl_xor(idx[s], 32); }
#pragma unroll
    for (int s = 0; s < 16; ++s) ins16(val, idx, pv[s], pi[s]);
}
template <int I, int J> struct Cand {
    static __device__ __forceinline__ void run(float (&cv)[16], int (&ci)[16], const float (&v1)[16], const float (&v2)[16], const int (&i1)[16], const int (&i2)[16]) {
        if constexpr ((I + 1) * (J + 1) <= 16) { ins16(cv, ci, v1[I] + v2[J], i1[I] * 128 + i2[J]); Cand<I, J + 1>::run(cv, ci, v1, v2, i1, i2); }
        else if constexpr (I + 1 < 16) Cand<I + 1, 0>::run(cv, ci, v1, v2, i1, i2);
    }
};
template <int I> struct Cand<I, 16> { static __device__ __forceinline__ void run(float (&cv)[16], int (&ci)[16], const float (&v1)[16], const float (&v2)[16], const int (&i1)[16], const int (&i2)[16]) {
        if constexpr (I + 1 < 16) Cand<I + 1, 0>::run(cv, ci, v1, v2, i1, i2); } };
constexpr int OFF_E = 0, OFF_G = 16384;
__device__ __forceinline__ void route_block(int t0, const bf16* PQ, const bf16* KEYSB, unsigned char* GD, int* EIDX, float* GATES, LAS char* lds, const int wave_id) {
    int tid_ = wave_id * 64 + lane_id(); asm volatile("" : "+v"(tid_));
    const int tid = tid_, h = tid >> 6, lane = tid & 63, r32 = lane & 31, hi = lane >> 5;
    LAS int* ent_e = (LAS int*)(lds + OFF_E); LAS float* ent_g = (LAS float*)(lds + OFF_G);
    __syncthreads();
    const bf16* q = PQ + (size_t)(t0 + r32) * 2048 + h * 256;
    float v1[16], v2[16], cv[16]; int i1[16], i2[16], ci[16];
    side_top16(q, KEYSB, r32, hi, v1, i1);
    side_top16(q + 128, KEYSB + 128 * 128, r32, hi, v2, i2);
#pragma unroll
    for (int s = 0; s < 16; ++s) { cv[s] = -3.0e38f; ci[s] = 0; }
    Cand<0, 0>::run(cv, ci, v1, v2, i1, i2);
    const float mx = cv[0]; float sum = 0.f;
#pragma unroll
    for (int s = 0; s < 16; ++s) { cv[s] = __expf(cv[s] - mx); sum += cv[s]; }
    const float inv = 1.0f / sum;
    if (hi == 0) {
#pragma unroll
        for (int s = 0; s < 16; ++s) { ent_e[r32 * 128 + h * 16 + s] = ci[s]; ent_g[r32 * 128 + h * 16 + s] = cv[s] * inv; }
        if (EIDX) {
#pragma unroll
            for (int s = 0; s < 16; ++s) { EIDX[(size_t)(t0 + r32) * 128 + h * 16 + s] = ci[s]; GATES[(size_t)(t0 + r32) * 128 + h * 16 + s] = cv[s] * inv; } }
    }
    __syncthreads();
    { const int tok = tid >> 4, s0 = (tid & 15) * 8;
        for (int k = 0; k < 8; ++k) { const int sidx = s0 + k, e = ent_e[tok * 128 + sidx]; float g = 0.f; bool first = true;
            for (int s2 = 0; s2 < 128; ++s2) { if (ent_e[tok * 128 + s2] == e) { g += ent_g[tok * 128 + s2]; if (s2 < sidx) first = false; } }
            if (first) GD[(size_t)(t0 + tok) * 16384 + e] = (unsigned char)(pk4_fp8(g * 256.f, 0.f, 0.f, 0.f) & 0xffu); } }
}
}

__device__ __forceinline__ float wave_sum(float v) {
#pragma unroll
    for (int o = 1; o < 64; o <<= 1) v += __shfl_xor(v, o);
    return v;
}
__device__ __forceinline__ void ln_row(const float* in, const float* g, const float* b, float* outf, bf16* outb, unsigned char* outq, int lane) {
    f32x4 v[16]; float s = 0.f;
#pragma unroll
    for (int j = 0; j < 16; ++j) { v[j] = *(const GAS f32x4*)(in + 256 * j + 4 * lane); s += (v[j].x + v[j].y) + (v[j].z + v[j].w); }
    const float mean = wave_sum(s) * (1.0f / DM); float s2 = 0.f;
#pragma unroll
    for (int j = 0; j < 16; ++j) { v[j] = v[j] - mean; s2 += (v[j].x * v[j].x + v[j].y * v[j].y) + (v[j].z * v[j].z + v[j].w * v[j].w); }
    const float rstd = rsqrtf(wave_sum(s2) * (1.0f / DM) + LN_EPS);
#pragma unroll
    for (int j = 0; j < 16; ++j) { const f32x4 gv = *(const GAS f32x4*)(g + 256 * j + 4 * lane), bv = *(const GAS f32x4*)(b + 256 * j + 4 * lane); const f32x4 y = v[j] * rstd * gv + bv;
        *(GAS f32x4*)(outf + 256 * j + 4 * lane) = y;
        if (outb) { v2u o; o.x = pk2(y.x, y.y); o.y = pk2(y.z, y.w); *(GAS v2u*)(outb + 256 * j + 4 * lane) = o; }
        if (outq) *(GAS unsigned*)(outq + 256 * j + 4 * lane) = pk4_fp8(y.x, y.y, y.z, y.w); }
}

struct Args { const float* in[21]; float* out; unsigned char* ws; int ph_lo, ph_hi; };
constexpr size_t WS_CTL = 0, WS_KMEANB = 1 * MiB, WS_KEYSB = 1 * MiB + 512 * 1024;
constexpr size_t WS_WINT = 2 * MiB, WS_MERGED = 2 * MiB, WS_X1B = 66 * MiB, WS_PQ = 130 * MiB;
constexpr size_t WS_XB = 162 * MiB, WS_YA = 162 * MiB, WS_YB = 194 * MiB;
constexpr size_t WS_PROJ = 226 * MiB, WS_G = 226 * MiB;
constexpr size_t WS_OP0 = 546 * MiB, WS_OP1 = 578 * MiB, WS_WOA = 610 * MiB, WS_WOB = 626 * MiB, WS_WOUT = 642 * MiB, WS_WQ = 674 * MiB, WS_UB = 690 * MiB, WS_VT = 818 * MiB, WS_X1F = 946 * MiB;
constexpr size_t WS_EIDX = 1074 * MiB, WS_GATES = 1078 * MiB, WS_NEED = 1082 * MiB;

__global__ void __launch_bounds__(NWAVES * 64, 2) mega_fwd(Args args) {
    extern __shared__ __attribute__((aligned(16))) unsigned char lds_raw[];
    LAS unsigned char* lds = (LAS unsigned char*)lds_raw;
    volatile LAS unsigned* MISC = (volatile LAS unsigned*)(lds + MISC_OFF);
    const int wave = __builtin_amdgcn_readfirstlane((int)threadIdx.x >> 6);
#define lane (lane_id())
#define tid (wave * 64 + lane_id())
    const int G = gridDim.x; const int vcu = (G % 8 == 0) ? ((int)blockIdx.x % 8) * (G / 8) + (int)blockIdx.x / 8 : (int)blockIdx.x;
    unsigned char* ws = args.ws;
    gu32* ctl = (gu32*)(ws + WS_CTL);
    for (int u = tid; u < (LDS_BYTES - LDSCTL_OFF) / 4; u += NWAVES * 64) ((LAS unsigned*)(lds + LDSCTL_OFF))[u] = 0u;
    __syncthreads();
    XcdBarrier bar = xcd_barrier_post((unsigned*)(ctl + CW_BAR), MISC + 8);
    const int lo = args.ph_lo, hi = args.ph_hi;
#define IN(k) (lo <= (k) && (k) < hi)
#define BOTH(k) (IN(k) && IN((k) + 1))
#define WINT ((bf16*)(ws + WS_WINT))
#define XB ((bf16*)(ws + WS_XB))
#define PROJ ((bf16*)(ws + WS_PROJ))

#define MERGED ((bf16*)(ws + WS_MERGED))
#define X1B ((bf16*)(ws + WS_X1B))
#define PQ ((bf16*)(ws + WS_PQ))
#define GD ((bf16*)(ws + WS_G))
#define WOA ((bf16*)(ws + WS_WOA))
#define WOB ((bf16*)(ws + WS_WOB))
#define WOUT ((bf16*)(ws + WS_WOUT))
#define WQ ((bf16*)(ws + WS_WQ))
#define UB ((bf16*)(ws + WS_UB))
#define VT ((bf16*)(ws + WS_VT))
#define KEYSB ((bf16*)(ws + WS_KEYSB))
#define X1F ((float*)(ws + WS_X1F))
#define X1Q ((unsigned char*)(ws + WS_OP0))
    if (IN(0)) {
        LAS float* scr = (LAS float*)(lds + wave * 16384);
        const int gw = vcu * NWAVES + wave, NGW = G * NWAVES;
        constexpr int I_IN = (DM / 64) * (INW / 64), I_OA = (2048 / 64) * (DM / 64), I_OUT = (DM / 64) * (DM / 64), I_WQ = (DM / 64) * (2048 / 64), I_V = (16384 / 64) * (DM / 64), I_ALL = I_IN + 2 * I_OA + I_OUT + I_WQ + I_V;
#define TR_DECODE(it_, J) do { int r_ = (it_); \
            if (r_ < I_IN) { J.W = args.in[1]; J.WT = (unsigned char*)WINT; J.K = DM; J.N = INW; J.scale = 64.f; J.f8 = 1; } else { r_ -= I_IN; \
            if (r_ < I_OA) { J.W = args.in[9]; J.WT = (unsigned char*)WOA; J.K = 2048; J.N = DM; J.scale = 64.f; J.f8 = 1; } else { r_ -= I_OA; \
            if (r_ < I_OA) { J.W = args.in[10]; J.WT = (unsigned char*)WOB; J.K = 2048; J.N = DM; J.scale = 64.f; J.f8 = 1; } else { r_ -= I_OA; \
            if (r_ < I_OUT) { J.W = args.in[11]; J.WT = (unsigned char*)WOUT; J.K = DM; J.N = DM; J.scale = 64.f; J.f8 = 1; } else { r_ -= I_OUT; \
            if (r_ < I_WQ) { J.W = args.in[14]; J.WT = (unsigned char*)WQ; J.K = DM; J.N = 2048; J.scale = 1.f; J.f8 = 0; } else { r_ -= I_WQ; \
            J.W = args.in[18]; J.WT = (unsigned char*)VT; J.K = 16384; J.N = DM; J.scale = 8.f; J.f8 = 1; } } } } } J.item = r_; } while (0)
        { TrJob jc, jn; f32x4 tv[16]; int it = gw;
          if (it < I_ALL) { TR_DECODE(it, jc); tr_load(jc, tv, lane); }
          while (it < I_ALL) { const int nx = it + NGW; tr_to_lds(tv, scr, lane);
              if (nx < I_ALL) { TR_DECODE(nx, jn); tr_load(jn, tv, lane); }
              tr_finish(jc, scr, lane); jc = jn; it = nx; } }
#undef TR_DECODE
        const size_t gtid = (size_t)blockIdx.x * 512 + tid, gth = (size_t)G * 512;
        p0_convert8(args.in[0], (unsigned char*)XB, 1.0f, (size_t)S * DM / 16, gtid, gth);
        p0_convert8(args.in[17], (unsigned char*)UB, 64.0f, (size_t)16384 * DM / 16, gtid, gth);
        p0_convert(args.in[15], KEYSB, 128 * 128 / 8, gtid, gth);
        p0_convert(args.in[16], KEYSB + 128 * 128, 128 * 128 / 8, gtid, gth);
        if (BOTH(0)) xcd_barrier(bar);
    }
    if (IN(1)) {
        pg8::Gemm g{XB, WINT, XB, WINT, S, INW, DM / 2, (int)(0x01010101u * (127 - 6)), 0}; pg8::StaticOrder So; So.init(S, INW, G, (int)blockIdx.x);
        pg8::EpiStoreBf16 E{PROJ, INW};
        pg8::gemm_phase<pg8::EpiStoreBf16, pg8::StaticOrder, true, false, true>(lds, g, So, E, wave);
        if (BOTH(1)) xcd_barrier(bar);
    }

#define KMEANB ((bf16*)(ws + WS_KMEANB))
#define YA ((bf16*)(ws + WS_YA))
#define YB ((bf16*)(ws + WS_YB))
#define OP0 ((bf16*)(ws + WS_OP0))
#define OP1 ((bf16*)(ws + WS_OP1))
    if (IN(2)) {
        for (int it = vcu * NWAVES + wave; it < 16 * 32; it += G * NWAVES) { const int h = it >> 5, j = it & 31;
            const bf16* kp = PROJ + (size_t)(j * 256) * INW + 2048 + h * 128 + 2 * lane; float s0 = 0.f, s1 = 0.f;
            for (int i = 0; i < 256; ++i) { const unsigned w = *(const unsigned*)(kp + (size_t)i * INW); s0 += bflo(w); s1 += bfhi(w); }
            *(unsigned*)(KMEANB + (size_t)it * 128 + 2 * lane) = pk2(s0 * (1.0f / 256.0f), s1 * (1.0f / 256.0f)); }
        if (BOTH(2)) xcd_barrier(bar);
    }
    if (IN(3)) {
#pragma nounroll
        for (int p = (int)blockIdx.x; p < 768; p += G) {
            const int xcd = p & 7, rank = (p >> 3) & 31, slot = p >> 8, t = rank & 15, gsel = rank >> 4;
#pragma nounroll
            for (int sub = 0; sub < 2; ++sub) {
                att::UnitDesc u; u.qb = sub == 0 ? 31 - t : t; u.ldo = 2048;
                if (slot == 0) { const int h = 2 * xcd + gsel; u.Q = PROJ + h * 128; u.K = PROJ + 2048 + h * 128; u.V = PROJ + 4096 + h * 128; u.O = (bf16*)((unsigned char*)YA + h * 128); u.o8 = 1; u.bias_head = h; u.kmean = KMEANB + (size_t)h * 32 * 128; }
                else { const int pm = slot - 1, h = xcd; u.Q = PROJ + 6144 + h * 256 + pm * 128; u.K = PROJ + 8192 + h * 256 + pm * 128; u.V = PROJ + 10240 + h * 256 + gsel * 128;
                       u.O = (pm ? OP1 : OP0) + h * 256 + gsel * 128; u.o8 = 0; u.bias_head = 16 + h; u.kmean = nullptr; }
                att::attn_unit(u, args.in[3], (LAS char*)lds, wave);
            }
        }
        if (BOTH(3)) xcd_barrier(bar);
    }
    if (IN(4)) {
        float a = args.in[4][lane] * args.in[5][lane] + args.in[4][lane + 64] * args.in[5][lane + 64], b = args.in[6][lane] * args.in[7][lane] + args.in[6][lane + 64] * args.in[7][lane + 64];
#pragma unroll
        for (int o = 1; o < 64; o <<= 1) { a += __shfl_xor(a, o); b += __shfl_xor(b, o); }
        const float lam = expf(a) - expf(b) + LAMBDA_INIT;
        const f32x4 gsub = *(const GAS f32x4*)(args.in[8] + 4 * lane);
        for (int it = vcu * NWAVES + wave; it < S * 8; it += G * NWAVES) { const size_t off = (size_t)(it >> 3) * 2048 + (it & 7) * 256 + 4 * lane;
            const v2u w0 = *(const GAS v2u*)(OP0 + off), w1 = *(const GAS v2u*)(OP1 + off);
            const float y0 = bflo(w0.x) - lam * bflo(w1.x), y1 = bfhi(w0.x) - lam * bfhi(w1.x), y2 = bflo(w0.y) - lam * bflo(w1.y), y3 = bfhi(w0.y) - lam * bfhi(w1.y);
            float ss = (y0 * y0 + y1 * y1) + (y2 * y2 + y3 * y3);
#pragma unroll
            for (int o = 1; o < 64; o <<= 1) ss += __shfl_xor(ss, o);
            const float rs = rsqrtf(ss * (1.0f / 256.0f) + LN_EPS) * (1.0f - LAMBDA_INIT);
            *(GAS unsigned*)((unsigned char*)YB + off) = pk4_fp8(8.0f * y0 * rs * gsub.x, 8.0f * y1 * rs * gsub.y, 8.0f * y2 * rs * gsub.z, 8.0f * y3 * rs * gsub.w); }
        if (BOTH(4)) xcd_barrier(bar);
    }

    if (IN(5)) {
        pg8::Gemm g{YA, WOA, YB, WOB, S, DM, 2048 / 2, (int)(0x01010101u * (127 - 12)), (int)(0x01010101u * (127 - 9))};
        pg8::DualOrder So; So.init(S, DM, G, (int)blockIdx.x);
        pg8::EpiMerge E{(unsigned char*)MERGED, PROJ, args.in[2]};
        pg8::gemm_phase<pg8::EpiMerge, pg8::DualOrder, true, P5_SP2, true>(lds, g, So, E, wave);
        if (BOTH(5)) xcd_barrier(bar);
    }
    if (IN(6)) {
        pg8::Gemm g{MERGED, WOUT, MERGED, WOUT, S, DM, DM / 2, (int)(0x01010101u * (127 - 10)), 0}; pg8::StaticOrder So; So.init(S, DM, G, (int)blockIdx.x);
        pg8::EpiResF32 E{args.out, args.in[0], ALPHA};
        pg8::gemm_phase<pg8::EpiResF32, pg8::StaticOrder, true, P6_SP2, true>(lds, g, So, E, wave);
        if (BOTH(6)) xcd_barrier(bar);
    }
    if (IN(7)) {
        for (int m = vcu * NWAVES + wave; m < S; m += G * NWAVES) ln_row(args.out + (size_t)m * DM, args.in[12], args.in[13], X1F + (size_t)m * DM, X1B + (size_t)m * DM, X1Q + (size_t)m * DM, lane);
        { GAS v4u* gz = (GAS v4u*)GD; const v4u z = {0u, 0u, 0u, 0u}; for (size_t i = (size_t)blockIdx.x * 512 + tid; i < (size_t)S * 16384 / 16; i += (size_t)G * 512) gz[i] = z; }
        if (BOTH(7)) xcd_barrier(bar);
    }
    if (IN(8)) {
        pg8::Gemm g{X1B, WQ, X1B, WQ, S, 2048, DM, 0, 0}; pg8::StaticOrder So; So.init(S, 2048, G, (int)blockIdx.x);
        pg8::EpiStoreBf16 E{PQ, 2048};
        pg8::gemm_phase<pg8::EpiStoreBf16, pg8::StaticOrder, true, true>(lds, g, So, E, wave);
        if (BOTH(8)) xcd_barrier(bar);
    }
    if (IN(9)) {
#pragma nounroll
        for (int b = (int)blockIdx.x; b < S / 32; b += G) rt::route_block(b * 32, PQ, KEYSB, (unsigned char*)GD, nullptr, nullptr, (LAS char*)lds, wave);
        if (BOTH(9)) xcd_barrier(bar);
    }
    if (IN(10)) {
        pg8::Gemm g{(const bf16*)X1Q, UB, (const bf16*)X1Q, UB, S, 16384, DM / 2, (int)(0x01010101u * (127 - 6)), 0}; pg8::StaticOrder So; So.init(S, 16384, G, (int)blockIdx.x);
        pg8::EpiPeerAct E{(unsigned char*)GD};
        pg8::gemm_phase<pg8::EpiPeerAct, pg8::StaticOrder, true, true, true>(lds, g, So, E, wave);
        if (BOTH(10)) xcd_barrier(bar);
    }
    if (IN(11)) {
        pg8::Gemm g{GD, VT, GD, VT, S, DM, 16384 / 2, (int)(0x01010101u * (127 - 9)), 0}; pg8::StaticOrder So; So.init(S, DM, G, (int)blockIdx.x);
        pg8::EpiResF32 E{args.out, X1F, ALPHA};
        pg8::gemm_phase<pg8::EpiResF32, pg8::StaticOrder, true, true, true>(lds, g, So, E, wave);
        if (BOTH(11)) xcd_barrier(bar);
    }
    if (IN(12)) {
        for (int m = vcu * NWAVES + wave; m < S; m += G * NWAVES) ln_row(args.out + (size_t)m * DM, args.in[19], args.in[20], args.out + (size_t)m * DM, nullptr, nullptr, lane);
    }
#undef IN
#undef BOTH
#undef lane
#undef tid
#undef WINT
#undef XB
#undef PROJ
#undef MERGED
#undef X1B
#undef PQ
#undef GD
#undef WOA
#undef WOB
#undef WOUT
#undef WQ
#undef UB
#undef VT
#undef KEYSB
#undef X1F
#undef X1Q
#undef KMEANB
#undef YA
#undef YB
#undef OP0
#undef OP1
}

__global__ void shim_proj(const bf16* __restrict__ PROJ, float* __restrict__ ws) {
    const size_t U64 = (size_t)S * 2048;
    const size_t i = (size_t)blockIdx.x * blockDim.x + threadIdx.x; const int row = (int)(i / INW), col = (int)(i % INW);
    const float v = bf2f(PROJ[i]);
    if (col < 12288) { const int t = col >> 11, c = col & 2047; ws[(size_t)t * U64 + (size_t)row * 2048 + c] = v; }
    else { const int t = (col - 12288) >> 12, c = (col - 12288) & 4095; ws[(size_t)(6 + 2 * t) * U64 + (size_t)row * 4096 + c] = v; }
}

__global__ void shim_bf16_f32(const bf16* __restrict__ src, float* __restrict__ dst) { const size_t i = (size_t)blockIdx.x * blockDim.x + threadIdx.x; dst[i] = bf2f(src[i]); }
}

extern "C" void kernel_launch(void* const* d_in, const int* in_sizes, int n_in, void* d_out, int out_size, void* d_ws, size_t ws_size, hipStream_t stream) {
    if (ws_size < WS_NEED) return;
    static int grid = 0;
    if (grid == 0) {
        int dev = 0, cus = 0;
        if (hipGetDevice(&dev) != hipSuccess || hipDeviceGetAttribute(&cus, hipDeviceAttributeMultiprocessorCount, dev) != hipSuccess) { grid = -1; return; }
        if (hipFuncSetAttribute((const void*)mega_fwd, hipFuncAttributeMaxDynamicSharedMemorySize, LDS_BYTES) != hipSuccess) { grid = -1; return; }
        grid = cus;
    }
    if (grid < 0) return;
    (void)hipMemsetAsync((char*)d_ws + WS_CTL, 0, CTL_ZERO_BYTES, stream);
    Args a{};
    for (int i = 0; i < 21; ++i) a.in[i] = (const float*)d_in[i];
    a.out = (float*)d_out; a.ws = (unsigned char*)d_ws;
    const int cuts[] = {0, 13};
    for (int li = 0; li + 1 < (int)(sizeof(cuts) / sizeof(int)); ++li) { a.ph_lo = cuts[li]; a.ph_hi = cuts[li + 1];
        hipLaunchKernelGGL(mega_fwd, dim3(grid), dim3(NWAVES * 64), LDS_BYTES, stream, a); }
}
```

```cpp
#include <hip/hip_runtime.h>
#include <math.h>
#include <cstdio>
#include <cstdint>

namespace {
constexpr int S = 8192, DM = 4096, INW = 20480;
constexpr float SCALE = 0.08838834764831845f;
constexpr float ALPHA = 1.189207115002721f;
constexpr float LN_EPS = 1e-5f;
constexpr float LAMBDA_INIT = 0.2f;
typedef float f32x16 __attribute__((ext_vector_type(16)));

__device__ __forceinline__ int t5_bucket(int n) {
    if (n < 16) return n;
    int b = 16;
    b += (n >= 19); b += (n >= 21); b += (n >= 24); b += (n >= 27); b += (n >= 31); b += (n >= 35); b += (n >= 40); b += (n >= 46);
    b += (n >= 52); b += (n >= 59); b += (n >= 67); b += (n >= 77); b += (n >= 87); b += (n >= 99); b += (n >= 113);
    return b;
}

__global__ void __launch_bounds__(256) gemm_f32(const float* __restrict__ A, int lda, const float* __restrict__ B, int ldb, float* __restrict__ C, int ldc, int K,
                                                const float* __restrict__ R, int ldr, float alpha) {
    __shared__ float As[16][132];
    __shared__ float Bs[16][132];
    const int tid = threadIdx.x, lane = tid & 63, wid = tid >> 6, wm = wid >> 1, wn = wid & 1;
    const int m0 = blockIdx.y * 128, n0 = blockIdx.x * 128;
    f32x16 acc[2][2];
    for (int i = 0; i < 2; ++i) for (int j = 0; j < 2; ++j) for (int r = 0; r < 16; ++r) acc[i][j][r] = 0.f;
    for (int k0 = 0; k0 < K; k0 += 16) {
        for (int i = 0; i < 2; ++i) {
            const int idx = tid + i * 256;
            const int r = idx >> 2, c4 = idx & 3;
            const float4 v = *(const float4*)(A + (size_t)(m0 + r) * lda + k0 + c4 * 4);
            As[c4 * 4 + 0][r] = v.x; As[c4 * 4 + 1][r] = v.y; As[c4 * 4 + 2][r] = v.z; As[c4 * 4 + 3][r] = v.w;
            const int kr = idx >> 5, cb = idx & 31;
            const float4 w = *(const float4*)(B + (size_t)(k0 + kr) * ldb + n0 + cb * 4);
            *(float4*)&Bs[kr][cb * 4] = w;
        }
        __syncthreads();
        for (int kk = 0; kk < 16; kk += 2) {
            float a[2], b[2];
            for (int i = 0; i < 2; ++i) a[i] = As[kk + (lane >> 5)][wm * 64 + i * 32 + (lane & 31)];
            for (int j = 0; j < 2; ++j) b[j] = Bs[kk + (lane >> 5)][wn * 64 + j * 32 + (lane & 31)];
            for (int i = 0; i < 2; ++i) for (int j = 0; j < 2; ++j) acc[i][j] = __builtin_amdgcn_mfma_f32_32x32x2f32(a[i], b[j], acc[i][j], 0, 0, 0);
        }
        __syncthreads();
    }
    for (int i = 0; i < 2; ++i) for (int j = 0; j < 2; ++j) for (int r = 0; r < 16; ++r) {
        const int row = m0 + wm * 64 + i * 32 + (r & 3) + 8 * (r >> 2) + 4 * (lane >> 5);
        const int col = n0 + wn * 64 + j * 32 + (lane & 31);
        float v = acc[i][j][r];
        if (R) v += alpha * R[(size_t)row * ldr + col];
        C[(size_t)row * ldc + col] = v;
    }
}

__global__ void transpose_f32(const float* __restrict__ in, int ld_in, float* __restrict__ out, int ld_out) {
    __shared__ float tile[32][33];
    const int tx = threadIdx.x & 31, ty = threadIdx.x >> 5;
    const int r0 = blockIdx.y * 32, c0 = blockIdx.x * 32;
    for (int i = ty; i < 32; i += 8) tile[i][tx] = in[(size_t)(r0 + i) * ld_in + c0 + tx];
    __syncthreads();
    for (int i = ty; i < 32; i += 8) out[(size_t)(c0 + i) * ld_out + r0 + tx] = tile[tx][i];
}

__global__ void kmean_kernel(const float* __restrict__ mk, float* __restrict__ kmean) {
    const int j = blockIdx.x, h = blockIdx.y, d = threadIdx.x;
    float s = 0.f;
    for (int i = 0; i < 256; ++i) s += mk[(size_t)(j * 256 + i) * 2048 + h * 128 + d];
    kmean[(h * 32 + j) * 128 + d] = s * (1.0f / 256.0f);
}

__device__ __forceinline__ float block_reduce(float v, float* red, bool is_max) {
    const int t = threadIdx.x;
    for (int o = 32; o >= 1; o >>= 1) { const float w = __shfl_xor(v, o); v = is_max ? fmaxf(v, w) : v + w; }
    __syncthreads();
    if ((t & 63) == 0) red[t >> 6] = v;
    __syncthreads();
    float r = red[0];
    for (int i = 1; i < (int)(blockDim.x >> 6); ++i) r = is_max ? fmaxf(r, red[i]) : r + red[i];
    __syncthreads();
    return r;
}

__global__ void __launch_bounds__(256) moba_naive(const float* __restrict__ mq, const float* __restrict__ mkT, const float* __restrict__ mv, const float* __restrict__ kmean,
                                                  const float* __restrict__ rel_bias, float* __restrict__ ya) {
    const int q = blockIdx.x, h = blockIdx.y, t = threadIdx.x;
    __shared__ float qs[128]; __shared__ float gate[32]; __shared__ int blk[4]; __shared__ int okf[4]; __shared__ float sc[1024]; __shared__ float red[8]; __shared__ float biasl[32];
    __shared__ float part[256];
    if (t < 128) qs[t] = mq[(size_t)q * 2048 + h * 128 + t];
    if (t < 32) biasl[t] = rel_bias[t * 24 + h];
    __syncthreads();
    const int qb = q >> 8;
    if (t < 32) { float g = -1e30f; if (t < qb) { g = 0.f; const float* km = kmean + (h * 32 + t) * 128; for (int d = 0; d < 128; ++d) g += qs[d] * km[d]; } gate[t] = g; }
    __syncthreads();
    if (t == 0) {
        unsigned used = 0;
        for (int r = 0; r < 3; ++r) { int best = -1; for (int j = 0; j < 32; ++j) if (!((used >> j) & 1u) && (best < 0 || gate[j] > gate[best])) best = j;
            used |= 1u << best; blk[r] = best; okf[r] = best < qb ? 1 : 0; }
        blk[3] = qb; okf[3] = 1;
    }
    __syncthreads();
    float lmax = -1e30f;
    for (int r = 0; r < 4; ++r) {
        const int kpos = blk[r] * 256 + t, dist = q - kpos; float s = -1e30f;
        if (okf[r] && dist >= 0) { float dot = 0.f; const float* kp = mkT + (size_t)(h * 128) * S + kpos; for (int d = 0; d < 128; ++d) dot += qs[d] * kp[(size_t)d * S];
            s = dot * SCALE + biasl[t5_bucket(dist)]; }
        sc[r * 256 + t] = s; lmax = fmaxf(lmax, s);
    }
    const float mx = block_reduce(lmax, red, true);
    float lsum = 0.f;
    for (int r = 0; r < 4; ++r) { const float e = expf(sc[r * 256 + t] - mx); sc[r * 256 + t] = e; lsum += e; }
    const float sum = block_reduce(lsum, red, false);
    const int d = t & 127, half = t >> 7; float a = 0.f;
    for (int i = half * 512; i < half * 512 + 512; ++i) { const float p = sc[i]; if (p != 0.f) { const int kpos = blk[i >> 8] * 256 + (i & 255); a += p * mv[(size_t)kpos * 2048 + h * 128 + d]; } }
    part[t] = a; __syncthreads();
    if (t < 128) ya[(size_t)q * 2048 + h * 128 + t] = (part[t] + part[t + 128]) / sum;
}

__global__ void __launch_bounds__(256) diff_naive(const float* __restrict__ dq, const float* __restrict__ dkT, const float* __restrict__ dv, const float* __restrict__ rel_bias,
                                                  const float* __restrict__ lq1, const float* __restrict__ lk1, const float* __restrict__ lq2, const float* __restrict__ lk2,
                                                  const float* __restrict__ subln_g, float* __restrict__ yb) {
    __shared__ float sc[S];
    __shared__ float qs[256]; __shared__ float red[8]; __shared__ float biasl[32]; __shared__ float lamsh;
    const int q = blockIdx.x, h = blockIdx.y, t = threadIdx.x;
    qs[t] = dq[(size_t)q * 2048 + h * 256 + t];
    if (t < 32) biasl[t] = rel_bias[t * 24 + 16 + h];
    if (t == 0) { float a = 0.f, b = 0.f; for (int d = 0; d < 128; ++d) { a += lq1[d] * lk1[d]; b += lq2[d] * lk2[d]; } lamsh = expf(a) - expf(b) + LAMBDA_INIT; }
    __syncthreads();
    const float lam = lamsh; const int nk = q + 1;
    float acc = 0.f;
    for (int mp = 0; mp < 2; ++mp) {
        float lmax = -1e30f;
        for (int kpos = t; kpos < nk; kpos += 256) { float dot = 0.f; const float* kp = dkT + (size_t)(h * 256 + mp * 128) * S + kpos;
            for (int d = 0; d < 128; ++d) dot += qs[mp * 128 + d] * kp[(size_t)d * S];
            const float s = dot * SCALE + biasl[t5_bucket(q - kpos)]; sc[kpos] = s; lmax = fmaxf(lmax, s); }
        const float mx = block_reduce(lmax, red, true);
        float lsum = 0.f;
        for (int kpos = t; kpos < nk; kpos += 256) { const float e = expf(sc[kpos] - mx); sc[kpos] = e; lsum += e; }
        const float inv = 1.0f / block_reduce(lsum, red, false);
        float a = 0.f;
        for (int i = 0; i < nk; ++i) a += sc[i] * dv[(size_t)i * 2048 + h * 256 + t];
        acc += (mp == 0 ? inv : -lam * inv) * a;
        __syncthreads();
    }
    const float ss = block_reduce(acc * acc, red, false);
    yb[(size_t)q * 2048 + h * 256 + t] = acc * rsqrtf(ss * (1.0f / 256.0f) + LN_EPS) * subln_g[t] * (1.0f - LAMBDA_INIT);
}

__global__ void merge_kernel(const float* __restrict__ ga, const float* __restrict__ gb, const float* __restrict__ gate_b, const float* __restrict__ ta, const float* __restrict__ tb, float* __restrict__ merged) {
    const size_t i = (size_t)blockIdx.x * blockDim.x + threadIdx.x; const int c = (int)(i & (DM - 1));
    const float a = 1.0f / (1.0f + expf(-(ga[i] + gate_b[c]))), b = 1.0f / (1.0f + expf(-(gb[i] + gate_b[DM + c])));
    merged[i] = a * ta[i] + b * tb[i];
}

__global__ void __launch_bounds__(256) ln_kernel(const float* __restrict__ in, const float* __restrict__ g, const float* __restrict__ b, float* __restrict__ out) {
    __shared__ float red[8];
    const int row = blockIdx.x, t = threadIdx.x; float v[16]; float s = 0.f;
    for (int i = 0; i < 16; ++i) { v[i] = in[(size_t)row * DM + i * 256 + t]; s += v[i]; }
    const float mu = block_reduce(s, red, false) * (1.0f / DM); float q = 0.f;
    for (int i = 0; i < 16; ++i) { v[i] -= mu; q += v[i] * v[i]; }
    const float rstd = rsqrtf(block_reduce(q, red, false) * (1.0f / DM) + LN_EPS);
    for (int i = 0; i < 16; ++i) out[(size_t)row * DM + i * 256 + t] = v[i] * rstd * g[i * 256 + t] + b[i * 256 + t];
}

__global__ void __launch_bounds__(256) peer_route_naive(const float* __restrict__ pq, const float* __restrict__ keys1, const float* __restrict__ keys2, int* __restrict__ eidx, float* __restrict__ gates) {
    __shared__ float qh[256]; __shared__ float sc[2][128]; __shared__ float tv[2][16]; __shared__ int ti[2][16];
    const int tok = blockIdx.x, t = threadIdx.x;
    for (int h = 0; h < 8; ++h) {
        qh[t] = pq[(size_t)tok * 2048 + h * 256 + t];
        __syncthreads();
        { const int side = t >> 7, k = t & 127; const float* kr = (side ? keys2 : keys1) + k * 128; float d = 0.f; for (int i = 0; i < 128; ++i) d += qh[side * 128 + i] * kr[i]; sc[side][k] = d; }
        __syncthreads();
        if (t == 0 || t == 128) { const int side = t >> 7; unsigned used[4] = {0, 0, 0, 0};
            for (int r = 0; r < 16; ++r) { int best = -1; for (int j = 0; j < 128; ++j) if (!((used[j >> 5] >> (j & 31)) & 1u) && (best < 0 || sc[side][j] > sc[side][best])) best = j;
                used[best >> 5] |= 1u << (best & 31); tv[side][r] = sc[side][best]; ti[side][r] = best; } }
        __syncthreads();
        if (t == 0) { unsigned used[8] = {0, 0, 0, 0, 0, 0, 0, 0}; float ts[16]; int tp[16];
            for (int r = 0; r < 16; ++r) { int best = -1; float bv = 0.f; for (int j = 0; j < 256; ++j) { if ((used[j >> 5] >> (j & 31)) & 1u) continue; const float c = tv[0][j >> 4] + tv[1][j & 15]; if (best < 0 || c > bv) { best = j; bv = c; } }
                used[best >> 5] |= 1u << (best & 31); ts[r] = bv; tp[r] = best; }
            float sum = 0.f; const float tmax = ts[0]; for (int r = 0; r < 16; ++r) { ts[r] = expf(ts[r] - tmax); sum += ts[r]; }
            for (int r = 0; r < 16; ++r) { eidx[(size_t)tok * 128 + h * 16 + r] = ti[0][tp[r] >> 4] * 128 + ti[1][tp[r] & 15]; gates[(size_t)tok * 128 + h * 16 + r] = ts[r] / sum; } }
        __syncthreads();
    }
}

__global__ void __launch_bounds__(256) peer_expert_naive(const float* __restrict__ x1, const int* __restrict__ eidx, const float* __restrict__ gates, const float* __restrict__ U, const float* __restrict__ V,
                                                         const float* __restrict__ g2, const float* __restrict__ b2, float* __restrict__ out) {
    __shared__ float xs[DM]; __shared__ float wts[128]; __shared__ int es[128]; __shared__ float red[8];
    const int tok = blockIdx.x, t = threadIdx.x, lane = t & 63, wid = t >> 6;
    for (int i = t; i < DM; i += 256) xs[i] = x1[(size_t)tok * DM + i];
    if (t < 128) es[t] = eidx[(size_t)tok * 128 + t];
    __syncthreads();
    for (int e = wid; e < 128; e += 4) { const float* u = U + (size_t)es[e] * DM; float d = 0.f;
        for (int j = 0; j < 16; ++j) { const float4 w = *(const float4*)(u + j * 256 + lane * 4); const float* xp = xs + j * 256 + lane * 4; d += w.x * xp[0] + w.y * xp[1] + w.z * xp[2] + w.w * xp[3]; }
        for (int o = 32; o >= 1; o >>= 1) d += __shfl_xor(d, o);
        if (lane == 0) wts[e] = gates[(size_t)tok * 128 + e] * 0.5f * d * (1.0f + erff(d * 0.7071067811865476f)); }
    __syncthreads();
    float acc[16];
    for (int i = 0; i < 16; ++i) acc[i] = 0.f;
    for (int e = 0; e < 128; ++e) { const float w = wts[e]; const float* v = V + (size_t)es[e] * DM; for (int i = 0; i < 16; ++i) acc[i] += w * v[i * 256 + t]; }
    float s = 0.f;
    for (int i = 0; i < 16; ++i) { acc[i] += ALPHA * xs[i * 256 + t]; s += acc[i]; }
    const float mu = block_reduce(s, red, false) * (1.0f / DM); float qq = 0.f;
    for (int i = 0; i < 16; ++i) { acc[i] -= mu; qq += acc[i] * acc[i]; }
    const float rstd = rsqrtf(block_reduce(qq, red, false) * (1.0f / DM) + LN_EPS);
    for (int i = 0; i < 16; ++i) out[(size_t)tok * DM + i * 256 + t] = acc[i] * rstd * g2[i * 256 + t] + b2[i * 256 + t];
}

void gemm(hipStream_t st, const float* A, int lda, const float* B, int ldb, float* C, int ldc, int M, int N, int K, const float* R = nullptr, int ldr = 0, float alpha = 0.f) {
    hipLaunchKernelGGL(gemm_f32, dim3(N / 128, M / 128), dim3(256), 0, st, A, lda, B, ldb, C, ldc, K, R, ldr, alpha);
}
#define GAS __attribute__((address_space(1)))
#define LAS __attribute__((address_space(3)))
typedef unsigned short bf16;
typedef unsigned v4u __attribute__((ext_vector_type(4)));
typedef unsigned v2u __attribute__((ext_vector_type(2)));
typedef float f32x4 __attribute__((ext_vector_type(4)));
typedef short bf16x8 __attribute__((ext_vector_type(8)));
typedef GAS unsigned gu32;
#define RLX_AGENT __ATOMIC_RELAXED, __HIP_MEMORY_SCOPE_AGENT
#define LDS_WAIT() asm volatile("s_waitcnt lgkmcnt(0)" ::: "memory")
#define VM_WAIT() asm volatile("s_waitcnt vmcnt(0)" ::: "memory")
__device__ __forceinline__ int lane_id() { int r; asm volatile("v_mbcnt_lo_u32_b32 %0, -1, 0\n\tv_mbcnt_hi_u32_b32 %0, -1, %0" : "=v"(r)); return r; }
__device__ __forceinline__ unsigned f2bf(float f) { unsigned u = __builtin_bit_cast(unsigned, f); return (u + 0x7fffu + ((u >> 16) & 1u)) >> 16; }
__device__ __forceinline__ unsigned pk2(float lo, float hi) { return f2bf(lo) | (f2bf(hi) << 16); }
__device__ __forceinline__ float bf2f(unsigned short b) { return __builtin_bit_cast(float, (unsigned)b << 16); }
__device__ __forceinline__ float bflo(unsigned w) { return __builtin_bit_cast(float, w << 16); }
__device__ __forceinline__ float bfhi(unsigned w) { return __builtin_bit_cast(float, w & 0xffff0000u); }
__device__ __forceinline__ float clamp8(float x) { return __builtin_amdgcn_fmed3f(x, -448.f, 448.f); }
__device__ __forceinline__ unsigned pk4_fp8(float a, float b, float c, float d) { int w = 0; w = __builtin_amdgcn_cvt_pk_fp8_f32(clamp8(a), clamp8(b), w, false); w = __builtin_amdgcn_cvt_pk_fp8_f32(clamp8(c), clamp8(d), w, true); return (unsigned)w; }

namespace pg8 {
#define PG8_LAS __attribute__((address_space(3)))
typedef unsigned short bf16_t;
typedef short bf16x8 __attribute__((ext_vector_type(8)));
typedef float f32x4 __attribute__((ext_vector_type(4)));
typedef unsigned u32x4 __attribute__((ext_vector_type(4)));
constexpr int BM = 256, BK = 64, HALF = 128, HTB = HALF * BK * 2  , STAGE_BYTES = 8 * HTB, NXCD = 8, WGM = 8;

__host__ __device__ __forceinline__ int lds_byte(int r, int c) { const int st = (r >> 4) * 2 + (c >> 5), rr = r & 15, cc = c & 31, ob = rr * 64 + cc * 2; return st * 1024 + (ob ^ (((ob >> 9) & 1) << 5)); }
__host__ __device__ __forceinline__ void stage_rc(int b, int& R, int& C) { const int st = b / 1024, sb = b % 1024, swz = sb ^ (((sb >> 9) & 1) << 5); R = (st >> 1) * 16 + swz / 64; C = (st & 1) * 32 + (swz % 64) / 2; }
__host__ __device__ __forceinline__ int perm32(int rho) { const int n = rho >> 4, i = rho & 15; return 8 * (i >> 2) + 4 * n + (i & 3); }

struct Unit { int pm, pn, part; };
struct Gemm { const bf16_t* A; const bf16_t* Bt; const bf16_t* A2; const bf16_t* Bt2; int M, N, K; int sc; int sc2; };

struct StaticOrder {
    int nM, nN, nwg, G, c;
    __host__ __device__ void init(int M, int N, int G_, int c_) { nM = M / BM; nN = N / BM; nwg = nM * nN; G = G_; c = c_; }
    __host__ __device__ bool next(int i, Unit& u) const {
        const long L = (long)i * G + c; if (L >= nwg) return false;
        int wgid = (int)L; { const int q = nwg / NXCD, r = nwg % NXCD, xcd = wgid % NXCD, off = wgid / NXCD; wgid = (xcd < r ? xcd * (q + 1) : r * (q + 1) + (xcd - r) * q) + off; }
        const int nig = WGM * nN, gid = wgid / nig, fm = gid * WGM, gsz = (nM - fm) < WGM ? (nM - fm) : WGM;
        u.pm = fm + ((wgid % nig) % gsz); u.pn = (wgid % nig) / gsz; u.part = 0; return true;
    }
    __device__ __forceinline__ void a_ready(const Unit&) const {}
    __device__ __forceinline__ void done(const Unit&) const {}
};


typedef int v4i_t __attribute__((ext_vector_type(4))); typedef int v8i_t __attribute__((ext_vector_type(8)));
__device__ __forceinline__ v8i_t cat8(bf16x8 a, bf16x8 b) { return __builtin_shufflevector(__builtin_bit_cast(v4i_t, a), __builtin_bit_cast(v4i_t, b), 0, 1, 2, 3, 4, 5, 6, 7); }
template <class Epi, class Sched, bool ALIGN_EPI = false, bool SP2 = false, bool F8 = false>
__device__ __forceinline__ void gemm_phase(PG8_LAS unsigned char* lds, const Gemm g, const Sched& S, const Epi& E, const int wave_id) {
    int lane_; asm volatile("v_mbcnt_lo_u32_b32 %0, -1, 0\n\tv_mbcnt_hi_u32_b32 %0, -1, %0" : "=v"(lane_));
    const int lane = lane_, wid = wave_id, tid = wid * 64 + lane, wr = wid >> 2, wc = wid & 3, fr = lane & 15, fq = lane >> 4;
    const int K = g.K, nt = K / BK;
    unsigned voffA[2], voffB[2];
#pragma unroll
    for (int i = 0; i < 2; ++i) { int R, C; stage_rc(tid * 16 + i * 8192, R, C); const int Rb = Epi::PERM ? ((R & ~31) + perm32(R & 31)) : R;
        voffA[i] = (unsigned)(R * K + C) * 2u; voffB[i] = (unsigned)(Rb * K + C) * 2u; }
    const size_t kstep = (size_t)(BK * 2);
    const size_t rstep64 = (size_t)64 * K * 2;
    const size_t hstep = (size_t)HALF * K * 2;
    const size_t tstep = 2 * hstep;
    const unsigned ldsw = (unsigned)wid * 1024u;
    const int aoff = lds_byte(wr * 64 + fr, fq * 8), boff = lds_byte(wc * 32 + fr, fq * 8);
#define PG8_SA(b, h) (((b) * 2 + (h)) * HTB)
#define PG8_SB(b, h) ((4 + (b) * 2 + (h)) * HTB)
#define PG8_STAGE(bufoff, gbase, voff) do { _Pragma("unroll") for (int _i = 0; _i < 2; ++_i) \
        __builtin_amdgcn_global_load_lds((const unsigned*)((const char*)(gbase) + (size_t)_i * rstep64 + (voff)[0]), (PG8_LAS unsigned*)(lds + (bufoff) + ldsw + _i * 8192), 16, 0, 0); } while (0)
#define PG8_LDA(dst, b, h) do { _Pragma("unroll") for (int m = 0; m < 4; ++m) _Pragma("unroll") for (int k = 0; k < 2; ++k) dst[m][k] = *(const PG8_LAS bf16x8*)(lds + PG8_SA(b, h) + aoff + m * 2048 + k * 1024); } while (0)
#define PG8_LDB(dst, b, h) do { _Pragma("unroll") for (int n = 0; n < 2; ++n) _Pragma("unroll") for (int k = 0; k < 2; ++k) dst[n][k] = *(const PG8_LAS bf16x8*)(lds + PG8_SB(b, h) + boff + n * 2048 + k * 1024); } while (0)
#define PG8_MMA(ai, bj, At, Bt) do { __builtin_amdgcn_s_setprio(1); if constexpr (F8) { _Pragma("unroll") for (int m = 0; m < 4; ++m) _Pragma("unroll") for (int n = 0; n < 2; ++n) \
        acc[ai][bj][m][n] = __builtin_amdgcn_mfma_scale_f32_16x16x128_f8f6f4(cat8(Bt[n][0], Bt[n][1]), cat8(At[m][0], At[m][1]), acc[ai][bj][m][n], 0, 0, 0, (cur.part ? g.sc2 : g.sc), 0, 0x7f7f7f7f); } else { \
        _Pragma("unroll") for (int m = 0; m < 4; ++m) _Pragma("unroll") for (int n = 0; n < 2; ++n) _Pragma("unroll") for (int k = 0; k < 2; ++k) \
        acc[ai][bj][m][n] = __builtin_amdgcn_mfma_f32_16x16x32_bf16(Bt[n][k], At[m][k], acc[ai][bj][m][n], 0, 0, 0); } __builtin_amdgcn_s_setprio(0); } while (0)
#define PG8_WAIT_V(n) asm volatile("s_waitcnt vmcnt(" #n ")" ::: "memory")
#define PG8_WAIT_L(n) asm volatile("s_waitcnt lgkmcnt(" #n ")" ::: "memory")
#define PG8_BAR __builtin_amdgcn_s_barrier()
#define PG8_SCHED __builtin_amdgcn_sched_barrier(0)
    Unit cur, nxt; int ui = 0;
    if (!S.next(0, cur)) return;
    f32x4 acc[2][2][4][2];
#pragma unroll
    for (int a = 0; a < 2; ++a)
#pragma unroll
        for (int b = 0; b < 2; ++b)
#pragma unroll
            for (int m = 0; m < 4; ++m)
#pragma unroll
                for (int n = 0; n < 2; ++n) acc[a][b][m][n] = (f32x4){0.f, 0.f, 0.f, 0.f};
    bf16x8 At[4][2], B0[2][2], B1[2][2];
    const char* cA = (const char*)(cur.part ? g.A2 : g.A) + (size_t)cur.pm * tstep; const char* cB = (const char*)(cur.part ? g.Bt2 : g.Bt) + (size_t)cur.pn * tstep;
    S.a_ready(cur);
    if constexpr (SP2) {
        PG8_STAGE(PG8_SB(0, 0), cB, voffB); PG8_STAGE(PG8_SB(0, 1), cB + hstep, voffB); PG8_STAGE(PG8_SA(0, 0), cA, voffA); PG8_STAGE(PG8_SA(0, 1), cA + hstep, voffA);
        if (wr == 1) PG8_BAR;
        PG8_WAIT_V(2); PG8_BAR;
        PG8_STAGE(PG8_SB(1, 0), cB + kstep, voffB); PG8_STAGE(PG8_SA(1, 0), cA + kstep, voffA); PG8_STAGE(PG8_SB(1, 1), cB + hstep + kstep, voffB);
        PG8_WAIT_V(6); PG8_BAR;
    } else {
        PG8_STAGE(PG8_SB(0, 0), cB, voffB); PG8_STAGE(PG8_SA(0, 0), cA, voffA); PG8_STAGE(PG8_SB(0, 1), cB + hstep, voffB); PG8_STAGE(PG8_SA(0, 1), cA + hstep, voffA);
        if (wr == 1) PG8_BAR;
        PG8_WAIT_V(4); PG8_BAR;
        PG8_STAGE(PG8_SB(1, 0), cB + kstep, voffB); PG8_STAGE(PG8_SA(1, 0), cA + kstep, voffA); PG8_STAGE(PG8_SB(1, 1), cB + hstep + kstep, voffB);
        PG8_WAIT_V(6); PG8_BAR;
    }
    for (;;) {
        const bool has_next = S.next(ui + 1, nxt);
        const char* nA = has_next ? (const char*)(nxt.part ? g.A2 : g.A) + (size_t)nxt.pm * tstep : cA; const char* nB = has_next ? (const char*)(nxt.part ? g.Bt2 : g.Bt) + (size_t)nxt.pn * tstep : cB;
        for (int t = 0; t < nt; t += 2) {
            const bool last = (t == nt - 2);
            const char* a1 = cA + (size_t)(t + 1) * kstep;
            const char* a2 = last ? nA : cA + (size_t)(t + 2) * kstep; const char* b2 = last ? nB : cB + (size_t)(t + 2) * kstep;
            const char* a3 = a2 + kstep; const char* b3 = b2 + kstep;
            if (last && has_next) S.a_ready(nxt);
            if constexpr (SP2) {
            PG8_LDB(B0, 0, 0); PG8_LDB(B1, 0, 1); PG8_SCHED; PG8_LDA(At, 0, 0); PG8_STAGE(PG8_SA(1, 1), a1 + hstep, voffA);
            PG8_WAIT_V(8); PG8_WAIT_L(0); PG8_BAR; PG8_MMA(0, 0, At, B0); PG8_MMA(0, 1, At, B1); PG8_BAR; PG8_SCHED;
            PG8_LDA(At, 0, 1); PG8_STAGE(PG8_SB(0, 0), b2, voffB); PG8_STAGE(PG8_SB(0, 1), b2 + hstep, voffB); PG8_STAGE(PG8_SA(0, 0), a2, voffA);
            PG8_WAIT_V(8); PG8_WAIT_L(0); PG8_BAR; PG8_MMA(1, 0, At, B0); PG8_MMA(1, 1, At, B1); PG8_BAR; PG8_SCHED;
            PG8_LDB(B0, 1, 0); PG8_LDB(B1, 1, 1); PG8_SCHED; PG8_LDA(At, 1, 0); PG8_STAGE(PG8_SA(0, 1), a2 + hstep, voffA);
            PG8_WAIT_V(8); PG8_WAIT_L(0); PG8_BAR; PG8_MMA(0, 0, At, B0); PG8_MMA(0, 1, At, B1); PG8_BAR; PG8_SCHED;
            PG8_LDA(At, 1, 1); PG8_STAGE(PG8_SB(1, 0), b3, voffB); PG8_STAGE(PG8_SB(1, 1), b3 + hstep, voffB); PG8_STAGE(PG8_SA(1, 0), a3, voffA);
            PG8_WAIT_V(8); PG8_WAIT_L(0); PG8_BAR; PG8_MMA(1, 0, At, B0); PG8_MMA(1, 1, At, B1); PG8_BAR; PG8_SCHED;
            } else {
            PG8_LDB(B0, 0, 0); PG8_SCHED; PG8_LDA(At, 0, 0); PG8_STAGE(PG8_SA(1, 1), a1 + hstep, voffA);
            PG8_WAIT_L(8); PG8_BAR; PG8_WAIT_L(0); PG8_MMA(0, 0, At, B0); PG8_BAR; PG8_SCHED;
            PG8_LDB(B1, 0, 1); PG8_STAGE(PG8_SB(0, 0), b2, voffB);
            PG8_BAR; PG8_WAIT_L(0); PG8_MMA(0, 1, At, B1); PG8_BAR;
            PG8_LDA(At, 0, 1); PG8_STAGE(PG8_SA(0, 0), a2, voffA);
            PG8_BAR; PG8_WAIT_L(0); PG8_MMA(1, 0, At, B0); PG8_BAR; PG8_SCHED;
            PG8_STAGE(PG8_SB(0, 1), b2 + hstep, voffB);
            PG8_WAIT_V(6); PG8_BAR; PG8_MMA(1, 1, At, B1); PG8_BAR;
            PG8_LDB(B0, 1, 0); PG8_SCHED; PG8_LDA(At, 1, 0); PG8_STAGE(PG8_SA(0, 1), a2 + hstep, voffA);
            PG8_WAIT_L(8); PG8_BAR; PG8_WAIT_L(0); PG8_MMA(0, 0, At, B0); PG8_BAR; PG8_SCHED;
            PG8_LDB(B1, 1, 1); PG8_STAGE(PG8_SB(1, 0), b3, voffB);
            PG8_BAR; PG8_WAIT_L(0); PG8_MMA(0, 1, At, B1); PG8_BAR;
            PG8_LDA(At, 1, 1); PG8_STAGE(PG8_SA(1, 0), a3, voffA);
            PG8_BAR; PG8_WAIT_L(0); PG8_MMA(1, 0, At, B0); PG8_BAR; PG8_SCHED;
            PG8_STAGE(PG8_SB(1, 1), b3 + hstep, voffB);
            PG8_WAIT_V(6); PG8_BAR; PG8_MMA(1, 1, At, B1); PG8_BAR;
            }
        }
        if constexpr (ALIGN_EPI) { if (wr == 0) PG8_BAR; }
        if constexpr (!Epi::AFTER_DRAIN) { int l_; asm volatile("v_mbcnt_lo_u32_b32 %0, -1, 0\n\tv_mbcnt_hi_u32_b32 %0, -1, %0" : "=v"(l_));
            E(acc, cur, wr, wc, l_ & 15, l_ >> 4); S.done(cur); }
        if (!has_next) break;
#pragma unroll
        for (int a = 0; a < 2; ++a)
#pragma unroll
            for (int b = 0; b < 2; ++b)
#pragma unroll
                for (int m = 0; m < 4; ++m)
#pragma unroll
                    for (int n = 0; n < 2; ++n) acc[a][b][m][n] = (f32x4){0.f, 0.f, 0.f, 0.f};
        cur = nxt; cA = nA; cB = nB; ++ui;
        if constexpr (ALIGN_EPI) { if (wr == 1) PG8_BAR; }
    }
    PG8_WAIT_V(0);
    if constexpr (!ALIGN_EPI) { if (wr == 0) PG8_BAR; }
    PG8_BAR;
    if constexpr (Epi::AFTER_DRAIN) { E.fused(acc, cur, wr, wc, fr, fq, lds, wid, lane); S.done(cur); }
#undef PG8_SA
#undef PG8_SB
#undef PG8_STAGE
#undef PG8_LDA
#undef PG8_LDB
#undef PG8_MMA
#undef PG8_WAIT_V
#undef PG8_WAIT_L
#undef PG8_BAR
#undef PG8_SCHED
}
}

#define XB_TMO      128
#define XB_XCNT(j)  (256  + 64 * (j))
#define XB_XSUB(j)  (1280 + 64 * (j))
#define XB_XGEN(j)  (2304 + 64 * (j))
#define XB_TOP      3328
#define XB_TOPGEN   3392
#define XCD_BAR_WORDS 3456
#define XB_SPIN_CAP (1u << 18)

__device__ __forceinline__ unsigned xb_ld(unsigned* p)              { return __hip_atomic_load(p, __ATOMIC_RELAXED, __HIP_MEMORY_SCOPE_AGENT); }
__device__ __forceinline__ unsigned xb_add(unsigned* p, unsigned v) { return __hip_atomic_fetch_add(p, v, __ATOMIC_RELAXED, __HIP_MEMORY_SCOPE_AGENT); }
__device__ __forceinline__ unsigned xb_xcc_id() { return (unsigned)__builtin_amdgcn_s_getreg((3 << 11) | 20) & 0xFu; }
#define XB_SPIN(cond, bar) do { unsigned _sp = 0; while (cond) { __builtin_amdgcn_s_sleep(1); \
    if ((++_sp & 255u) == 0u) { if (xb_ld(&(bar)[XB_TMO])) break; if (_sp > XB_SPIN_CAP) { atomicAdd(&(bar)[XB_TMO], 1u); break; } } } } while (0)

struct XcdBarrier {
    unsigned* bar; unsigned x;
    volatile LAS unsigned* st;
};

__device__ __forceinline__ XcdBarrier xcd_barrier_post(unsigned* bar, volatile LAS unsigned* st) {
    XcdBarrier b; b.bar = bar; b.x = xb_xcc_id(); b.st = st;
    if (threadIdx.x == 0) (void)xb_add(&bar[XB_XCNT(b.x)], 1u);
    return b;
}
__device__ __forceinline__ void xcd_barrier_complete(unsigned* bar, unsigned x, unsigned& nloc, unsigned& nx) {
    const unsigned G = gridDim.x * gridDim.y * gridDim.z;
    unsigned sum, cnt, mine, sp = 0u;
    for (;;) {
        sum = 0u; cnt = 0u; mine = 0u;
#pragma unroll
        for (unsigned j = 0; j < 16; ++j) { const unsigned c = xb_ld(&bar[XB_XCNT(j)]); sum += c; cnt += (c > 0u) ? 1u : 0u; mine = (j == x) ? c : mine; }
        if (sum == G) break;
        __builtin_amdgcn_s_sleep(1);
        if ((++sp & 255u) == 0u) { if (xb_ld(&bar[XB_TMO])) break; if (sp > XB_SPIN_CAP) { atomicAdd(&bar[XB_TMO], 1u); break; } }
    }
    nloc = mine > 0u ? mine : 1u; nx = cnt > 0u ? cnt : 1u;
}

__device__ __forceinline__ void xcd_barrier(const XcdBarrier& b) {
    asm volatile("s_waitcnt vmcnt(0)" ::: "memory");
    __syncthreads();
    if (threadIdx.x == 0) {
        unsigned* bar = b.bar;
        __builtin_amdgcn_s_waitcnt(0);
        unsigned nloc = b.st[0], nx = b.st[1];
        if (nloc == 0u) { xcd_barrier_complete(bar, b.x, nloc, nx); b.st[0] = nloc; b.st[1] = nx; }
        const unsigned old = xb_add(&bar[XB_XSUB(b.x)], 1u);
        const unsigned gen = old / nloc;
        if (old + 1u == (gen + 1u) * nloc) {
            __builtin_amdgcn_fence(__ATOMIC_RELEASE, "agent");
            asm volatile("s_waitcnt vmcnt(0)" ::: "memory");
            const unsigned og = xb_add(&bar[XB_TOP], 1u);
            const unsigned tg = og / nx;
            if (og + 1u == (tg + 1u) * nx) xb_add(&bar[XB_TOPGEN], 1u);
            else XB_SPIN(xb_ld(&bar[XB_TOPGEN]) == tg, bar);
            __builtin_amdgcn_fence(__ATOMIC_ACQUIRE, "agent");
            xb_add(&bar[XB_XGEN(b.x)], 1u);
            asm volatile("s_waitcnt vmcnt(0)" ::: "memory");
        } else {
            XB_SPIN(xb_ld(&bar[XB_XGEN(b.x)]) == gen, bar);
            __builtin_amdgcn_fence(__ATOMIC_ACQUIRE, "agent");
            asm volatile("s_waitcnt vmcnt(0)" ::: "memory");
        }
    }
    __syncthreads();
}

constexpr int NWAVES = 8;
#ifndef P5_SP2
#define P5_SP2 true
#endif
#ifndef P6_SP2
#define P6_SP2 true
#endif
constexpr size_t MiB = 1u << 20;
constexpr int RING_BYTES = 131072, LDSCTL_OFF = RING_BYTES, MISC_OFF = LDSCTL_OFF + 320, LDS_BYTES = 147456;
constexpr int CW_BAR = 4096;
constexpr size_t CTL_ZERO_BYTES = 1 * MiB;

namespace pg8 {
__device__ __forceinline__ unsigned cvt_pk_bf16(float lo, float hi) { unsigned r; asm volatile("v_cvt_pk_bf16_f32 %0, %1, %2" : "=v"(r) : "v"(lo), "v"(hi)); return r; }
typedef float f32x2 __attribute__((ext_vector_type(2)));
struct EpiStoreBf16 {
    static constexpr bool PERM = true, AFTER_DRAIN = false;
    bf16_t* O; int ldc;
    __device__ __forceinline__ void operator()(const f32x4 (&acc)[2][2][4][2], const Unit& u, int wr, int wc, int fr, int fq) const {
        const int row0 = u.pm * BM + wr * 64 + fr, col0 = u.pn * BM + wc * 32 + 8 * fq;
#pragma unroll
        for (int ai = 0; ai < 2; ++ai)
#pragma unroll
            for (int m = 0; m < 4; ++m) { bf16_t* rowp = O + (size_t)(row0 + ai * HALF + m * 16) * ldc + col0;
#pragma unroll
                for (int bj = 0; bj < 2; ++bj) { const f32x4 v0 = acc[ai][bj][m][0], v1 = acc[ai][bj][m][1];
                    u32x4 w; w.x = cvt_pk_bf16(v0[0], v0[1]); w.y = cvt_pk_bf16(v0[2], v0[3]); w.z = cvt_pk_bf16(v1[0], v1[1]); w.w = cvt_pk_bf16(v1[2], v1[3]);
                    *(u32x4*)(rowp + bj * HALF) = w; } }
    }
};

struct EpiMerge {
    static constexpr bool PERM = true, AFTER_DRAIN = false;
    unsigned char* Mg; const bf16_t* proj; const float* gate_b;
    __device__ __forceinline__ void operator()(const f32x4 (&acc)[2][2][4][2], const Unit& u, int wr, int wc, int fr, int fq) const {
        const int row0 = u.pm * BM + wr * 64 + fr, col0 = u.pn * BM + wc * 32 + 8 * fq; const int part = u.part;
        const bf16_t* gsrc = proj + (part ? 16384 : 12288); const float* gbp = gate_b + (part ? 4096 : 0);
#pragma unroll
        for (int bj = 0; bj < 2; ++bj) { const int col = col0 + bj * HALF;
            f32x4 gbv[2]; gbv[0] = *(const f32x4*)(gbp + col); gbv[1] = *(const f32x4*)(gbp + col + 4);
            asm volatile("" : "+v"(gbv[0]), "+v"(gbv[1]));
#pragma unroll
        for (int ai = 0; ai < 2; ++ai)
#pragma unroll
            for (int m = 0; m < 4; ++m) { const int row = row0 + ai * HALF + m * 16;
                {
                    const u32x4 gw = *(const u32x4*)(gsrc + (size_t)row * 20480 + col);
                    float z[8]; z[0] = __uint_as_float(gw.x << 16); z[1] = __uint_as_float(gw.x & 0xffff0000u); z[2] = __uint_as_float(gw.y << 16); z[3] = __uint_as_float(gw.y & 0xffff0000u);
                    z[4] = __uint_as_float(gw.z << 16); z[5] = __uint_as_float(gw.z & 0xffff0000u); z[6] = __uint_as_float(gw.w << 16); z[7] = __uint_as_float(gw.w & 0xffff0000u);
                    float v[8];
#pragma unroll
                    for (int k = 0; k < 8; ++k) { const float zz = z[k] + gbv[k >> 2][k & 3]; const float sg = __builtin_amdgcn_rcpf(1.0f + __builtin_amdgcn_exp2f(-1.4426950408889634f * zz)); v[k] = sg * acc[ai][bj][m][k >> 2][k & 3]; }
                    typedef unsigned u32x2v __attribute__((ext_vector_type(2)));
                    unsigned char* dst = Mg + (size_t)row * 4096 + col;
                    if (part) { const u32x2v pw = *(const u32x2v*)dst;
                        v[0] += 0.0625f * __builtin_amdgcn_cvt_f32_fp8((int)pw.x, 0); v[1] += 0.0625f * __builtin_amdgcn_cvt_f32_fp8((int)pw.x, 1); v[2] += 0.0625f * __builtin_amdgcn_cvt_f32_fp8((int)pw.x, 2); v[3] += 0.0625f * __builtin_amdgcn_cvt_f32_fp8((int)pw.x, 3);
                        v[4] += 0.0625f * __builtin_amdgcn_cvt_f32_fp8((int)pw.y, 0); v[5] += 0.0625f * __builtin_amdgcn_cvt_f32_fp8((int)pw.y, 1); v[6] += 0.0625f * __builtin_amdgcn_cvt_f32_fp8((int)pw.y, 2); v[7] += 0.0625f * __builtin_amdgcn_cvt_f32_fp8((int)pw.y, 3); }
                    u32x2v w; int t0 = 0, t1 = 0;
#define C8(x) __builtin_amdgcn_fmed3f((x) * 16.0f, -448.f, 448.f)
                    t0 = __builtin_amdgcn_cvt_pk_fp8_f32(C8(v[0]), C8(v[1]), t0, false); t0 = __builtin_amdgcn_cvt_pk_fp8_f32(C8(v[2]), C8(v[3]), t0, true);
                    t1 = __builtin_amdgcn_cvt_pk_fp8_f32(C8(v[4]), C8(v[5]), t1, false); t1 = __builtin_amdgcn_cvt_pk_fp8_f32(C8(v[6]), C8(v[7]), t1, true);
#undef C8
                    w.x = (unsigned)t0; w.y = (unsigned)t1; *(u32x2v*)dst = w; } } }
    }
};
struct DualOrder : StaticOrder { __device__ bool next(int i, Unit& u) const { if (!StaticOrder::next(i >> 1, u)) return false; u.part = i & 1; return true; } };
struct EpiResF32 {
    static constexpr bool PERM = false, AFTER_DRAIN = false;
    float* C; const float* R; float alpha;
    __device__ __forceinline__ void operator()(const f32x4 (&acc)[2][2][4][2], const Unit& u, int wr, int wc, int fr, int fq) const {
        const int row0 = u.pm * BM + wr * 64 + fr, col0 = u.pn * BM + wc * 32 + 4 * fq;
#pragma unroll
        for (int ai = 0; ai < 2; ++ai)
#pragma unroll
            for (int m = 0; m < 4; ++m) { const size_t off = (size_t)(row0 + ai * HALF + m * 16) * 4096 + col0;
#pragma unroll
                for (int bj = 0; bj < 2; ++bj)
#pragma unroll
                    for (int n = 0; n < 2; ++n) { const f32x4 r = *(const f32x4*)(R + off + bj * HALF + n * 16); *(f32x4*)(C + off + bj * HALF + n * 16) = r * alpha + acc[ai][bj][m][n]; } }
    }
};
struct EpiPeerAct {
    static constexpr bool PERM = true, AFTER_DRAIN = false;
    unsigned char* Gd;
    __device__ __forceinline__ void operator()(const f32x4 (&acc)[2][2][4][2], const Unit& u, int wr, int wc, int fr, int fq) const {
        typedef unsigned u32x2v __attribute__((ext_vector_type(2)));
        const int row0 = u.pm * BM + wr * 64 + fr, col0 = u.pn * BM + wc * 32 + 8 * fq;
#pragma unroll
        for (int ai = 0; ai < 2; ++ai)
#pragma unroll
            for (int m = 0; m < 4; ++m) { unsigned char* rowp = Gd + (size_t)(row0 + ai * HALF + m * 16) * 16384 + col0;
#pragma unroll
                for (int bj = 0; bj < 2; ++bj) { const u32x2v gw = *(const u32x2v*)(rowp + bj * HALF);
                    if ((gw.x | gw.y) != 0u) {
                        float v[8];
#pragma unroll
                        for (int k = 0; k < 8; ++k) { const unsigned word = k < 4 ? gw.x : gw.y; const float gk = (k & 3) == 0 ? __builtin_amdgcn_cvt_f32_fp8((int)word, 0) : (k & 3) == 1 ? __builtin_amdgcn_cvt_f32_fp8((int)word, 1) : (k & 3) == 2 ? __builtin_amdgcn_cvt_f32_fp8((int)word, 2) : __builtin_amdgcn_cvt_f32_fp8((int)word, 3);
                            const float a = acc[ai][bj][m][k >> 2][k & 3]; v[k] = gk != 0.f ? __builtin_amdgcn_fmed3f(gk * 0.125f * a * (1.0f + erff(a * 0.7071067811865476f)), -448.f, 448.f) : 0.f; }
                        u32x2v w; int t0 = 0, t1 = 0; t0 = __builtin_amdgcn_cvt_pk_fp8_f32(v[0], v[1], t0, false); t0 = __builtin_amdgcn_cvt_pk_fp8_f32(v[2], v[3], t0, true);
                        t1 = __builtin_amdgcn_cvt_pk_fp8_f32(v[4], v[5], t1, false); t1 = __builtin_amdgcn_cvt_pk_fp8_f32(v[6], v[7], t1, true); w.x = (unsigned)t0; w.y = (unsigned)t1;
                        *(u32x2v*)(rowp + bj * HALF) = w; } } }
    }
};
}

__device__ __forceinline__ void p0_transpose_item(const float* W, int K, int N, bf16* WT, LAS float* scr, int item, int lane) {
    const int nblk = N / 32, kb = item / nblk, nb = item % nblk, k0 = 64 * kb, n0 = 32 * nb;
#pragma unroll 8
    for (int i = 0; i < 32; ++i) { const int kk = 2 * i + (lane >> 5); scr[kk * 33 + (lane & 31)] = W[(size_t)(k0 + kk) * N + n0 + (lane & 31)]; }
    LDS_WAIT(); asm volatile("" ::: "memory");
    const int c = lane & 7;
#pragma unroll
    for (int j = 0; j < 4; ++j) { const int n = (lane >> 3) + 8 * j; const LAS float* s = scr + (8 * c) * 33 + n;
        v4u o; o.x = pk2(s[0 * 33], s[1 * 33]); o.y = pk2(s[2 * 33], s[3 * 33]); o.z = pk2(s[4 * 33], s[5 * 33]); o.w = pk2(s[6 * 33], s[7 * 33]);
        *(GAS v4u*)(WT + (size_t)(n0 + n) * K + k0 + 8 * c) = o; }
    LDS_WAIT(); asm volatile("" ::: "memory");
}
__device__ __forceinline__ void p0_convert(const float* src, bf16* dst, size_t n8, size_t gtid, size_t gthreads) {
    for (size_t i = gtid; i < n8; i += gthreads) { const f32x4 a = *(const GAS f32x4*)(src + i * 8), b = *(const GAS f32x4*)(src + i * 8 + 4);
        v4u o; o.x = pk2(a.x, a.y); o.y = pk2(a.z, a.w); o.z = pk2(b.x, b.y); o.w = pk2(b.z, b.w); *(GAS v4u*)(dst + i * 8) = o; }
}

namespace att {
using s16x4  = __attribute__((ext_vector_type(4))) short;
using f32x16 = __attribute__((ext_vector_type(16))) float;
using u32x4  = __attribute__((ext_vector_type(4))) unsigned;
constexpr int NW = 8, QBLK = 32, KVBLK = 64, LDP = INW;
constexpr float LOG2E = 1.4426950408889634f, CQK = SCALE * LOG2E, THRL = 11.5f, NEGBIG = -1e30f;
constexpr int SHM_V = 16384, SHM_K = 16384;
constexpr int OFF_V = 0, OFF_K = 2 * SHM_V, OFF_WS = OFF_K + 2 * SHM_K, OFF_LUT = OFF_WS + NW * 64 * 4, OFF_GATE = OFF_LUT + 2176, GATE_W = 33 * 32 * 4, OFF_END = OFF_GATE + NW * GATE_W;
static_assert(OFF_END <= RING_BYTES, "attention LDS");
#define KSWZ(row, colB) ((row) * 256 + ((colB) ^ (((row) & 7) << 4)))
#define SBAR() __builtin_amdgcn_sched_barrier(0)
__device__ __forceinline__ int crow(int r, int hi) { return (r & 3) + 8 * (r >> 2) + 4 * hi; }
__device__ __forceinline__ unsigned cvtpk(float lo, float hi) { unsigned r; asm volatile("v_cvt_pk_bf16_f32 %0, %1, %2" : "=v"(r) : "v"(lo), "v"(hi)); return r; }

__device__ __forceinline__ void bias_far(f32x16& p0, f32x16& p1, float rowoff) {
#pragma unroll
  for (int r = 0; r < 16; ++r) { p0[r] = fmaf(p0[r], CQK, rowoff); p1[r] = fmaf(p1[r], CQK, rowoff); }
}
constexpr int LUT_DMAX = 207, LUT_N = 528;
__device__ __forceinline__ void bias_near(f32x16& p0, f32x16& p1, const LAS float* rl, int dist0  , int hi) {
  const LAS float* b = rl + (LUT_DMAX - dist0 + 4 * hi);
#pragma unroll
  for (int r = 0; r < 16; ++r) { const int c = (r & 3) + 8 * (r >> 2); p0[r] = fmaf(p0[r], CQK, b[c]); p1[r] = fmaf(p1[r], CQK, b[c + 32]); }
}
__device__ __forceinline__ void partialSM(f32x16& p0, f32x16& p1, float& m_reg, float& mn, float& alpha) {
  float pmax = p0[0];
#pragma unroll
  for (int r = 1; r < 16; ++r) pmax = fmaxf(pmax, p0[r]);
#pragma unroll
  for (int r = 0; r < 16; ++r) pmax = fmaxf(pmax, p1[r]);
  { auto rr = __builtin_amdgcn_permlane32_swap(__float_as_uint(pmax), __float_as_uint(pmax), false, false);
    pmax = fmaxf(__uint_as_float(rr[0]), __uint_as_float(rr[1])); }
  if (__builtin_expect(__all(pmax - m_reg <= THRL), 1)) { mn = m_reg; alpha = 1.f; }
  else { mn = fmaxf(m_reg, pmax); alpha = __builtin_amdgcn_exp2f(m_reg - mn); m_reg = mn; }
#pragma unroll
  for (int r = 0; r < 16; ++r) { p0[r] -= mn; p1[r] -= mn; }
#pragma unroll
  for (int r = 0; r < 16; ++r) p0[r] = __builtin_amdgcn_exp2f(p0[r]);
}
__device__ __forceinline__ void finishSM(f32x16& p0, f32x16& p1, float alpha, float& l_reg, bf16x8& pa0, bf16x8& pa1, bf16x8& pa2, bf16x8& pa3) {
#pragma unroll
  for (int r = 0; r < 16; ++r) p1[r] = __builtin_amdgcn_exp2f(p1[r]);
  float ps = 0;
#pragma unroll
  for (int r = 0; r < 16; ++r) ps += p0[r];
#pragma unroll
  for (int r = 0; r < 16; ++r) ps += p1[r];
  { auto rr = __builtin_amdgcn_permlane32_swap(__float_as_uint(ps), __float_as_uint(ps), false, false);
    ps = __uint_as_float(rr[0]) + __uint_as_float(rr[1]); }
  l_reg = l_reg * alpha + ps;
#define PK4(P, BASE, OUT) do { unsigned a0 = cvtpk(P[BASE + 0], P[BASE + 1]), a1 = cvtpk(P[BASE + 2], P[BASE + 3]);   \
    unsigned b0 = cvtpk(P[BASE + 4], P[BASE + 5]), b1 = cvtpk(P[BASE + 6], P[BASE + 7]);                              \
    auto r0 = __builtin_amdgcn_permlane32_swap(a0, b0, false, false); auto r1 = __builtin_amdgcn_permlane32_swap(a1, b1, false, false); \
    u32x4 w = {r0[0], r1[0], r0[1], r1[1]}; OUT = *reinterpret_cast<bf16x8*>(&w); } while (0)
  PK4(p0, 0, pa0); PK4(p0, 8, pa1); PK4(p1, 0, pa2); PK4(p1, 8, pa3);
#undef PK4
}
__device__ __forceinline__ void qkt(f32x16& p0, f32x16& p1, const LAS char* Ks, const bf16x8* qr, int r32, int hi) {
  p0 = f32x16{}; p1 = f32x16{};
#pragma unroll
  for (int d0 = 0; d0 < 8; ++d0) { const int cb = (d0 * 16 + hi * 8) * 2;
    const bf16x8 b0 = *reinterpret_cast<const LAS bf16x8*>(Ks + KSWZ(r32, cb));
    const bf16x8 b1 = *reinterpret_cast<const LAS bf16x8*>(Ks + KSWZ(32 + r32, cb));
    p0 = __builtin_amdgcn_mfma_f32_32x32x16_bf16(b0, qr[d0], p0, 0, 0, 0);
    p1 = __builtin_amdgcn_mfma_f32_32x32x16_bf16(b1, qr[d0], p1, 0, 0, 0); }
}
__device__ __forceinline__ int v_st(int k, int c) { const int kk = (k & ~0xC) | ((k & 4) << 1) | ((k & 8) >> 1); return ((kk >> 3) * 4 + (c >> 5)) * 512 + ((kk & 7) * 32 + (c & 31)) * 2; }
__device__ __forceinline__ int v_rd_base(int lane) { return ((lane & 3) << 3) | (((lane >> 2) & 3) << 6) | (((lane >> 4) & 1) << 5) | (((lane >> 5) & 1) << 8); }
constexpr int v_rd_off(int d0, int ks, int half) { return d0 * 512 + ks * 4096 + half * 2048; }
template <int OFF> __device__ __forceinline__ s16x4 tr_read(int vb) {
  s16x4 r; asm volatile("ds_read_b64_tr_b16 %0, %1 offset:%2" : "=&v"(r) : "v"(vb), "i"(OFF) : "memory"); return r;
}
template <int D0> __device__ __forceinline__ void pv_one(f32x16& od, int vb, bf16x8 pa0, bf16x8 pa1, bf16x8 pa2, bf16x8 pa3) {
  const s16x4 l0 = tr_read<v_rd_off(D0, 0, 0)>(vb), h0 = tr_read<v_rd_off(D0, 0, 1)>(vb), l1 = tr_read<v_rd_off(D0, 1, 0)>(vb), h1 = tr_read<v_rd_off(D0, 1, 1)>(vb);
  const s16x4 l2 = tr_read<v_rd_off(D0, 2, 0)>(vb), h2 = tr_read<v_rd_off(D0, 2, 1)>(vb), l3 = tr_read<v_rd_off(D0, 3, 0)>(vb), h3 = tr_read<v_rd_off(D0, 3, 1)>(vb);
  asm volatile("s_waitcnt lgkmcnt(0)" ::: "memory"); SBAR();
#define PK(L, H) (bf16x8){L[0], L[1], L[2], L[3], H[0], H[1], H[2], H[3]}
  od = __builtin_amdgcn_mfma_f32_32x32x16_bf16(pa0, PK(l0, h0), od, 0, 0, 0);
  od = __builtin_amdgcn_mfma_f32_32x32x16_bf16(pa1, PK(l1, h1), od, 0, 0, 0);
  od = __builtin_amdgcn_mfma_f32_32x32x16_bf16(pa2, PK(l2, h2), od, 0, 0, 0);
  od = __builtin_amdgcn_mfma_f32_32x32x16_bf16(pa3, PK(l3, h3), od, 0, 0, 0);
#undef PK
}
__device__ __forceinline__ void pv_d0(f32x16* o, int vb, bf16x8 pa0, bf16x8 pa1, bf16x8 pa2, bf16x8 pa3) {
  pv_one<0>(o[0], vb, pa0, pa1, pa2, pa3); pv_one<1>(o[1], vb, pa0, pa1, pa2, pa3); pv_one<2>(o[2], vb, pa0, pa1, pa2, pa3); pv_one<3>(o[3], vb, pa0, pa1, pa2, pa3);
}

struct UnitDesc { const bf16* Q; const bf16* K; const bf16* V; bf16* O; int ldo; int qb; int bias_head;
    int nt;
    int kb0;
    const unsigned short* qlist;
    int nrows;
    int part;
    bf16* PO; float* PML; };

__device__ __forceinline__ void attn_unit(const UnitDesc& u, const float* __restrict__ rel_bias, LAS char* lds, const int wave_id) {
  int tid_ = wave_id * 64 + lane_id(); asm volatile("" : "+v"(tid_));
  const int tid = tid_, wid = tid >> 6, lane = tid & 63, r32 = lane & 31, hi = lane >> 5;
  LAS char* V_lds = lds + OFF_V; LAS char* K_lds = lds + OFF_K;
  LAS float* wsl = (LAS float*)(lds + OFF_WS) + wid * 64; LAS float* li_l = wsl; LAS float* al_l = wsl + 32;
  LAS float* lut = (LAS float*)(lds + OFF_LUT);
  const int q0 = u.qb * 256, qw0 = q0 + wid * QBLK;
  int qpos = qw0 + r32, dsti = (qw0 + r32) * 4 + 3;
  if (u.qlist) { const int i = wid * QBLK + r32; const unsigned e = u.qlist[i < u.nrows ? i : u.nrows - 1]; qpos = (int)(e & 8191u); dsti = i < u.nrows ? qpos * 4 + (int)(e >> 13) : -1; }
  __syncthreads();
  for (int i = tid; i < LUT_N; i += 512) { const int d = LUT_DMAX - i; lut[i] = d < 0 ? NEGBIG : rel_bias[t5_bucket(d > 127 ? 127 : d) * 24 + u.bias_head] * LOG2E; }
  LAS int* rowdst = (LAS int*)(lds + OFF_GATE) + wid * 32;
  if (hi == 0) rowdst[r32] = dsti;
  float m_reg = NEGBIG, l_reg = 0; f32x16 o[4] = {}; bf16x8 qr[8];
  const bf16* Qw = u.Q + (size_t)qpos * LDP + hi * 8;
#pragma unroll
  for (int d0 = 0; d0 < 8; ++d0) qr[d0] = *reinterpret_cast<const bf16x8*>(Qw + d0 * 16);
  const bool gathered = u.qlist != nullptr;
  const int sr = tid >> 4, sc = (tid & 15) * 8, vst0 = v_st(sr, sc), vst1 = v_st(32 + sr, sc);
  const int vb0 = (int)(uintptr_t)V_lds + v_rd_base(lane);
  struct { bf16x8 vs0, vs1, ks0, ks1; } sr_[2];
  const bf16* Kh = u.K + (size_t)u.kb0 * LDP; const bf16* Vh = u.V + (size_t)u.kb0 * LDP;
#define SLOAD(i, k0) do { sr_[i].vs0 = *reinterpret_cast<const bf16x8*>(&Vh[(size_t)((k0) + sr) * LDP + sc]); sr_[i].vs1 = *reinterpret_cast<const bf16x8*>(&Vh[(size_t)((k0) + 32 + sr) * LDP + sc]); \
    sr_[i].ks0 = *reinterpret_cast<const bf16x8*>(&Kh[(size_t)((k0) + sr) * LDP + sc]); sr_[i].ks1 = *reinterpret_cast<const bf16x8*>(&Kh[(size_t)((k0) + 32 + sr) * LDP + sc]); } while (0)
#define SWRITE(b, i) do { *(LAS bf16x8*)(V_lds + (b) * SHM_V + vst0) = sr_[i].vs0; *(LAS bf16x8*)(V_lds + (b) * SHM_V + vst1) = sr_[i].vs1; const int kc = sc * 2; \
    *(LAS bf16x8*)(K_lds + (b) * SHM_K + KSWZ(sr, kc)) = sr_[i].ks0; *(LAS bf16x8*)(K_lds + (b) * SHM_K + KSWZ(32 + sr, kc)) = sr_[i].ks1; } while (0)
#define SWAIT() asm volatile("s_waitcnt vmcnt(4)" ::: "memory")
#define RESC(a) do { if (__any((a) < 1.f)) { if (hi == 0) al_l[r32] = (a); asm volatile("s_waitcnt lgkmcnt(0)" ::: "memory"); \
    _Pragma("unroll") for (int d = 0; d < 4; ++d) _Pragma("unroll") for (int r = 0; r < 16; ++r) o[d][r] *= al_l[crow(r, hi)]; } } while (0)
#define BIAS(P0, P1, j) do { const int k0_ = u.kb0 + (j) * KVBLK; \
    if (!gathered && qw0 - k0_ - 63 >= 113) bias_far(P0, P1, b31c); else { const int d_ = qpos - k0_; bias_near(P0, P1, lut, d_ > LUT_DMAX ? LUT_DMAX : d_, hi); } } while (0)
  f32x16 pA0, pA1, pB0, pB1; float mnA, mnB, alA, alB; bf16x8 pa0, pa1, pa2, pa3; const int NT = u.nt;
  constexpr int SE = 0, SO = 1;
  SLOAD(SE, 0); asm volatile("s_waitcnt vmcnt(0)" ::: "memory"); SWRITE(0, SE); __syncthreads();
  const float b31c = lut[LUT_DMAX - 127];
  qkt(pA0, pA1, K_lds, qr, r32, hi); BIAS(pA0, pA1, 0); partialSM(pA0, pA1, m_reg, mnA, alA);
  SLOAD(SO, KVBLK); if (2 < NT) SLOAD(SE, 2 * KVBLK);
  SWAIT(); SWRITE(1, SO); __syncthreads();
  for (int j = 1; j + 1 < NT; j += 2) {
    SBAR(); qkt(pB0, pB1, K_lds + SHM_K, qr, r32, hi);
    finishSM(pA0, pA1, alA, l_reg, pa0, pa1, pa2, pa3); SBAR();
    SLOAD(SO, (j + 2) * KVBLK); SBAR();
    pv_d0(o, vb0, pa0, pa1, pa2, pa3); BIAS(pB0, pB1, j); partialSM(pB0, pB1, m_reg, mnB, alB);
    __syncthreads(); SWAIT(); SWRITE(0, SE);
    RESC(alB); __syncthreads();
    SBAR(); qkt(pA0, pA1, K_lds, qr, r32, hi);
    finishSM(pB0, pB1, alB, l_reg, pa0, pa1, pa2, pa3); SBAR();
    if (j + 3 < NT) SLOAD(SE, (j + 3) * KVBLK); SBAR();
    pv_d0(o, vb0 + SHM_V, pa0, pa1, pa2, pa3); BIAS(pA0, pA1, j + 1); partialSM(pA0, pA1, m_reg, mnA, alA);
    __syncthreads(); SWAIT(); SWRITE(1, SO);
    RESC(alA); __syncthreads();
  }
  SBAR(); qkt(pB0, pB1, K_lds + SHM_K, qr, r32, hi);
  finishSM(pA0, pA1, alA, l_reg, pa0, pa1, pa2, pa3); SBAR();
  pv_d0(o, vb0, pa0, pa1, pa2, pa3); BIAS(pB0, pB1, NT - 1); partialSM(pB0, pB1, m_reg, mnB, alB);
  __syncthreads(); RESC(alB);
  finishSM(pB0, pB1, alB, l_reg, pa0, pa1, pa2, pa3); SBAR();
  pv_d0(o, vb0 + SHM_V, pa0, pa1, pa2, pa3);
  if (u.part) {
    if (hi == 0 && dsti >= 0) { u.PML[(size_t)dsti * 2] = m_reg; u.PML[(size_t)dsti * 2 + 1] = l_reg; }
    asm volatile("s_waitcnt lgkmcnt(0)" ::: "memory");
#pragma unroll
    for (int r = 0; r < 16; ++r) { const int di = rowdst[crow(r, hi)];
      if (di >= 0) { bf16* Ow = u.PO + (size_t)di * 128 + r32;
#pragma unroll
        for (int d0 = 0; d0 < 4; ++d0) Ow[d0 * 32] = (bf16)f2bf(o[d0][r]); } }
  } else {
    if (hi == 0) li_l[r32] = l_reg; asm volatile("s_waitcnt lgkmcnt(0)" ::: "memory");
    float rli[16];
#pragma unroll
    for (int r = 0; r < 16; ++r) rli[r] = __builtin_amdgcn_rcpf(li_l[crow(r, hi)]);
    bf16* Ow = u.O + (size_t)qw0 * u.ldo;
#pragma unroll
    for (int r = 0; r < 16; ++r) { const int orow = crow(r, hi);
#pragma unroll
      for (int d0 = 0; d0 < 4; ++d0) Ow[(size_t)orow * u.ldo + d0 * 32 + r32] = (bf16)f2bf(o[d0][r] * rli[r]); } }
#undef SLOAD
#undef SWRITE
#undef SWAIT
#undef RESC
#undef BIAS
}
constexpr int MX_LUT = RING_BYTES + 512, MX_WS = MX_LUT + 2176, MX_ROW = MX_WS + NW * 256, MX_CNT = MX_ROW + NW * 128, MX_PFX = MX_CNT + 64, MX_END = MX_PFX + 2048 + 64;
static_assert(MX_END <= LDS_BYTES, "MoBA LDS");
struct MobaUnit { const bf16* Q; const bf16* K; const bf16* V; int kb0; int bias_head; const unsigned short* qlist; int cnt; int c_begin, c_end; bf16* PO; float* PML; };
__device__ __forceinline__ void moba_unit(const MobaUnit& u, const float* __restrict__ rel_bias, LAS char* lds, const int wave_id) {
  int tid_ = wave_id * 64 + lane_id(); asm volatile("" : "+v"(tid_));
  const int tid = tid_, wid = tid >> 6, lane = tid & 63, r32 = lane & 31, hi = lane >> 5;
  LAS char* K_lds = lds; LAS char* V_lds = lds + 65536;
  LAS float* lut = (LAS float*)(lds + MX_LUT); LAS float* al_l = (LAS float*)(lds + MX_WS) + wid * 64;
  LAS int* rowdst = (LAS int*)(lds + MX_ROW) + wid * 32; LAS int* ccnt = (LAS int*)(lds + MX_CNT);
  __syncthreads();
  { const int sr = tid >> 4, sc = (tid & 15) * 8; const bf16* Kh = u.K + (size_t)u.kb0 * LDP; const bf16* Vh = u.V + (size_t)u.kb0 * LDP;
    bf16x8 kv[8], vv[8];
#pragma unroll
    for (int t = 0; t < 4; ++t) { kv[2 * t] = *reinterpret_cast<const bf16x8*>(&Kh[(size_t)(64 * t + sr) * LDP + sc]); kv[2 * t + 1] = *reinterpret_cast<const bf16x8*>(&Kh[(size_t)(64 * t + 32 + sr) * LDP + sc]);
                                  vv[2 * t] = *reinterpret_cast<const bf16x8*>(&Vh[(size_t)(64 * t + sr) * LDP + sc]); vv[2 * t + 1] = *reinterpret_cast<const bf16x8*>(&Vh[(size_t)(64 * t + 32 + sr) * LDP + sc]); }
    for (int i = tid; i < LUT_N; i += 512) { const int d = LUT_DMAX - i; lut[i] = d < 0 ? NEGBIG : rel_bias[t5_bucket(d > 127 ? 127 : d) * 24 + u.bias_head] * LOG2E; }
    if (tid == 0) ccnt[0] = u.c_begin;
#pragma unroll
    for (int t = 0; t < 4; ++t) { *(LAS bf16x8*)(K_lds + t * SHM_K + KSWZ(sr, sc * 2)) = kv[2 * t]; *(LAS bf16x8*)(K_lds + t * SHM_K + KSWZ(32 + sr, sc * 2)) = kv[2 * t + 1];
                                  *(LAS bf16x8*)(V_lds + t * SHM_V + v_st(sr, sc)) = vv[2 * t]; *(LAS bf16x8*)(V_lds + t * SHM_V + v_st(32 + sr, sc)) = vv[2 * t + 1]; } }
  __syncthreads();
  const int vb0 = (int)(uintptr_t)V_lds + v_rd_base(lane);
#define MX_TAKE(c_) do { int t_ = 0; if (lane == 0) t_ = __hip_atomic_fetch_add(ccnt, 1, __ATOMIC_RELAXED, __HIP_MEMORY_SCOPE_WORKGROUP); c_ = __builtin_amdgcn_readfirstlane(t_); } while (0)
#define MX_ROWS(c_, qpos_, dst_) do { if ((c_) < 8) { qpos_ = u.kb0 + 32 * (c_) + r32; dst_ = qpos_ * 4 + 3; } \
    else { const int i_ = ((c_) - 8) * 32 + r32; const unsigned e_ = u.qlist[i_ < u.cnt ? i_ : u.cnt - 1]; qpos_ = (int)(e_ & 8191u); dst_ = i_ < u.cnt ? qpos_ * 4 + (int)(e_ >> 13) : -1; } } while (0)
#define MX_QLOAD(dstq, qpos_) do { const bf16* Qw_ = u.Q + (size_t)(qpos_) * LDP + hi * 8; _Pragma("unroll") for (int d0 = 0; d0 < 8; ++d0) dstq[d0] = *reinterpret_cast<const bf16x8*>(Qw_ + d0 * 16); } while (0)
#define MX_RESC(a) do { if (__any((a) < 1.f)) { if (hi == 0) al_l[r32] = (a); asm volatile("s_waitcnt lgkmcnt(0)" ::: "memory"); \
    _Pragma("unroll") for (int d = 0; d < 4; ++d) _Pragma("unroll") for (int r = 0; r < 16; ++r) o[d][r] *= al_l[crow(r, hi)]; } } while (0)
#define MX_BIAS(P0, P1, t) do { const int d_ = qpos - (u.kb0 + (t) * KVBLK); bias_near(P0, P1, lut, d_ > LUT_DMAX ? LUT_DMAX : d_, hi); } while (0)
  int c, cn; MX_TAKE(c);
  if (c >= u.c_end) return;
  int qpos, dsti, qposn = 0, dstn = -1; bf16x8 qr[8], qn[8];
  MX_ROWS(c, qpos, dsti); MX_QLOAD(qr, qpos);
  for (;;) {
    MX_TAKE(cn);
    if (cn < u.c_end) { MX_ROWS(cn, qposn, dstn); MX_QLOAD(qn, qposn); }
    if (hi == 0) rowdst[r32] = dsti;
    float m_reg = NEGBIG, l_reg = 0; f32x16 o[4] = {}; f32x16 pA0, pA1, pB0, pB1; float mnA, mnB, alA, alB; bf16x8 pa0, pa1, pa2, pa3;
    qkt(pA0, pA1, K_lds, qr, r32, hi); MX_BIAS(pA0, pA1, 0); partialSM(pA0, pA1, m_reg, mnA, alA);
    SBAR(); qkt(pB0, pB1, K_lds + SHM_K, qr, r32, hi); finishSM(pA0, pA1, alA, l_reg, pa0, pa1, pa2, pa3); SBAR();
    pv_d0(o, vb0, pa0, pa1, pa2, pa3); MX_BIAS(pB0, pB1, 1); partialSM(pB0, pB1, m_reg, mnB, alB); MX_RESC(alB);
    SBAR(); qkt(pA0, pA1, K_lds + 2 * SHM_K, qr, r32, hi); finishSM(pB0, pB1, alB, l_reg, pa0, pa1, pa2, pa3); SBAR();
    pv_d0(o, vb0 + SHM_V, pa0, pa1, pa2, pa3); MX_BIAS(pA0, pA1, 2); partialSM(pA0, pA1, m_reg, mnA, alA); MX_RESC(alA);
    SBAR(); qkt(pB0, pB1, K_lds + 3 * SHM_K, qr, r32, hi); finishSM(pA0, pA1, alA, l_reg, pa0, pa1, pa2, pa3); SBAR();
    pv_d0(o, vb0 + 2 * SHM_V, pa0, pa1, pa2, pa3); MX_BIAS(pB0, pB1, 3); partialSM(pB0, pB1, m_reg, mnB, alB); MX_RESC(alB);
    finishSM(pB0, pB1, alB, l_reg, pa0, pa1, pa2, pa3); SBAR();
    pv_d0(o, vb0 + 3 * SHM_V, pa0, pa1, pa2, pa3);
    if (hi == 0 && dsti >= 0) { u.PML[(size_t)dsti * 2] = m_reg; u.PML[(size_t)dsti * 2 + 1] = l_reg; }
    asm volatile("s_waitcnt lgkmcnt(0)" ::: "memory");
#pragma unroll
    for (int r = 0; r < 16; ++r) { const int di = rowdst[crow(r, hi)];
      if (di >= 0) { bf16* Ow = u.PO + (size_t)di * 128 + r32;
#pragma unroll
        for (int d0 = 0; d0 < 4; ++d0) Ow[d0 * 32] = (bf16)f2bf(o[d0][r]); } }
    if (cn >= u.c_end) break;
    c = cn; qpos = qposn; dsti = dstn;
#pragma unroll
    for (int d0 = 0; d0 < 8; ++d0) qr[d0] = qn[d0];
  }
#undef MX_TAKE
#undef MX_ROWS
#undef MX_QLOAD
#undef MX_RESC
#undef MX_BIAS
}
}

__device__ __forceinline__ void p0_transpose_item8(const float* W, int K, int N, unsigned char* WT, float scale, LAS float* scr, int item, int lane) {
    const int nblk = N / 32, kb = item / nblk, nb = item % nblk, k0 = 64 * kb, n0 = 32 * nb;
#pragma unroll 8
    for (int i = 0; i < 32; ++i) { const int kk = 2 * i + (lane >> 5); scr[kk * 33 + (lane & 31)] = W[(size_t)(k0 + kk) * N + n0 + (lane & 31)]; }
    LDS_WAIT(); asm volatile("" ::: "memory");
    const int n = lane >> 1, kh = (lane & 1) * 32; const LAS float* sp = scr + kh * 33 + n;
    v4u o0, o1;
    o0.x = pk4_fp8(sp[0 * 33] * scale, sp[1 * 33] * scale, sp[2 * 33] * scale, sp[3 * 33] * scale); o0.y = pk4_fp8(sp[4 * 33] * scale, sp[5 * 33] * scale, sp[6 * 33] * scale, sp[7 * 33] * scale);
    o0.z = pk4_fp8(sp[8 * 33] * scale, sp[9 * 33] * scale, sp[10 * 33] * scale, sp[11 * 33] * scale); o0.w = pk4_fp8(sp[12 * 33] * scale, sp[13 * 33] * scale, sp[14 * 33] * scale, sp[15 * 33] * scale);
    o1.x = pk4_fp8(sp[16 * 33] * scale, sp[17 * 33] * scale, sp[18 * 33] * scale, sp[19 * 33] * scale); o1.y = pk4_fp8(sp[20 * 33] * scale, sp[21 * 33] * scale, sp[22 * 33] * scale, sp[23 * 33] * scale);
    o1.z = pk4_fp8(sp[24 * 33] * scale, sp[25 * 33] * scale, sp[26 * 33] * scale, sp[27 * 33] * scale); o1.w = pk4_fp8(sp[28 * 33] * scale, sp[29 * 33] * scale, sp[30 * 33] * scale, sp[31 * 33] * scale);
    GAS v4u* dst = (GAS v4u*)(WT + (size_t)(n0 + n) * K + k0 + kh); dst[0] = o0; dst[1] = o1;
    LDS_WAIT(); asm volatile("" ::: "memory");
}
struct TrJob { const float* W; unsigned char* WT; int K, N; float scale; int f8; int item; };
__device__ __forceinline__ void tr_load(const TrJob& j, f32x4 (&v)[16], int lane) {
    const int nblk = j.N / 64, kb = j.item / nblk, nb = j.item % nblk; const float* p = j.W + (size_t)(64 * kb + (lane >> 4)) * j.N + 64 * nb + 4 * (lane & 15);
#pragma unroll
    for (int i = 0; i < 16; ++i) v[i] = *(const GAS f32x4*)(p + (size_t)(4 * i) * j.N);
}
__device__ __forceinline__ void tr_to_lds(const f32x4 (&v)[16], LAS float* scr, int lane) {
#pragma unroll
    for (int i = 0; i < 16; ++i) *(LAS f32x4*)(scr + (4 * i + (lane >> 4)) * 64 + 4 * (lane & 15)) = v[i];
}
__device__ __forceinline__ void tr_finish(const TrJob& j, LAS float* scr, int lane) {
    const int nblk = j.N / 64, kb = j.item / nblk, nb = j.item % nblk, k0 = 64 * kb, n0 = 64 * nb, part = lane & 3;
    LDS_WAIT(); asm volatile("" ::: "memory");
#pragma unroll
    for (int p = 0; p < 4; ++p) { const int n = 16 * p + (lane >> 2); const LAS float* sp = scr + (16 * part) * 64 + n; float x[16];
#pragma unroll
        for (int q = 0; q < 16; ++q) x[q] = sp[q * 64] * j.scale;
        if (j.f8) { v4u o; o.x = pk4_fp8(x[0], x[1], x[2], x[3]); o.y = pk4_fp8(x[4], x[5], x[6], x[7]); o.z = pk4_fp8(x[8], x[9], x[10], x[11]); o.w = pk4_fp8(x[12], x[13], x[14], x[15]);
            *(GAS v4u*)(j.WT + (size_t)(n0 + n) * j.K + k0 + 16 * part) = o; }
        else { v4u o0, o1; o0.x = pk2(x[0], x[1]); o0.y = pk2(x[2], x[3]); o0.z = pk2(x[4], x[5]); o0.w = pk2(x[6], x[7]); o1.x = pk2(x[8], x[9]); o1.y = pk2(x[10], x[11]); o1.z = pk2(x[12], x[13]); o1.w = pk2(x[14], x[15]);
            GAS v4u* d = (GAS v4u*)(j.WT + ((size_t)(n0 + n) * j.K + k0 + 16 * part) * 2); d[0] = o0; d[1] = o1; } }
    LDS_WAIT(); asm volatile("" ::: "memory");
}
__device__ __forceinline__ void p0_convert8(const float* src, unsigned char* dst, float scale, size_t n16, size_t gtid, size_t gthreads) {
    for (size_t i = gtid; i < n16; i += gthreads) { const GAS f32x4* p = (const GAS f32x4*)(src + i * 16); const f32x4 a = p[0] * scale, b = p[1] * scale, c = p[2] * scale, d = p[3] * scale;
        v4u o; o.x = pk4_fp8(a.x, a.y, a.z, a.w); o.y = pk4_fp8(b.x, b.y, b.z, b.w); o.z = pk4_fp8(c.x, c.y, c.z, c.w); o.w = pk4_fp8(d.x, d.y, d.z, d.w); *(GAS v4u*)(dst + i * 16) = o; }
}

namespace rt {
using f32x16 = __attribute__((ext_vector_type(16))) float;
__device__ __forceinline__ void ins16(float (&val)[16], int (&idx)[16], float v, int i) {
#pragma unroll
    for (int s = 0; s < 16; ++s) { const bool gt = v > val[s]; const float tv = gt ? val[s] : v; const int ti = gt ? idx[s] : i; val[s] = gt ? v : val[s]; idx[s] = gt ? i : idx[s]; v = tv; i = ti; }
}
__device__ __forceinline__ void side_top16(const bf16* q, const bf16* keys, int r32, int hi, float (&val)[16], int (&idx)[16]) {
    bf16x8 qf[8];
#pragma unroll
    for (int d0 = 0; d0 < 8; ++d0) qf[d0] = *reinterpret_cast<const bf16x8*>(q + d0 * 16 + hi * 8);
    f32x16 acc[4];
#pragma unroll
    for (int nb = 0; nb < 4; ++nb) { acc[nb] = f32x16{};
#pragma unroll
        for (int d0 = 0; d0 < 8; ++d0) { const bf16x8 kf = *reinterpret_cast<const bf16x8*>(keys + (32 * nb + r32) * 128 + d0 * 16 + hi * 8);
            acc[nb] = __builtin_amdgcn_mfma_f32_32x32x16_bf16(kf, qf[d0], acc[nb], 0, 0, 0); } }
#pragma unroll
    for (int s = 0; s < 16; ++s) { val[s] = -3.0e38f; idx[s] = 0; }
#pragma unroll
    for (int nb = 0; nb < 4; ++nb)
#pragma unroll
        for (int r = 0; r < 16; ++r) ins16(val, idx, acc[nb][r], 32 * nb + (r & 3) + 8 * (r >> 2) + 4 * hi);
    float pv[16]; int pi[16];
#pragma unroll
    for (int s = 0; s < 16; ++s) { pv[s] = __shfl_xor(val[s], 32); pi[s] = __shfl_xor(idx[s], 32); }
#pragma unroll
    for (int s = 0; s < 16; ++s) ins16(val, idx, pv[s], pi[s]);
}
template <int I, int J> struct Cand {
    static __device__ __forceinline__ void run(float (&cv)[16], int (&ci)[16], const float (&v1)[16], const float (&v2)[16], const int (&i1)[16], const int (&i2)[16]) {
        if constexpr ((I + 1) * (J + 1) <= 16) { ins16(cv, ci, v1[I] + v2[J], i1[I] * 128 + i2[J]); Cand<I, J + 1>::run(cv, ci, v1, v2, i1, i2); }
        else if constexpr (I + 1 < 16) Cand<I + 1, 0>::run(cv, ci, v1, v2, i1, i2);
    }
};
template <int I> struct Cand<I, 16> { static __device__ __forceinline__ void run(float (&cv)[16], int (&ci)[16], const float (&v1)[16], const float (&v2)[16], const int (&i1)[16], const int (&i2)[16]) {
        if constexpr (I + 1 < 16) Cand<I + 1, 0>::run(cv, ci, v1, v2, i1, i2); } };
constexpr int OFF_E = 0, OFF_G = 16384;
__device__ __forceinline__ void route_block(int t0, const bf16* PQ, const bf16* KEYSB, unsigned char* GD, int* EIDX, float* GATES, LAS char* lds, const int wave_id) {
    int tid_ = wave_id * 64 + lane_id(); asm volatile("" : "+v"(tid_));
    const int tid = tid_, h = tid >> 6, lane = tid & 63, r32 = lane & 31, hi = lane >> 5;
    LAS int* ent_e = (LAS int*)(lds + OFF_E); LAS float* ent_g = (LAS float*)(lds + OFF_G);
    __syncthreads();
    const bf16* q = PQ + (size_t)(t0 + r32) * 2048 + h * 256;
    float v1[16], v2[16], cv[16]; int i1[16], i2[16], ci[16];
    side_top16(q, KEYSB, r32, hi, v1, i1);
    side_top16(q + 128, KEYSB + 128 * 128, r32, hi, v2, i2);
#pragma unroll
    for (int s = 0; s < 16; ++s) { cv[s] = -3.0e38f; ci[s] = 0; }
    Cand<0, 0>::run(cv, ci, v1, v2, i1, i2);
    const float mx = cv[0]; float sum = 0.f;
#pragma unroll
    for (int s = 0; s < 16; ++s) { cv[s] = __expf(cv[s] - mx); sum += cv[s]; }
    const float inv = 1.0f / sum;
    if (hi == 0) {
#pragma unroll
        for (int s = 0; s < 16; ++s) { ent_e[r32 * 128 + h * 16 + s] = ci[s]; ent_g[r32 * 128 + h * 16 + s] = cv[s] * inv; }
        if (EIDX) {
#pragma unroll
            for (int s = 0; s < 16; ++s) { EIDX[(size_t)(t0 + r32) * 128 + h * 16 + s] = ci[s]; GATES[(size_t)(t0 + r32) * 128 + h * 16 + s] = cv[s] * inv; } }
    }
    __syncthreads();
    { const int tok = tid >> 4, s0 = (tid & 15) * 8;
        for (int k = 0; k < 8; ++k) { const int sidx = s0 + k, e = ent_e[tok * 128 + sidx]; float g = 0.f; bool first = true;
            for (int s2 = 0; s2 < 128; ++s2) { if (ent_e[tok * 128 + s2] == e) { g += ent_g[tok * 128 + s2]; if (s2 < sidx) first = false; } }
            if (first) GD[(size_t)(t0 + tok) * 16384 + e] = (unsigned char)(pk4_fp8(g * 256.f, 0.f, 0.f, 0.f) & 0xffu); } }
}
}

__device__ __forceinline__ float wave_sum(float v) {
#pragma unroll
    for (int o = 1; o < 64; o <<= 1) v += __shfl_xor(v, o);
    return v;
}
__device__ __forceinline__ void ln_row(const float* in, const float* g, const float* b, float* outf, bf16* outb, unsigned char* outq, int lane, float mul = 1.0f) {
    f32x4 v[16]; float s = 0.f;
#pragma unroll
    for (int j = 0; j < 16; ++j) { v[j] = *(const GAS f32x4*)(in + 256 * j + 4 * lane); s += (v[j].x + v[j].y) + (v[j].z + v[j].w); }
    const float mean = wave_sum(s) * (1.0f / DM); float s2 = 0.f;
#pragma unroll
    for (int j = 0; j < 16; ++j) { v[j] = v[j] - mean; s2 += (v[j].x * v[j].x + v[j].y * v[j].y) + (v[j].z * v[j].z + v[j].w * v[j].w); }
    const float rstd = rsqrtf(wave_sum(s2) * (1.0f / DM) + LN_EPS);
#pragma unroll
    for (int j = 0; j < 16; ++j) { const f32x4 gv = *(const GAS f32x4*)(g + 256 * j + 4 * lane), bv = *(const GAS f32x4*)(b + 256 * j + 4 * lane); const f32x4 y = (v[j] * rstd * gv + bv) * mul;
        *(GAS f32x4*)(outf + 256 * j + 4 * lane) = y;
        if (outb) { v2u o; o.x = pk2(y.x, y.y); o.y = pk2(y.z, y.w); *(GAS v2u*)(outb + 256 * j + 4 * lane) = o; }
        if (outq) *(GAS unsigned*)(outq + 256 * j + 4 * lane) = pk4_fp8(y.x, y.y, y.z, y.w); }
}

struct Args { const float* in[21]; float* out; unsigned char* ws; int ph_lo, ph_hi; };
constexpr size_t WS_CTL = 0, WS_KMEANB = 1 * MiB, WS_KEYSB = 1 * MiB + 512 * 1024;
constexpr size_t WS_WINT = 2 * MiB, WS_MERGED = 2 * MiB, WS_X1B = 66 * MiB, WS_PQ = 130 * MiB;
constexpr size_t WS_XB = 162 * MiB, WS_YA = 162 * MiB, WS_YB = 194 * MiB;
constexpr size_t WS_PROJ = 226 * MiB, WS_G = 226 * MiB;
constexpr size_t WS_OP0 = 546 * MiB, WS_OP1 = 578 * MiB, WS_WOA = 610 * MiB, WS_WOB = 626 * MiB, WS_WOUT = 642 * MiB, WS_WQ = 674 * MiB, WS_UB = 690 * MiB, WS_VT = 818 * MiB, WS_X1F = 946 * MiB;
constexpr size_t WS_MLIST = 2 * MiB, WS_PO = 10 * MiB, WS_PML = 138 * MiB;
constexpr int CW_CNT = 8192, CNT_STRIDE = 64, CW_QUEUE = 49152;
constexpr size_t WS_EIDX = 1074 * MiB, WS_GATES = 1078 * MiB, WS_NEED = 1082 * MiB;

__global__ void __launch_bounds__(NWAVES * 64, 2) mega_fwd(Args args) {
    extern __shared__ __attribute__((aligned(16))) unsigned char lds_raw[];
    LAS unsigned char* lds = (LAS unsigned char*)lds_raw;
    volatile LAS unsigned* MISC = (volatile LAS unsigned*)(lds + MISC_OFF);
    const int wave = __builtin_amdgcn_readfirstlane((int)threadIdx.x >> 6);
#define lane (lane_id())
#define tid (wave * 64 + lane_id())
    const int G = gridDim.x; const int vcu = (G % 8 == 0) ? ((int)blockIdx.x % 8) * (G / 8) + (int)blockIdx.x / 8 : (int)blockIdx.x;
    unsigned char* ws = args.ws;
    gu32* ctl = (gu32*)(ws + WS_CTL);
    for (int u = tid; u < (LDS_BYTES - LDSCTL_OFF) / 4; u += NWAVES * 64) ((LAS unsigned*)(lds + LDSCTL_OFF))[u] = 0u;
    __syncthreads();
    XcdBarrier bar = xcd_barrier_post((unsigned*)(ctl + CW_BAR), MISC + 8);
    const int lo = args.ph_lo, hi = args.ph_hi;
#ifdef PROBE_A
#define PR_BEGIN(k) do { if ((k) == PROBE_A && blockIdx.x == 0 && tid == 0) __hip_atomic_store(ctl + 2112, (unsigned)__builtin_amdgcn_s_memrealtime(), RLX_AGENT); } while (0)
#define PR_END(k) do { if ((k) == PROBE_B - 1 && blockIdx.x == 0 && tid == 0) __hip_atomic_store(ctl + 2048, (unsigned)__builtin_amdgcn_s_memrealtime() - __hip_atomic_load(ctl + 2112, RLX_AGENT), RLX_AGENT); } while (0)
#else
#define PR_BEGIN(k)
#define PR_END(k)
#endif
#define IN(k) (lo <= (k) && (k) < hi)
#define BOTH(k) (IN(k) && IN((k) + 1))
#define WINT ((bf16*)(ws + WS_WINT))
#define XB ((bf16*)(ws + WS_XB))
#define PROJ ((bf16*)(ws + WS_PROJ))

#define MERGED ((bf16*)(ws + WS_MERGED))
#define X1B ((bf16*)(ws + WS_X1B))
#define PQ ((bf16*)(ws + WS_PQ))
#define GD ((bf16*)(ws + WS_G))
#define WOA ((bf16*)(ws + WS_WOA))
#define WOB ((bf16*)(ws + WS_WOB))
#define WOUT ((bf16*)(ws + WS_WOUT))
#define WQ ((bf16*)(ws + WS_WQ))
#define UB ((bf16*)(ws + WS_UB))
#define VT ((bf16*)(ws + WS_VT))
#define KEYSB ((bf16*)(ws + WS_KEYSB))
#define X1F ((float*)(ws + WS_X1F))
#define X1Q ((unsigned char*)(ws + WS_OP0))
    if (IN(0)) { PR_BEGIN(0);
        LAS float* scr = (LAS float*)(lds + wave * 16384);
        const int gw = vcu * NWAVES + wave, NGW = G * NWAVES;
        constexpr int I_IN = (DM / 64) * (INW / 64), I_OA = (2048 / 64) * (DM / 64), I_OUT = (DM / 64) * (DM / 64), I_WQ = (DM / 64) * (2048 / 64), I_V = (16384 / 64) * (DM / 64), I_ALL = I_IN + 2 * I_OA + I_OUT + I_WQ + I_V;
#define TR_DECODE(it_, J) do { int r_ = (it_); \
            if (r_ < I_IN) { J.W = args.in[1]; J.WT = (unsigned char*)WINT; J.K = DM; J.N = INW; J.scale = 64.f; J.f8 = 1; } else { r_ -= I_IN; \
            if (r_ < I_OA) { J.W = args.in[9]; J.WT = (unsigned char*)WOA; J.K = 2048; J.N = DM; J.scale = 64.f; J.f8 = 1; } else { r_ -= I_OA; \
            if (r_ < I_OA) { J.W = args.in[10]; J.WT = (unsigned char*)WOB; J.K = 2048; J.N = DM; J.scale = 64.f; J.f8 = 1; } else { r_ -= I_OA; \
            if (r_ < I_OUT) { J.W = args.in[11]; J.WT = (unsigned char*)WOUT; J.K = DM; J.N = DM; J.scale = 64.f; J.f8 = 1; } else { r_ -= I_OUT; \
            if (r_ < I_WQ) { J.W = args.in[14]; J.WT = (unsigned char*)WQ; J.K = DM; J.N = 2048; J.scale = 1.f; J.f8 = 0; } else { r_ -= I_WQ; \
            J.W = args.in[18]; J.WT = (unsigned char*)VT; J.K = 16384; J.N = DM; J.scale = 8.f; J.f8 = 1; } } } } } J.item = r_; } while (0)
        { TrJob jc, jn; f32x4 tv[16]; int it = gw;
          if (it < I_ALL) { TR_DECODE(it, jc); tr_load(jc, tv, lane); }
          while (it < I_ALL) { const int nx = it + NGW; tr_to_lds(tv, scr, lane);
              if (nx < I_ALL) { TR_DECODE(nx, jn); tr_load(jn, tv, lane); }
              tr_finish(jc, scr, lane); jc = jn; it = nx; } }
#undef TR_DECODE
        const size_t gtid = (size_t)blockIdx.x * 512 + tid, gth = (size_t)G * 512;
        p0_convert8(args.in[0], (unsigned char*)XB, 1.0f, (size_t)S * DM / 16, gtid, gth);
        p0_convert8(args.in[17], (unsigned char*)UB, 64.0f, (size_t)16384 * DM / 16, gtid, gth);
        p0_convert(args.in[15], KEYSB, 128 * 128 / 8, gtid, gth);
        p0_convert(args.in[16], KEYSB + 128 * 128, 128 * 128 / 8, gtid, gth);
        PR_END(0); if (BOTH(0)) xcd_barrier(bar);
    }
    if (IN(1)) { PR_BEGIN(1);
        pg8::Gemm g{XB, WINT, XB, WINT, S, INW, DM / 2, (int)(0x01010101u * (127 - 6)), 0}; pg8::StaticOrder So; So.init(S, INW, G, (int)blockIdx.x);
        pg8::EpiStoreBf16 E{PROJ, INW};
        pg8::gemm_phase<pg8::EpiStoreBf16, pg8::StaticOrder, true, false, true>(lds, g, So, E, wave);
        PR_END(1); if (BOTH(1)) xcd_barrier(bar);
    }

#define KMEANB ((bf16*)(ws + WS_KMEANB))
#define YA ((bf16*)(ws + WS_YA))
#define YB ((bf16*)(ws + WS_YB))
#define OP0 ((bf16*)(ws + WS_OP0))
#define OP1 ((bf16*)(ws + WS_OP1))
    if (IN(2)) { PR_BEGIN(2);
        for (int it = vcu * NWAVES + wave; it < 16 * 32; it += G * NWAVES) { const int h = it >> 5, j = it & 31;
            const bf16* kp = PROJ + (size_t)(j * 256) * INW + 2048 + h * 128 + 2 * lane; float s0 = 0.f, s1 = 0.f;
            for (int i = 0; i < 256; ++i) { const unsigned w = *(const unsigned*)(kp + (size_t)i * INW); s0 += bflo(w); s1 += bfhi(w); }
            *(unsigned*)(KMEANB + (size_t)it * 128 + 2 * lane) = pk2(s0 * (1.0f / 256.0f), s1 * (1.0f / 256.0f)); }
        xcd_barrier(bar);
        for (int it8 = vcu; it8 < 16 * 32; it8 += G) { const int h = it8 >> 5, qb = it8 & 31, l_ = lane, r32 = l_ & 31, hi_ = l_ >> 5, q = qb * 256 + wave * 32 + r32;
            LAS int* cntl = (LAS int*)(lds + 4096); LAS int* gbl = cntl + 32;
            __syncthreads();
            if (tid < 32) cntl[tid] = 0;
            __syncthreads();
            int b1i = -1, b2i = -1, b3i = -1, p1 = 0, p2 = 0, p3 = 0;
            if (qb > 0) {
                att::f32x16 g0 = att::f32x16{};
                const bf16* qp = PROJ + (size_t)q * INW + h * 128 + hi_ * 8; const bf16* kp = KMEANB + ((size_t)h * 32 + r32) * 128 + hi_ * 8;
#pragma unroll
                for (int d0 = 0; d0 < 8; ++d0) g0 = __builtin_amdgcn_mfma_f32_32x32x16_bf16(*reinterpret_cast<const bf16x8*>(kp + d0 * 16), *reinterpret_cast<const bf16x8*>(qp + d0 * 16), g0, 0, 0, 0);
                float b1v = -3.0e38f, b2v = -3.0e38f, b3v = -3.0e38f;
#define TOP3_INS(gv, gi) do { const float g_ = (gv); const int j_ = (gi); if (j_ >= 0 && j_ < qb) { \
                    if (g_ > b1v) { b3v = b2v; b3i = b2i; b2v = b1v; b2i = b1i; b1v = g_; b1i = j_; } else if (g_ > b2v) { b3v = b2v; b3i = b2i; b2v = g_; b2i = j_; } else if (g_ > b3v) { b3v = g_; b3i = j_; } } } while (0)
#pragma unroll
                for (int r = 0; r < 16; ++r) TOP3_INS(g0[r], (r & 3) + 8 * (r >> 2) + 4 * hi_);
                { const float x1 = __shfl_xor(b1v, 32), x2 = __shfl_xor(b2v, 32), x3 = __shfl_xor(b3v, 32); const int i1 = __shfl_xor(b1i, 32), i2 = __shfl_xor(b2i, 32), i3 = __shfl_xor(b3i, 32);
                  TOP3_INS(x1, i1); TOP3_INS(x2, i2); TOP3_INS(x3, i3); }
#undef TOP3_INS
                if (hi_ == 0) { if (b1i >= 0) p1 = __hip_atomic_fetch_add(cntl + b1i, 1, __ATOMIC_RELAXED, __HIP_MEMORY_SCOPE_WORKGROUP);
                                if (b2i >= 0) p2 = __hip_atomic_fetch_add(cntl + b2i, 1, __ATOMIC_RELAXED, __HIP_MEMORY_SCOPE_WORKGROUP);
                                if (b3i >= 0) p3 = __hip_atomic_fetch_add(cntl + b3i, 1, __ATOMIC_RELAXED, __HIP_MEMORY_SCOPE_WORKGROUP); }
            }
            __syncthreads();
            if (tid < 32) { const int c = cntl[tid]; gbl[tid] = c > 0 ? (int)__hip_atomic_fetch_add(ctl + CW_CNT + CNT_STRIDE * (h * 32 + tid), (unsigned)c, RLX_AGENT) : 0; }
            __syncthreads();
            if (hi_ == 0) { unsigned short* ML = (unsigned short*)(ws + WS_MLIST) + (size_t)h * 32 * 8192;
                if (b1i >= 0) ML[(size_t)b1i * 8192 + gbl[b1i] + p1] = (unsigned short)(q | (0 << 13));
                if (b2i >= 0) ML[(size_t)b2i * 8192 + gbl[b2i] + p2] = (unsigned short)(q | (1 << 13));
                if (b3i >= 0) ML[(size_t)b3i * 8192 + gbl[b3i] + p3] = (unsigned short)(q | (2 << 13)); }
        }
        PR_END(2); if (BOTH(2)) xcd_barrier(bar);
    }
    if (IN(3)) { PR_BEGIN(3);
#pragma nounroll
        for (int p = 256 + (int)blockIdx.x; p < 768; p += G) {
            const int xcd = p & 7, rank = (p >> 3) & 31, slot = p >> 8, t = rank & 15, gsel = rank >> 4;
#pragma nounroll
            for (int sub = 0; sub < 2; ++sub) {
                att::UnitDesc u; u.qb = sub == 0 ? 31 - t : t; u.ldo = 2048; u.nt = 4 * (u.qb + 1); u.kb0 = 0; u.qlist = nullptr; u.nrows = 256; u.part = 0; u.PO = nullptr; u.PML = nullptr;
                const int pm = slot - 1, h = xcd; u.Q = PROJ + 6144 + h * 256 + pm * 128; u.K = PROJ + 8192 + h * 256 + pm * 128; u.V = PROJ + 10240 + h * 256 + gsel * 128;
                u.O = (pm ? OP1 : OP0) + h * 256 + gsel * 128; u.bias_head = 16 + h;
                att::attn_unit(u, args.in[3], (LAS char*)lds, wave);
            }
        }
        {
            constexpr int MX_CH = 24;
            LAS int* PFX = (LAS int*)(lds + att::MX_PFX); LAS int* QID = PFX + 512;
            __syncthreads();
            { const unsigned c = __hip_atomic_load(ctl + CW_CNT + CNT_STRIDE * tid, RLX_AGENT); PFX[tid] = (int)((8u + ((c + 31u) >> 5) + MX_CH - 1) / MX_CH); }
            __syncthreads();
            int mine = 0; for (int k = 0; k <= tid; ++k) mine += PFX[k];
            __syncthreads();
            PFX[tid] = mine;
            __syncthreads();
            const int total = PFX[511];
#pragma nounroll
            for (;;) {
                if (tid == 0) QID[0] = (int)__hip_atomic_fetch_add(ctl + CW_QUEUE, 1u, RLX_AGENT);
                __syncthreads();
                const int id = __builtin_amdgcn_readfirstlane(QID[0]);
                if (id >= total) break;
                int lo_ = 0, hi2 = 511;
                while (lo_ < hi2) { const int mid = (lo_ + hi2) >> 1; if (PFX[mid] > id) hi2 = mid; else lo_ = mid + 1; }
                const int li = __builtin_amdgcn_readfirstlane(lo_), part = id - (li ? PFX[li - 1] : 0), h = li >> 5;
                att::MobaUnit u; u.cnt = (int)__hip_atomic_load(ctl + CW_CNT + CNT_STRIDE * li, RLX_AGENT); const int nch = 8 + ((u.cnt + 31) >> 5);
                u.c_begin = part * MX_CH; u.c_end = (part + 1) * MX_CH < nch ? (part + 1) * MX_CH : nch; u.kb0 = (li & 31) * 256; u.bias_head = h;
                u.qlist = (const unsigned short*)(ws + WS_MLIST) + (size_t)li * 8192;
                u.Q = PROJ + h * 128; u.K = PROJ + 2048 + h * 128; u.V = PROJ + 4096 + h * 128;
                u.PO = (bf16*)(ws + WS_PO) + (size_t)h * 8192 * 4 * 128; u.PML = (float*)(ws + WS_PML) + (size_t)h * 8192 * 4 * 2;
                att::moba_unit(u, args.in[3], (LAS char*)lds, wave);
            }
        }
        PR_END(3); if (BOTH(3)) xcd_barrier(bar);
    }
    if (IN(4)) { PR_BEGIN(4);
        float a = args.in[4][lane] * args.in[5][lane] + args.in[4][lane + 64] * args.in[5][lane + 64], b = args.in[6][lane] * args.in[7][lane] + args.in[6][lane + 64] * args.in[7][lane + 64];
#pragma unroll
        for (int o = 1; o < 64; o <<= 1) { a += __shfl_xor(a, o); b += __shfl_xor(b, o); }
        const float lam = expf(a) - expf(b) + LAMBDA_INIT;
        const f32x4 gsub = *(const GAS f32x4*)(args.in[8] + 4 * lane);
        for (int it0 = (vcu * NWAVES + wave) * 4; it0 < S * 8; it0 += G * NWAVES * 4) {
            v2u w0[4], w1[4]; size_t off[4];
#pragma unroll
            for (int k = 0; k < 4; ++k) { const int it = it0 + k; off[k] = (size_t)(it >> 3) * 2048 + (it & 7) * 256 + 4 * lane; w0[k] = *(const GAS v2u*)(OP0 + off[k]); w1[k] = *(const GAS v2u*)(OP1 + off[k]); }
#pragma unroll
            for (int k = 0; k < 4; ++k) {
                const float y0 = bflo(w0[k].x) - lam * bflo(w1[k].x), y1 = bfhi(w0[k].x) - lam * bfhi(w1[k].x), y2 = bflo(w0[k].y) - lam * bflo(w1[k].y), y3 = bfhi(w0[k].y) - lam * bfhi(w1[k].y);
                float ss = (y0 * y0 + y1 * y1) + (y2 * y2 + y3 * y3);
#pragma unroll
                for (int o = 1; o < 64; o <<= 1) ss += __shfl_xor(ss, o);
                const float rs = rsqrtf(ss * (1.0f / 256.0f) + LN_EPS) * (1.0f - LAMBDA_INIT);
                *(GAS unsigned*)((unsigned char*)YB + off[k]) = pk4_fp8(8.0f * y0 * rs * gsub.x, 8.0f * y1 * rs * gsub.y, 8.0f * y2 * rs * gsub.z, 8.0f * y3 * rs * gsub.w); } }
        for (int it0 = (vcu * NWAVES + wave) * 4; it0 < S * 16; it0 += G * NWAVES * 4) {
            const int q = it0 >> 4, qb = q >> 8, ns = qb < 3 ? qb : 3;
            float mm[4][4], ll[4][4]; unsigned pw[4][4];
#pragma unroll
            for (int k = 0; k < 4; ++k) { const int h = (it0 & 15) + k; const size_t base = ((size_t)h * 8192 + q) * 4;
                const float* pml = (const float*)(ws + WS_PML) + base * 2; const bf16* po = (const bf16*)(ws + WS_PO) + base * 128 + 2 * lane;
#pragma unroll
                for (int sl = 0; sl < 4; ++sl) { const bool on = sl == 3 || sl < ns; mm[k][sl] = on ? pml[2 * sl] : -3.0e38f; ll[k][sl] = on ? pml[2 * sl + 1] : 0.f; pw[k][sl] = on ? *(const GAS unsigned*)(po + sl * 128) : 0u; } }
#pragma unroll
            for (int k = 0; k < 4; ++k) { const int h = (it0 & 15) + k;
                const float M = fmaxf(fmaxf(mm[k][0], mm[k][1]), fmaxf(mm[k][2], mm[k][3])); float L = 0.f, a0 = 0.f, a1 = 0.f;
#pragma unroll
                for (int sl = 0; sl < 4; ++sl) { const float w = __builtin_amdgcn_exp2f(mm[k][sl] - M); L += w * ll[k][sl]; a0 += w * bflo(pw[k][sl]); a1 += w * bfhi(pw[k][sl]); }
                const float sc = 64.0f / L;
                *(GAS unsigned short*)((unsigned char*)YA + (size_t)q * 2048 + h * 128 + 2 * lane) = (unsigned short)(pk4_fp8(a0 * sc, a1 * sc, 0.f, 0.f) & 0xffffu); } }
        PR_END(4); if (BOTH(4)) xcd_barrier(bar);
    }

    if (IN(5)) { PR_BEGIN(5);
        pg8::Gemm g{YA, WOA, YB, WOB, S, DM, 2048 / 2, (int)(0x01010101u * (127 - 12)), (int)(0x01010101u * (127 - 9))};
        pg8::DualOrder So; So.init(S, DM, G, (int)blockIdx.x);
        pg8::EpiMerge E{(unsigned char*)MERGED, PROJ, args.in[2]};
        pg8::gemm_phase<pg8::EpiMerge, pg8::DualOrder, true, P5_SP2, true>(lds, g, So, E, wave);
        PR_END(5); if (BOTH(5)) xcd_barrier(bar);
    }
    if (IN(6)) { PR_BEGIN(6);
        pg8::Gemm g{MERGED, WOUT, MERGED, WOUT, S, DM, DM / 2, (int)(0x01010101u * (127 - 10)), 0}; pg8::StaticOrder So; So.init(S, DM, G, (int)blockIdx.x);
        pg8::EpiResF32 E{args.out, args.in[0], ALPHA};
        pg8::gemm_phase<pg8::EpiResF32, pg8::StaticOrder, true, P6_SP2, true>(lds, g, So, E, wave);
        PR_END(6); if (BOTH(6)) xcd_barrier(bar);
    }
    if (IN(7)) { PR_BEGIN(7);
        for (int m = vcu * NWAVES + wave; m < S; m += G * NWAVES) ln_row(args.out + (size_t)m * DM, args.in[12], args.in[13], X1F + (size_t)m * DM, X1B + (size_t)m * DM, X1Q + (size_t)m * DM, lane);
        { GAS v4u* gz = (GAS v4u*)GD; const v4u z = {0u, 0u, 0u, 0u}; for (size_t i = (size_t)blockIdx.x * 512 + tid; i < (size_t)S * 16384 / 16; i += (size_t)G * 512) gz[i] = z; }
        PR_END(7); if (BOTH(7)) xcd_barrier(bar);
    }
    if (IN(8)) { PR_BEGIN(8);
        pg8::Gemm g{X1B, WQ, X1B, WQ, S, 2048, DM, 0, 0}; pg8::StaticOrder So; So.init(S, 2048, G, (int)blockIdx.x);
        pg8::EpiStoreBf16 E{PQ, 2048};
        pg8::gemm_phase<pg8::EpiStoreBf16, pg8::StaticOrder, true, true>(lds, g, So, E, wave);
        PR_END(8); if (BOTH(8)) xcd_barrier(bar);
    }
    if (IN(9)) { PR_BEGIN(9);
#pragma nounroll
        for (int b = (int)blockIdx.x; b < S / 32; b += G) rt::route_block(b * 32, PQ, KEYSB, (unsigned char*)GD, nullptr, nullptr, (LAS char*)lds, wave);
        PR_END(9); if (BOTH(9)) xcd_barrier(bar);
    }
    if (IN(10)) { PR_BEGIN(10);
        pg8::Gemm g{(const bf16*)X1Q, UB, (const bf16*)X1Q, UB, S, 16384, DM / 2, (int)(0x01010101u * (127 - 6)), 0}; pg8::StaticOrder So; So.init(S, 16384, G, (int)blockIdx.x);
        pg8::EpiPeerAct E{(unsigned char*)GD};
        pg8::gemm_phase<pg8::EpiPeerAct, pg8::StaticOrder, true, true, true>(lds, g, So, E, wave);
        PR_END(10); if (BOTH(10)) xcd_barrier(bar);
    }
    if (IN(11)) { PR_BEGIN(11);
        pg8::Gemm g{GD, VT, GD, VT, S, DM, 16384 / 2, (int)(0x01010101u * (127 - 9)), 0}; pg8::StaticOrder So; So.init(S, DM, G, (int)blockIdx.x);
        pg8::EpiResF32 E{args.out, X1F, ALPHA};
        pg8::gemm_phase<pg8::EpiResF32, pg8::StaticOrder, true, true, true>(lds, g, So, E, wave);
        PR_END(11); if (BOTH(11)) xcd_barrier(bar);
    }
    if (IN(12)) {
#ifdef PROBE_A
        const float pr_mul = 1.0f + 1e-5f * (float)__hip_atomic_load(ctl + 2048, RLX_AGENT);
#else
        const float pr_mul = 1.0f;
#endif
        for (int m = vcu * NWAVES + wave; m < S; m += G * NWAVES) ln_row(args.out + (size_t)m * DM, args.in[19], args.in[20], args.out + (size_t)m * DM, nullptr, nullptr, lane, pr_mul);
    }
#undef IN
#undef BOTH
#undef lane
#undef tid
#undef WINT
#undef XB
#undef PROJ
#undef MERGED
#undef X1B
#undef PQ
#undef GD
#undef WOA
#undef WOB
#undef WOUT
#undef WQ
#undef UB
#undef VT
#undef KEYSB
#undef X1F
#undef X1Q
#undef KMEANB
#undef YA
#undef YB
#undef OP0
#undef OP1
}

__global__ void shim_proj(const bf16* __restrict__ PROJ, float* __restrict__ ws) {
    const size_t U64 = (size_t)S * 2048;
    const size_t i = (size_t)blockIdx.x * blockDim.x + threadIdx.x; const int row = (int)(i / INW), col = (int)(i % INW);
    const float v = bf2f(PROJ[i]);
    if (col < 12288) { const int t = col >> 11, c = col & 2047; ws[(size_t)t * U64 + (size_t)row * 2048 + c] = v; }
    else { const int t = (col - 12288) >> 12, c = (col - 12288) & 4095; ws[(size_t)(6 + 2 * t) * U64 + (size_t)row * 4096 + c] = v; }
}

__global__ void shim_bf16_f32(const bf16* __restrict__ src, float* __restrict__ dst) { const size_t i = (size_t)blockIdx.x * blockDim.x + threadIdx.x; dst[i] = bf2f(src[i]); }
}

extern "C" void kernel_launch(void* const* d_in, const int* in_sizes, int n_in, void* d_out, int out_size, void* d_ws, size_t ws_size, hipStream_t stream) {
    if (ws_size < WS_NEED) return;
    static int grid = 0;
    if (grid == 0) {
        int dev = 0, cus = 0;
        if (hipGetDevice(&dev) != hipSuccess || hipDeviceGetAttribute(&cus, hipDeviceAttributeMultiprocessorCount, dev) != hipSuccess) { grid = -1; return; }
        if (hipFuncSetAttribute((const void*)mega_fwd, hipFuncAttributeMaxDynamicSharedMemorySize, LDS_BYTES) != hipSuccess) { grid = -1; return; }
        grid = cus;
    }
    if (grid < 0) return;
    (void)hipMemsetAsync((char*)d_ws + WS_CTL, 0, CTL_ZERO_BYTES, stream);
    Args a{};
    for (int i = 0; i < 21; ++i) a.in[i] = (const float*)d_in[i];
    a.out = (float*)d_out; a.ws = (unsigned char*)d_ws;
    const int cuts[] = {0, 13};
    for (int li = 0; li + 1 < (int)(sizeof(cuts) / sizeof(int)); ++li) { a.ph_lo = cuts[li]; a.ph_hi = cuts[li + 1];
        hipLaunchKernelGGL(mega_fwd, dim3(grid), dim3(NWAVES * 64), LDS_BYTES, stream, a); }
}
```

```cpp
#include <hip/hip_runtime.h>
#include <math.h>
#include <cstdio>
#include <cstdint>

namespace {
constexpr int S = 8192, DM = 4096, INW = 20480;
constexpr float SCALE = 0.08838834764831845f;
constexpr float ALPHA = 1.189207115002721f;
constexpr float LN_EPS = 1e-5f;
constexpr float LAMBDA_INIT = 0.2f;
typedef float f32x16 __attribute__((ext_vector_type(16)));

__device__ __forceinline__ int t5_bucket(int n) {
    if (n < 16) return n;
    int b = 16;
    b += (n >= 19); b += (n >= 21); b += (n >= 24); b += (n >= 27); b += (n >= 31); b += (n >= 35); b += (n >= 40); b += (n >= 46);
    b += (n >= 52); b += (n >= 59); b += (n >= 67); b += (n >= 77); b += (n >= 87); b += (n >= 99); b += (n >= 113);
    return b;
}

__global__ void __launch_bounds__(256) gemm_f32(const float* __restrict__ A, int lda, const float* __restrict__ B, int ldb, float* __restrict__ C, int ldc, int K,
                                                const float* __restrict__ R, int ldr, float alpha) {
    __shared__ float As[16][132];
    __shared__ float Bs[16][132];
    const int tid = threadIdx.x, lane = tid & 63, wid = tid >> 6, wm = wid >> 1, wn = wid & 1;
    const int m0 = blockIdx.y * 128, n0 = blockIdx.x * 128;
    f32x16 acc[2][2];
    for (int i = 0; i < 2; ++i) for (int j = 0; j < 2; ++j) for (int r = 0; r < 16; ++r) acc[i][j][r] = 0.f;
    for (int k0 = 0; k0 < K; k0 += 16) {
        for (int i = 0; i < 2; ++i) {
            const int idx = tid + i * 256;
            const int r = idx >> 2, c4 = idx & 3;
            const float4 v = *(const float4*)(A + (size_t)(m0 + r) * lda + k0 + c4 * 4);
            As[c4 * 4 + 0][r] = v.x; As[c4 * 4 + 1][r] = v.y; As[c4 * 4 + 2][r] = v.z; As[c4 * 4 + 3][r] = v.w;
            const int kr = idx >> 5, cb = idx & 31;
            const float4 w = *(const float4*)(B + (size_t)(k0 + kr) * ldb + n0 + cb * 4);
            *(float4*)&Bs[kr][cb * 4] = w;
        }
        __syncthreads();
        for (int kk = 0; kk < 16; kk += 2) {
            float a[2], b[2];
            for (int i = 0; i < 2; ++i) a[i] = As[kk + (lane >> 5)][wm * 64 + i * 32 + (lane & 31)];
            for (int j = 0; j < 2; ++j) b[j] = Bs[kk + (lane >> 5)][wn * 64 + j * 32 + (lane & 31)];
            for (int i = 0; i < 2; ++i) for (int j = 0; j < 2; ++j) acc[i][j] = __builtin_amdgcn_mfma_f32_32x32x2f32(a[i], b[j], acc[i][j], 0, 0, 0);
        }
        __syncthreads();
    }
    for (int i = 0; i < 2; ++i) for (int j = 0; j < 2; ++j) for (int r = 0; r < 16; ++r) {
        const int row = m0 + wm * 64 + i * 32 + (r & 3) + 8 * (r >> 2) + 4 * (lane >> 5);
        const int col = n0 + wn * 64 + j * 32 + (lane & 31);
        float v = acc[i][j][r];
        if (R) v += alpha * R[(size_t)row * ldr + col];
        C[(size_t)row * ldc + col] = v;
    }
}

__global__ void transpose_f32(const float* __restrict__ in, int ld_in, float* __restrict__ out, int ld_out) {
    __shared__ float tile[32][33];
    const int tx = threadIdx.x & 31, ty = threadIdx.x >> 5;
    const int r0 = blockIdx.y * 32, c0 = blockIdx.x * 32;
    for (int i = ty; i < 32; i += 8) tile[i][tx] = in[(size_t)(r0 + i) * ld_in + c0 + tx];
    __syncthreads();
    for (int i = ty; i < 32; i += 8) out[(size_t)(c0 + i) * ld_out + r0 + tx] = tile[tx][i];
}

__global__ void kmean_kernel(const float* __restrict__ mk, float* __restrict__ kmean) {
    const int j = blockIdx.x, h = blockIdx.y, d = threadIdx.x;
    float s = 0.f;
    for (int i = 0; i < 256; ++i) s += mk[(size_t)(j * 256 + i) * 2048 + h * 128 + d];
    kmean[(h * 32 + j) * 128 + d] = s * (1.0f / 256.0f);
}

__device__ __forceinline__ float block_reduce(float v, float* red, bool is_max) {
    const int t = threadIdx.x;
    for (int o = 32; o >= 1; o >>= 1) { const float w = __shfl_xor(v, o); v = is_max ? fmaxf(v, w) : v + w; }
    __syncthreads();
    if ((t & 63) == 0) red[t >> 6] = v;
    __syncthreads();
    float r = red[0];
    for (int i = 1; i < (int)(blockDim.x >> 6); ++i) r = is_max ? fmaxf(r, red[i]) : r + red[i];
    __syncthreads();
    return r;
}

__global__ void __launch_bounds__(256) moba_naive(const float* __restrict__ mq, const float* __restrict__ mkT, const float* __restrict__ mv, const float* __restrict__ kmean,
                                                  const float* __restrict__ rel_bias, float* __restrict__ ya) {
    const int q = blockIdx.x, h = blockIdx.y, t = threadIdx.x;
    __shared__ float qs[128]; __shared__ float gate[32]; __shared__ int blk[4]; __shared__ int okf[4]; __shared__ float sc[1024]; __shared__ float red[8]; __shared__ float biasl[32];
    __shared__ float part[256];
    if (t < 128) qs[t] = mq[(size_t)q * 2048 + h * 128 + t];
    if (t < 32) biasl[t] = rel_bias[t * 24 + h];
    __syncthreads();
    const int qb = q >> 8;
    if (t < 32) { float g = -1e30f; if (t < qb) { g = 0.f; const float* km = kmean + (h * 32 + t) * 128; for (int d = 0; d < 128; ++d) g += qs[d] * km[d]; } gate[t] = g; }
    __syncthreads();
    if (t == 0) {
        unsigned used = 0;
        for (int r = 0; r < 3; ++r) { int best = -1; for (int j = 0; j < 32; ++j) if (!((used >> j) & 1u) && (best < 0 || gate[j] > gate[best])) best = j;
            used |= 1u << best; blk[r] = best; okf[r] = best < qb ? 1 : 0; }
        blk[3] = qb; okf[3] = 1;
    }
    __syncthreads();
    float lmax = -1e30f;
    for (int r = 0; r < 4; ++r) {
        const int kpos = blk[r] * 256 + t, dist = q - kpos; float s = -1e30f;
        if (okf[r] && dist >= 0) { float dot = 0.f; const float* kp = mkT + (size_t)(h * 128) * S + kpos; for (int d = 0; d < 128; ++d) dot += qs[d] * kp[(size_t)d * S];
            s = dot * SCALE + biasl[t5_bucket(dist)]; }
        sc[r * 256 + t] = s; lmax = fmaxf(lmax, s);
    }
    const float mx = block_reduce(lmax, red, true);
    float lsum = 0.f;
    for (int r = 0; r < 4; ++r) { const float e = expf(sc[r * 256 + t] - mx); sc[r * 256 + t] = e; lsum += e; }
    const float sum = block_reduce(lsum, red, false);
    const int d = t & 127, half = t >> 7; float a = 0.f;
    for (int i = half * 512; i < half * 512 + 512; ++i) { const float p = sc[i]; if (p != 0.f) { const int kpos = blk[i >> 8] * 256 + (i & 255); a += p * mv[(size_t)kpos * 2048 + h * 128 + d]; } }
    part[t] = a; __syncthreads();
    if (t < 128) ya[(size_t)q * 2048 + h * 128 + t] = (part[t] + part[t + 128]) / sum;
}

__global__ void __launch_bounds__(256) diff_naive(const float* __restrict__ dq, const float* __restrict__ dkT, const float* __restrict__ dv, const float* __restrict__ rel_bias,
                                                  const float* __restrict__ lq1, const float* __restrict__ lk1, const float* __restrict__ lq2, const float* __restrict__ lk2,
                                                  const float* __restrict__ subln_g, float* __restrict__ yb) {
    __shared__ float sc[S];
    __shared__ float qs[256]; __shared__ float red[8]; __shared__ float biasl[32]; __shared__ float lamsh;
    const int q = blockIdx.x, h = blockIdx.y, t = threadIdx.x;
    qs[t] = dq[(size_t)q * 2048 + h * 256 + t];
    if (t < 32) biasl[t] = rel_bias[t * 24 + 16 + h];
    if (t == 0) { float a = 0.f, b = 0.f; for (int d = 0; d < 128; ++d) { a += lq1[d] * lk1[d]; b += lq2[d] * lk2[d]; } lamsh = expf(a) - expf(b) + LAMBDA_INIT; }
    __syncthreads();
    const float lam = lamsh; const int nk = q + 1;
    float acc = 0.f;
    for (int mp = 0; mp < 2; ++mp) {
        float lmax = -1e30f;
        for (int kpos = t; kpos < nk; kpos += 256) { float dot = 0.f; const float* kp = dkT + (size_t)(h * 256 + mp * 128) * S + kpos;
            for (int d = 0; d < 128; ++d) dot += qs[mp * 128 + d] * kp[(size_t)d * S];
            const float s = dot * SCALE + biasl[t5_bucket(q - kpos)]; sc[kpos] = s; lmax = fmaxf(lmax, s); }
        const float mx = block_reduce(lmax, red, true);
        float lsum = 0.f;
        for (int kpos = t; kpos < nk; kpos += 256) { const float e = expf(sc[kpos] - mx); sc[kpos] = e; lsum += e; }
        const float inv = 1.0f / block_reduce(lsum, red, false);
        float a = 0.f;
        for (int i = 0; i < nk; ++i) a += sc[i] * dv[(size_t)i * 2048 + h * 256 + t];
        acc += (mp == 0 ? inv : -lam * inv) * a;
        __syncthreads();
    }
    const float ss = block_reduce(acc * acc, red, false);
    yb[(size_t)q * 2048 + h * 256 + t] = acc * rsqrtf(ss * (1.0f / 256.0f) + LN_EPS) * subln_g[t] * (1.0f - LAMBDA_INIT);
}

__global__ void merge_kernel(const float* __restrict__ ga, const float* __restrict__ gb, const float* __restrict__ gate_b, const float* __restrict__ ta, const float* __restrict__ tb, float* __restrict__ merged) {
    const size_t i = (size_t)blockIdx.x * blockDim.x + threadIdx.x; const int c = (int)(i & (DM - 1));
    const float a = 1.0f / (1.0f + expf(-(ga[i] + gate_b[c]))), b = 1.0f / (1.0f + expf(-(gb[i] + gate_b[DM + c])));
    merged[i] = a * ta[i] + b * tb[i];
}

__global__ void __launch_bounds__(256) ln_kernel(const float* __restrict__ in, const float* __restrict__ g, const float* __restrict__ b, float* __restrict__ out) {
    __shared__ float red[8];
    const int row = blockIdx.x, t = threadIdx.x; float v[16]; float s = 0.f;
    for (int i = 0; i < 16; ++i) { v[i] = in[(size_t)row * DM + i * 256 + t]; s += v[i]; }
    const float mu = block_reduce(s, red, false) * (1.0f / DM); float q = 0.f;
    for (int i = 0; i < 16; ++i) { v[i] -= mu; q += v[i] * v[i]; }
    const float rstd = rsqrtf(block_reduce(q, red, false) * (1.0f / DM) + LN_EPS);
    for (int i = 0; i < 16; ++i) out[(size_t)row * DM + i * 256 + t] = v[i] * rstd * g[i * 256 + t] + b[i * 256 + t];
}

__global__ void __launch_bounds__(256) peer_route_naive(const float* __restrict__ pq, const float* __restrict__ keys1, const float* __restrict__ keys2, int* __restrict__ eidx, float* __restrict__ gates) {
    __shared__ float qh[256]; __shared__ float sc[2][128]; __shared__ float tv[2][16]; __shared__ int ti[2][16];
    const int tok = blockIdx.x, t = threadIdx.x;
    for (int h = 0; h < 8; ++h) {
        qh[t] = pq[(size_t)tok * 2048 + h * 256 + t];
        __syncthreads();
        { const int side = t >> 7, k = t & 127; const float* kr = (side ? keys2 : keys1) + k * 128; float d = 0.f; for (int i = 0; i < 128; ++i) d += qh[side * 128 + i] * kr[i]; sc[side][k] = d; }
        __syncthreads();
        if (t == 0 || t == 128) { const int side = t >> 7; unsigned used[4] = {0, 0, 0, 0};
            for (int r = 0; r < 16; ++r) { int best = -1; for (int j = 0; j < 128; ++j) if (!((used[j >> 5] >> (j & 31)) & 1u) && (best < 0 || sc[side][j] > sc[side][best])) best = j;
                used[best >> 5] |= 1u << (best & 31); tv[side][r] = sc[side][best]; ti[side][r] = best; } }
        __syncthreads();
        if (t == 0) { unsigned used[8] = {0, 0, 0, 0, 0, 0, 0, 0}; float ts[16]; int tp[16];
            for (int r = 0; r < 16; ++r) { int best = -1; float bv = 0.f; for (int j = 0; j < 256; ++j) { if ((used[j >> 5] >> (j & 31)) & 1u) continue; const float c = tv[0][j >> 4] + tv[1][j & 15]; if (best < 0 || c > bv) { best = j; bv = c; } }
                used[best >> 5] |= 1u << (best & 31); ts[r] = bv; tp[r] = best; }
            float sum = 0.f; const float tmax = ts[0]; for (int r = 0; r < 16; ++r) { ts[r] = expf(ts[r] - tmax); sum += ts[r]; }
            for (int r = 0; r < 16; ++r) { eidx[(size_t)tok * 128 + h * 16 + r] = ti[0][tp[r] >> 4] * 128 + ti[1][tp[r] & 15]; gates[(size_t)tok * 128 + h * 16 + r] = ts[r] / sum; } }
        __syncthreads();
    }
}

__global__ void __launch_bounds__(256) peer_expert_naive(const float* __restrict__ x1, const int* __restrict__ eidx, const float* __restrict__ gates, const float* __restrict__ U, const float* __restrict__ V,
                                                         const float* __restrict__ g2, const float* __restrict__ b2, float* __restrict__ out) {
    __shared__ float xs[DM]; __shared__ float wts[128]; __shared__ int es[128]; __shared__ float red[8];
    const int tok = blockIdx.x, t = threadIdx.x, lane = t & 63, wid = t >> 6;
    for (int i = t; i < DM; i += 256) xs[i] = x1[(size_t)tok * DM + i];
    if (t < 128) es[t] = eidx[(size_t)tok * 128 + t];
    __syncthreads();
    for (int e = wid; e < 128; e += 4) { const float* u = U + (size_t)es[e] * DM; float d = 0.f;
        for (int j = 0; j < 16; ++j) { const float4 w = *(const float4*)(u + j * 256 + lane * 4); const float* xp = xs + j * 256 + lane * 4; d += w.x * xp[0] + w.y * xp[1] + w.z * xp[2] + w.w * xp[3]; }
        for (int o = 32; o >= 1; o >>= 1) d += __shfl_xor(d, o);
        if (lane == 0) wts[e] = gates[(size_t)tok * 128 + e] * 0.5f * d * (1.0f + erff(d * 0.7071067811865476f)); }
    __syncthreads();
    float acc[16];
    for (int i = 0; i < 16; ++i) acc[i] = 0.f;
    for (int e = 0; e < 128; ++e) { const float w = wts[e]; const float* v = V + (size_t)es[e] * DM; for (int i = 0; i < 16; ++i) acc[i] += w * v[i * 256 + t]; }
    float s = 0.f;
    for (int i = 0; i < 16; ++i) { acc[i] += ALPHA * xs[i * 256 + t]; s += acc[i]; }
    const float mu = block_reduce(s, red, false) * (1.0f / DM); float qq = 0.f;
    for (int i = 0; i < 16; ++i) { acc[i] -= mu; qq += acc[i] * acc[i]; }
    const float rstd = rsqrtf(block_reduce(qq, red, false) * (1.0f / DM) + LN_EPS);
    for (int i = 0; i < 16; ++i) out[(size_t)tok * DM + i * 256 + t] = acc[i] * rstd * g2[i * 256 + t] + b2[i * 256 + t];
}

void gemm(hipStream_t st, const float* A, int lda, const float* B, int ldb, float* C, int ldc, int M, int N, int K, const float* R = nullptr, int ldr = 0, float alpha = 0.f) {
    hipLaunchKernelGGL(gemm_f32, dim3(N / 128, M / 128), dim3(256), 0, st, A, lda, B, ldb, C, ldc, K, R, ldr, alpha);
}
#define GAS __attribute__((address_space(1)))
#define LAS __attribute__((address_space(3)))
typedef unsigned short bf16;
typedef unsigned v4u __attribute__((ext_vector_type(4)));
typedef unsigned v2u __attribute__((ext_vector_type(2)));
typedef float f32x4 __attribute__((ext_vector_type(4)));
typedef short bf16x8 __attribute__((ext_vector_type(8)));
typedef GAS unsigned gu32;
#define RLX_AGENT __ATOMIC_RELAXED, __HIP_MEMORY_SCOPE_AGENT
#define LDS_WAIT() asm volatile("s_waitcnt lgkmcnt(0)" ::: "memory")
#define VM_WAIT() asm volatile("s_waitcnt vmcnt(0)" ::: "memory")
__device__ __forceinline__ int lane_id() { int r; asm volatile("v_mbcnt_lo_u32_b32 %0, -1, 0\n\tv_mbcnt_hi_u32_b32 %0, -1, %0" : "=v"(r)); return r; }
__device__ __forceinline__ unsigned f2bf(float f) { unsigned u = __builtin_bit_cast(unsigned, f); return (u + 0x7fffu + ((u >> 16) & 1u)) >> 16; }
__device__ __forceinline__ unsigned pk2(float lo, float hi) { return f2bf(lo) | (f2bf(hi) << 16); }
__device__ __forceinline__ float bf2f(unsigned short b) { return __builtin_bit_cast(float, (unsigned)b << 16); }
__device__ __forceinline__ float bflo(unsigned w) { return __builtin_bit_cast(float, w << 16); }
__device__ __forceinline__ float bfhi(unsigned w) { return __builtin_bit_cast(float, w & 0xffff0000u); }
__device__ __forceinline__ float clamp8(float x) { return __builtin_amdgcn_fmed3f(x, -448.f, 448.f); }
__device__ __forceinline__ unsigned pk4_fp8(float a, float b, float c, float d) { int w = 0; w = __builtin_amdgcn_cvt_pk_fp8_f32(clamp8(a), clamp8(b), w, false); w = __builtin_amdgcn_cvt_pk_fp8_f32(clamp8(c), clamp8(d), w, true); return (unsigned)w; }

namespace pg8 {
#define PG8_LAS __attribute__((address_space(3)))
typedef unsigned short bf16_t;
typedef short bf16x8 __attribute__((ext_vector_type(8)));
typedef float f32x4 __attribute__((ext_vector_type(4)));
typedef unsigned u32x4 __attribute__((ext_vector_type(4)));
constexpr int BM = 256, BK = 64, HALF = 128, HTB = HALF * BK * 2  , STAGE_BYTES = 8 * HTB, NXCD = 8, WGM = 8;

__host__ __device__ __forceinline__ int lds_byte(int r, int c) { const int st = (r >> 4) * 2 + (c >> 5), rr = r & 15, cc = c & 31, ob = rr * 64 + cc * 2; return st * 1024 + (ob ^ (((ob >> 9) & 1) << 5)); }
__host__ __device__ __forceinline__ void stage_rc(int b, int& R, int& C) { const int st = b / 1024, sb = b % 1024, swz = sb ^ (((sb >> 9) & 1) << 5); R = (st >> 1) * 16 + swz / 64; C = (st & 1) * 32 + (swz % 64) / 2; }
__host__ __device__ __forceinline__ int perm32(int rho) { const int n = rho >> 4, i = rho & 15; return 8 * (i >> 2) + 4 * n + (i & 3); }

struct Unit { int pm, pn, part; };
struct Gemm { const bf16_t* A; const bf16_t* Bt; const bf16_t* A2; const bf16_t* Bt2; int M, N, K; int sc; int sc2; };

struct StaticOrder {
    int nM, nN, nwg, G, c;
    __host__ __device__ void init(int M, int N, int G_, int c_) { nM = M / BM; nN = N / BM; nwg = nM * nN; G = G_; c = c_; }
    __host__ __device__ bool next(int i, Unit& u) const {
        const long L = (long)i * G + c; if (L >= nwg) return false;
        int wgid = (int)L; { const int q = nwg / NXCD, r = nwg % NXCD, xcd = wgid % NXCD, off = wgid / NXCD; wgid = (xcd < r ? xcd * (q + 1) : r * (q + 1) + (xcd - r) * q) + off; }
        const int nig = WGM * nN, gid = wgid / nig, fm = gid * WGM, gsz = (nM - fm) < WGM ? (nM - fm) : WGM;
        u.pm = fm + ((wgid % nig) % gsz); u.pn = (wgid % nig) / gsz; u.part = 0; return true;
    }
    __device__ __forceinline__ void a_ready(const Unit&) const {}
    __device__ __forceinline__ void done(const Unit&) const {}
};


typedef int v4i_t __attribute__((ext_vector_type(4))); typedef int v8i_t __attribute__((ext_vector_type(8)));
__device__ __forceinline__ v8i_t cat8(bf16x8 a, bf16x8 b) { return __builtin_shufflevector(__builtin_bit_cast(v4i_t, a), __builtin_bit_cast(v4i_t, b), 0, 1, 2, 3, 4, 5, 6, 7); }
template <class Epi, class Sched, bool ALIGN_EPI = false, bool SP2 = false, bool F8 = false>
__device__ __forceinline__ void gemm_phase(PG8_LAS unsigned char* lds, const Gemm g, const Sched& S, const Epi& E, const int wave_id) {
    int lane_; asm volatile("v_mbcnt_lo_u32_b32 %0, -1, 0\n\tv_mbcnt_hi_u32_b32 %0, -1, %0" : "=v"(lane_));
    const int lane = lane_, wid = wave_id, tid = wid * 64 + lane, wr = wid >> 2, wc = wid & 3, fr = lane & 15, fq = lane >> 4;
    const int K = g.K, nt = K / BK;
    unsigned voffA[2], voffB[2];
#pragma unroll
    for (int i = 0; i < 2; ++i) { int R, C; stage_rc(tid * 16 + i * 8192, R, C); const int Rb = Epi::PERM ? ((R & ~31) + perm32(R & 31)) : R;
        voffA[i] = (unsigned)(R * K + C) * 2u; voffB[i] = (unsigned)(Rb * K + C) * 2u; }
    const size_t kstep = (size_t)(BK * 2);
    const size_t rstep64 = (size_t)64 * K * 2;
    const size_t hstep = (size_t)HALF * K * 2;
    const size_t tstep = 2 * hstep;
    const unsigned ldsw = (unsigned)wid * 1024u;
    const int aoff = lds_byte(wr * 64 + fr, fq * 8), boff = lds_byte(wc * 32 + fr, fq * 8);
#define PG8_SA(b, h) (((b) * 2 + (h)) * HTB)
#define PG8_SB(b, h) ((4 + (b) * 2 + (h)) * HTB)
#define PG8_STAGE(bufoff, gbase, voff) do { _Pragma("unroll") for (int _i = 0; _i < 2; ++_i) \
        __builtin_amdgcn_global_load_lds((const unsigned*)((const char*)(gbase) + (size_t)_i * rstep64 + (voff)[0]), (PG8_LAS unsigned*)(lds + (bufoff) + ldsw + _i * 8192), 16, 0, 0); } while (0)
#define PG8_LDA(dst, b, h) do { _Pragma("unroll") for (int m = 0; m < 4; ++m) _Pragma("unroll") for (int k = 0; k < 2; ++k) dst[m][k] = *(const PG8_LAS bf16x8*)(lds + PG8_SA(b, h) + aoff + m * 2048 + k * 1024); } while (0)
#define PG8_LDB(dst, b, h) do { _Pragma("unroll") for (int n = 0; n < 2; ++n) _Pragma("unroll") for (int k = 0; k < 2; ++k) dst[n][k] = *(const PG8_LAS bf16x8*)(lds + PG8_SB(b, h) + boff + n * 2048 + k * 1024); } while (0)
#define PG8_MMA(ai, bj, At, Bt) do { __builtin_amdgcn_s_setprio(1); if constexpr (F8) { _Pragma("unroll") for (int m = 0; m < 4; ++m) _Pragma("unroll") for (int n = 0; n < 2; ++n) \
        acc[ai][bj][m][n] = __builtin_amdgcn_mfma_scale_f32_16x16x128_f8f6f4(cat8(Bt[n][0], Bt[n][1]), cat8(At[m][0], At[m][1]), acc[ai][bj][m][n], 0, 0, 0, (cur.part ? g.sc2 : g.sc), 0, 0x7f7f7f7f); } else { \
        _Pragma("unroll") for (int m = 0; m < 4; ++m) _Pragma("unroll") for (int n = 0; n < 2; ++n) _Pragma("unroll") for (int k = 0; k < 2; ++k) \
        acc[ai][bj][m][n] = __builtin_amdgcn_mfma_f32_16x16x32_bf16(Bt[n][k], At[m][k], acc[ai][bj][m][n], 0, 0, 0); } __builtin_amdgcn_s_setprio(0); } while (0)
#define PG8_WAIT_V(n) asm volatile("s_waitcnt vmcnt(" #n ")" ::: "memory")
#define PG8_WAIT_L(n) asm volatile("s_waitcnt lgkmcnt(" #n ")" ::: "memory")
#define PG8_BAR __builtin_amdgcn_s_barrier()
#define PG8_SCHED __builtin_amdgcn_sched_barrier(0)
    Unit cur, nxt; int ui = 0;
    if (!S.next(0, cur)) return;
    f32x4 acc[2][2][4][2];
#pragma unroll
    for (int a = 0; a < 2; ++a)
#pragma unroll
        for (int b = 0; b < 2; ++b)
#pragma unroll
            for (int m = 0; m < 4; ++m)
#pragma unroll
                for (int n = 0; n < 2; ++n) acc[a][b][m][n] = (f32x4){0.f, 0.f, 0.f, 0.f};
    bf16x8 At[4][2], B0[2][2], B1[2][2];
    const char* cA = (const char*)(cur.part ? g.A2 : g.A) + (size_t)cur.pm * tstep; const char* cB = (const char*)(cur.part ? g.Bt2 : g.Bt) + (size_t)cur.pn * tstep;
    S.a_ready(cur);
    if constexpr (SP2) {
        PG8_STAGE(PG8_SB(0, 0), cB, voffB); PG8_STAGE(PG8_SB(0, 1), cB + hstep, voffB); PG8_STAGE(PG8_SA(0, 0), cA, voffA); PG8_STAGE(PG8_SA(0, 1), cA + hstep, voffA);
        if (wr == 1) PG8_BAR;
        PG8_WAIT_V(2); PG8_BAR;
        PG8_STAGE(PG8_SB(1, 0), cB + kstep, voffB); PG8_STAGE(PG8_SA(1, 0), cA + kstep, voffA); PG8_STAGE(PG8_SB(1, 1), cB + hstep + kstep, voffB);
        PG8_WAIT_V(6); PG8_BAR;
    } else {
        PG8_STAGE(PG8_SB(0, 0), cB, voffB); PG8_STAGE(PG8_SA(0, 0), cA, voffA); PG8_STAGE(PG8_SB(0, 1), cB + hstep, voffB); PG8_STAGE(PG8_SA(0, 1), cA + hstep, voffA);
        if (wr == 1) PG8_BAR;
        PG8_WAIT_V(4); PG8_BAR;
        PG8_STAGE(PG8_SB(1, 0), cB + kstep, voffB); PG8_STAGE(PG8_SA(1, 0), cA + kstep, voffA); PG8_STAGE(PG8_SB(1, 1), cB + hstep + kstep, voffB);
        PG8_WAIT_V(6); PG8_BAR;
    }
    for (;;) {
        const bool has_next = S.next(ui + 1, nxt);
        const char* nA = has_next ? (const char*)(nxt.part ? g.A2 : g.A) + (size_t)nxt.pm * tstep : cA; const char* nB = has_next ? (const char*)(nxt.part ? g.Bt2 : g.Bt) + (size_t)nxt.pn * tstep : cB;
        for (int t = 0; t < nt; t += 2) {
            const bool last = (t == nt - 2);
            const char* a1 = cA + (size_t)(t + 1) * kstep;
            const char* a2 = last ? nA : cA + (size_t)(t + 2) * kstep; const char* b2 = last ? nB : cB + (size_t)(t + 2) * kstep;
            const char* a3 = a2 + kstep; const char* b3 = b2 + kstep;
            if (last && has_next) S.a_ready(nxt);
            if constexpr (SP2) {
            PG8_LDB(B0, 0, 0); PG8_LDB(B1, 0, 1); PG8_SCHED; PG8_LDA(At, 0, 0); PG8_STAGE(PG8_SA(1, 1), a1 + hstep, voffA);
            PG8_WAIT_V(8); PG8_WAIT_L(0); PG8_BAR; PG8_MMA(0, 0, At, B0); PG8_MMA(0, 1, At, B1); PG8_BAR; PG8_SCHED;
            PG8_LDA(At, 0, 1); PG8_STAGE(PG8_SB(0, 0), b2, voffB); PG8_STAGE(PG8_SB(0, 1), b2 + hstep, voffB); PG8_STAGE(PG8_SA(0, 0), a2, voffA);
            PG8_WAIT_V(8); PG8_WAIT_L(0); PG8_BAR; PG8_MMA(1, 0, At, B0); PG8_MMA(1, 1, At, B1); PG8_BAR; PG8_SCHED;
            PG8_LDB(B0, 1, 0); PG8_LDB(B1, 1, 1); PG8_SCHED; PG8_LDA(At, 1, 0); PG8_STAGE(PG8_SA(0, 1), a2 + hstep, voffA);
            PG8_WAIT_V(8); PG8_WAIT_L(0); PG8_BAR; PG8_MMA(0, 0, At, B0); PG8_MMA(0, 1, At, B1); PG8_BAR; PG8_SCHED;
            PG8_LDA(At, 1, 1); PG8_STAGE(PG8_SB(1, 0), b3, voffB); PG8_STAGE(PG8_SB(1, 1), b3 + hstep, voffB); PG8_STAGE(PG8_SA(1, 0), a3, voffA);
            PG8_WAIT_V(8); PG8_WAIT_L(0); PG8_BAR; PG8_MMA(1, 0, At, B0); PG8_MMA(1, 1, At, B1); PG8_BAR; PG8_SCHED;
            } else {
            PG8_LDB(B0, 0, 0); PG8_SCHED; PG8_LDA(At, 0, 0); PG8_STAGE(PG8_SA(1, 1), a1 + hstep, voffA);
            PG8_WAIT_L(8); PG8_BAR; PG8_WAIT_L(0); PG8_MMA(0, 0, At, B0); PG8_BAR; PG8_SCHED;
            PG8_LDB(B1, 0, 1); PG8_STAGE(PG8_SB(0, 0), b2, voffB);
            PG8_BAR; PG8_WAIT_L(0); PG8_MMA(0, 1, At, B1); PG8_BAR;
            PG8_LDA(At, 0, 1); PG8_STAGE(PG8_SA(0, 0), a2, voffA);
            PG8_BAR; PG8_WAIT_L(0); PG8_MMA(1, 0, At, B0); PG8_BAR; PG8_SCHED;
            PG8_STAGE(PG8_SB(0, 1), b2 + hstep, voffB);
            PG8_WAIT_V(6); PG8_BAR; PG8_MMA(1, 1, At, B1); PG8_BAR;
            PG8_LDB(B0, 1, 0); PG8_SCHED; PG8_LDA(At, 1, 0); PG8_STAGE(PG8_SA(0, 1), a2 + hstep, voffA);
            PG8_WAIT_L(8); PG8_BAR; PG8_WAIT_L(0); PG8_MMA(0, 0, At, B0); PG8_BAR; PG8_SCHED;
            PG8_LDB(B1, 1, 1); PG8_STAGE(PG8_SB(1, 0), b3, voffB);
            PG8_BAR; PG8_WAIT_L(0); PG8_MMA(0, 1, At, B1); PG8_BAR;
            PG8_LDA(At, 1, 1); PG8_STAGE(PG8_SA(1, 0), a3, voffA);
            PG8_BAR; PG8_WAIT_L(0); PG8_MMA(1, 0, At, B0); PG8_BAR; PG8_SCHED;
            PG8_STAGE(PG8_SB(1, 1), b3 + hstep, voffB);
            PG8_WAIT_V(6); PG8_BAR; PG8_MMA(1, 1, At, B1); PG8_BAR;
            }
        }
        if constexpr (ALIGN_EPI) { if (wr == 0) PG8_BAR; }
        if constexpr (!Epi::AFTER_DRAIN) { int l_; asm volatile("v_mbcnt_lo_u32_b32 %0, -1, 0\n\tv_mbcnt_hi_u32_b32 %0, -1, %0" : "=v"(l_));
            E(acc, cur, wr, wc, l_ & 15, l_ >> 4); S.done(cur); }
        if (!has_next) break;
#pragma unroll
        for (int a = 0; a < 2; ++a)
#pragma unroll
            for (int b = 0; b < 2; ++b)
#pragma unroll
                for (int m = 0; m < 4; ++m)
#pragma unroll
                    for (int n = 0; n < 2; ++n) acc[a][b][m][n] = (f32x4){0.f, 0.f, 0.f, 0.f};
        cur = nxt; cA = nA; cB = nB; ++ui;
        if constexpr (ALIGN_EPI) { if (wr == 1) PG8_BAR; }
    }
    PG8_WAIT_V(0);
    if constexpr (!ALIGN_EPI) { if (wr == 0) PG8_BAR; }
    PG8_BAR;
    if constexpr (Epi::AFTER_DRAIN) { E.fused(acc, cur, wr, wc, fr, fq, lds, wid, lane); S.done(cur); }
#undef PG8_SA
#undef PG8_SB
#undef PG8_STAGE
#undef PG8_LDA
#undef PG8_LDB
#undef PG8_MMA
#undef PG8_WAIT_V
#undef PG8_WAIT_L
#undef PG8_BAR
#undef PG8_SCHED
}
}

#define XB_TMO      128
#define XB_XCNT(j)  (256  + 64 * (j))
#define XB_XSUB(j)  (1280 + 64 * (j))
#define XB_XGEN(j)  (2304 + 64 * (j))
#define XB_TOP      3328
#define XB_TOPGEN   3392
#define XCD_BAR_WORDS 3456
#define XB_SPIN_CAP (1u << 18)

__device__ __forceinline__ unsigned xb_ld(unsigned* p)              { return __hip_atomic_load(p, __ATOMIC_RELAXED, __HIP_MEMORY_SCOPE_AGENT); }
__device__ __forceinline__ unsigned xb_add(unsigned* p, unsigned v) { return __hip_atomic_fetch_add(p, v, __ATOMIC_RELAXED, __HIP_MEMORY_SCOPE_AGENT); }
__device__ __forceinline__ unsigned xb_xcc_id() { return (unsigned)__builtin_amdgcn_s_getreg((3 << 11) | 20) & 0xFu; }
#define XB_SPIN(cond, bar) do { unsigned _sp = 0; while (cond) { __builtin_amdgcn_s_sleep(1); \
    if ((++_sp & 255u) == 0u) { if (xb_ld(&(bar)[XB_TMO])) break; if (_sp > XB_SPIN_CAP) { atomicAdd(&(bar)[XB_TMO], 1u); break; } } } } while (0)

struct XcdBarrier {
    unsigned* bar; unsigned x;
    volatile LAS unsigned* st;
};

__device__ __forceinline__ XcdBarrier xcd_barrier_post(unsigned* bar, volatile LAS unsigned* st) {
    XcdBarrier b; b.bar = bar; b.x = xb_xcc_id(); b.st = st;
    if (threadIdx.x == 0) (void)xb_add(&bar[XB_XCNT(b.x)], 1u);
    return b;
}
__device__ __forceinline__ void xcd_barrier_complete(unsigned* bar, unsigned x, unsigned& nloc, unsigned& nx) {
    const unsigned G = gridDim.x * gridDim.y * gridDim.z;
    unsigned sum, cnt, mine, sp = 0u;
    for (;;) {
        sum = 0u; cnt = 0u; mine = 0u;
#pragma unroll
        for (unsigned j = 0; j < 16; ++j) { const unsigned c = xb_ld(&bar[XB_XCNT(j)]); sum += c; cnt += (c > 0u) ? 1u : 0u; mine = (j == x) ? c : mine; }
        if (sum == G) break;
        __builtin_amdgcn_s_sleep(1);
        if ((++sp & 255u) == 0u) { if (xb_ld(&bar[XB_TMO])) break; if (sp > XB_SPIN_CAP) { atomicAdd(&bar[XB_TMO], 1u); break; } }
    }
    nloc = mine > 0u ? mine : 1u; nx = cnt > 0u ? cnt : 1u;
}

__device__ __forceinline__ void xcd_barrier(const XcdBarrier& b) {
    asm volatile("s_waitcnt vmcnt(0)" ::: "memory");
    __syncthreads();
    if (threadIdx.x == 0) {
        unsigned* bar = b.bar;
        __builtin_amdgcn_s_waitcnt(0);
        unsigned nloc = b.st[0], nx = b.st[1];
        if (nloc == 0u) { xcd_barrier_complete(bar, b.x, nloc, nx); b.st[0] = nloc; b.st[1] = nx; }
        const unsigned old = xb_add(&bar[XB_XSUB(b.x)], 1u);
        const unsigned gen = old / nloc;
        if (old + 1u == (gen + 1u) * nloc) {
            __builtin_amdgcn_fence(__ATOMIC_RELEASE, "agent");
            asm volatile("s_waitcnt vmcnt(0)" ::: "memory");
            const unsigned og = xb_add(&bar[XB_TOP], 1u);
            const unsigned tg = og / nx;
            if (og + 1u == (tg + 1u) * nx) xb_add(&bar[XB_TOPGEN], 1u);
            else XB_SPIN(xb_ld(&bar[XB_TOPGEN]) == tg, bar);
            __builtin_amdgcn_fence(__ATOMIC_ACQUIRE, "agent");
            xb_add(&bar[XB_XGEN(b.x)], 1u);
            asm volatile("s_waitcnt vmcnt(0)" ::: "memory");
        } else {
            XB_SPIN(xb_ld(&bar[XB_XGEN(b.x)]) == gen, bar);
            __builtin_amdgcn_fence(__ATOMIC_ACQUIRE, "agent");
            asm volatile("s_waitcnt vmcnt(0)" ::: "memory");
        }
    }
    __syncthreads();
}

constexpr int NWAVES = 8;
#ifndef P5_SP2
#define P5_SP2 true
#endif
#ifndef P6_SP2
#define P6_SP2 true
#endif
constexpr size_t MiB = 1u << 20;
constexpr int RING_BYTES = 131072, LDSCTL_OFF = RING_BYTES, MISC_OFF = LDSCTL_OFF + 320, LDS_BYTES = 147456;
constexpr int CW_BAR = 4096;
constexpr size_t CTL_ZERO_BYTES = 1 * MiB;

namespace pg8 {
__device__ __forceinline__ unsigned cvt_pk_bf16(float lo, float hi) { unsigned r; asm volatile("v_cvt_pk_bf16_f32 %0, %1, %2" : "=v"(r) : "v"(lo), "v"(hi)); return r; }
typedef float f32x2 __attribute__((ext_vector_type(2)));
struct EpiStoreBf16 {
    static constexpr bool PERM = true, AFTER_DRAIN = false;
    bf16_t* O; int ldc;
    __device__ __forceinline__ void operator()(const f32x4 (&acc)[2][2][4][2], const Unit& u, int wr, int wc, int fr, int fq) const {
        const int row0 = u.pm * BM + wr * 64 + fr, col0 = u.pn * BM + wc * 32 + 8 * fq;
#pragma unroll
        for (int ai = 0; ai < 2; ++ai)
#pragma unroll
            for (int m = 0; m < 4; ++m) { bf16_t* rowp = O + (size_t)(row0 + ai * HALF + m * 16) * ldc + col0;
#pragma unroll
                for (int bj = 0; bj < 2; ++bj) { const f32x4 v0 = acc[ai][bj][m][0], v1 = acc[ai][bj][m][1];
                    u32x4 w; w.x = cvt_pk_bf16(v0[0], v0[1]); w.y = cvt_pk_bf16(v0[2], v0[3]); w.z = cvt_pk_bf16(v1[0], v1[1]); w.w = cvt_pk_bf16(v1[2], v1[3]);
                    *(u32x4*)(rowp + bj * HALF) = w; } }
    }
};

struct EpiMerge {
    static constexpr bool PERM = true, AFTER_DRAIN = false;
    unsigned char* Mg; const bf16_t* proj; const float* gate_b;
    __device__ __forceinline__ void operator()(const f32x4 (&acc)[2][2][4][2], const Unit& u, int wr, int wc, int fr, int fq) const {
        const int row0 = u.pm * BM + wr * 64 + fr, col0 = u.pn * BM + wc * 32 + 8 * fq; const int part = u.part;
        const bf16_t* gsrc = proj + (part ? 16384 : 12288); const float* gbp = gate_b + (part ? 4096 : 0);
#pragma unroll
        for (int bj = 0; bj < 2; ++bj) { const int col = col0 + bj * HALF;
            f32x4 gbv[2]; gbv[0] = *(const f32x4*)(gbp + col); gbv[1] = *(const f32x4*)(gbp + col + 4);
            asm volatile("" : "+v"(gbv[0]), "+v"(gbv[1]));
#pragma unroll
        for (int ai = 0; ai < 2; ++ai)
#pragma unroll
            for (int m = 0; m < 4; ++m) { const int row = row0 + ai * HALF + m * 16;
                {
                    const u32x4 gw = *(const u32x4*)(gsrc + (size_t)row * 20480 + col);
                    float z[8]; z[0] = __uint_as_float(gw.x << 16); z[1] = __uint_as_float(gw.x & 0xffff0000u); z[2] = __uint_as_float(gw.y << 16); z[3] = __uint_as_float(gw.y & 0xffff0000u);
                    z[4] = __uint_as_float(gw.z << 16); z[5] = __uint_as_float(gw.z & 0xffff0000u); z[6] = __uint_as_float(gw.w << 16); z[7] = __uint_as_float(gw.w & 0xffff0000u);
                    float v[8];
#pragma unroll
                    for (int k = 0; k < 8; ++k) { const float zz = z[k] + gbv[k >> 2][k & 3]; const float sg = __builtin_amdgcn_rcpf(1.0f + __builtin_amdgcn_exp2f(-1.4426950408889634f * zz)); v[k] = sg * acc[ai][bj][m][k >> 2][k & 3]; }
                    typedef unsigned u32x2v __attribute__((ext_vector_type(2)));
                    unsigned char* dst = Mg + (size_t)row * 4096 + col;
                    if (part) { const u32x2v pw = *(const u32x2v*)dst;
                        v[0] += 0.0625f * __builtin_amdgcn_cvt_f32_fp8((int)pw.x, 0); v[1] += 0.0625f * __builtin_amdgcn_cvt_f32_fp8((int)pw.x, 1); v[2] += 0.0625f * __builtin_amdgcn_cvt_f32_fp8((int)pw.x, 2); v[3] += 0.0625f * __builtin_amdgcn_cvt_f32_fp8((int)pw.x, 3);
                        v[4] += 0.0625f * __builtin_amdgcn_cvt_f32_fp8((int)pw.y, 0); v[5] += 0.0625f * __builtin_amdgcn_cvt_f32_fp8((int)pw.y, 1); v[6] += 0.0625f * __builtin_amdgcn_cvt_f32_fp8((int)pw.y, 2); v[7] += 0.0625f * __builtin_amdgcn_cvt_f32_fp8((int)pw.y, 3); }
                    u32x2v w; int t0 = 0, t1 = 0;
#define C8(x) __builtin_amdgcn_fmed3f((x) * 16.0f, -448.f, 448.f)
                    t0 = __builtin_amdgcn_cvt_pk_fp8_f32(C8(v[0]), C8(v[1]), t0, false); t0 = __builtin_amdgcn_cvt_pk_fp8_f32(C8(v[2]), C8(v[3]), t0, true);
                    t1 = __builtin_amdgcn_cvt_pk_fp8_f32(C8(v[4]), C8(v[5]), t1, false); t1 = __builtin_amdgcn_cvt_pk_fp8_f32(C8(v[6]), C8(v[7]), t1, true);
#undef C8
                    w.x = (unsigned)t0; w.y = (unsigned)t1; *(u32x2v*)dst = w; } } }
    }
};
struct DualOrder : StaticOrder { __device__ bool next(int i, Unit& u) const { if (!StaticOrder::next(i >> 1, u)) return false; u.part = i & 1; return true; } };
struct EpiResF32 {
    static constexpr bool PERM = false, AFTER_DRAIN = false;
    float* C; const float* R; float alpha;
    __device__ __forceinline__ void operator()(const f32x4 (&acc)[2][2][4][2], const Unit& u, int wr, int wc, int fr, int fq) const {
        const int row0 = u.pm * BM + wr * 64 + fr, col0 = u.pn * BM + wc * 32 + 4 * fq;
#pragma unroll
        for (int ai = 0; ai < 2; ++ai)
#pragma unroll
            for (int m = 0; m < 4; ++m) { const size_t off = (size_t)(row0 + ai * HALF + m * 16) * 4096 + col0;
#pragma unroll
                for (int bj = 0; bj < 2; ++bj)
#pragma unroll
                    for (int n = 0; n < 2; ++n) { const f32x4 r = *(const f32x4*)(R + off + bj * HALF + n * 16); *(f32x4*)(C + off + bj * HALF + n * 16) = r * alpha + acc[ai][bj][m][n]; } }
    }
};
struct EpiPeerAct {
    static constexpr bool PERM = true, AFTER_DRAIN = false;
    unsigned char* Gd;
    __device__ __forceinline__ void operator()(const f32x4 (&acc)[2][2][4][2], const Unit& u, int wr, int wc, int fr, int fq) const {
        typedef unsigned u32x2v __attribute__((ext_vector_type(2)));
        const int row0 = u.pm * BM + wr * 64 + fr, col0 = u.pn * BM + wc * 32 + 8 * fq;
#pragma unroll
        for (int ai = 0; ai < 2; ++ai)
#pragma unroll
            for (int m = 0; m < 4; ++m) { unsigned char* rowp = Gd + (size_t)(row0 + ai * HALF + m * 16) * 16384 + col0;
#pragma unroll
                for (int bj = 0; bj < 2; ++bj) { const u32x2v gw = *(const u32x2v*)(rowp + bj * HALF);
                    if ((gw.x | gw.y) != 0u) {
                        float v[8];
#pragma unroll
                        for (int k = 0; k < 8; ++k) { const unsigned word = k < 4 ? gw.x : gw.y; const float gk = (k & 3) == 0 ? __builtin_amdgcn_cvt_f32_fp8((int)word, 0) : (k & 3) == 1 ? __builtin_amdgcn_cvt_f32_fp8((int)word, 1) : (k & 3) == 2 ? __builtin_amdgcn_cvt_f32_fp8((int)word, 2) : __builtin_amdgcn_cvt_f32_fp8((int)word, 3);
                            const float a = acc[ai][bj][m][k >> 2][k & 3]; v[k] = gk != 0.f ? __builtin_amdgcn_fmed3f(gk * 0.125f * a * (1.0f + erff(a * 0.7071067811865476f)), -448.f, 448.f) : 0.f; }
                        u32x2v w; int t0 = 0, t1 = 0; t0 = __builtin_amdgcn_cvt_pk_fp8_f32(v[0], v[1], t0, false); t0 = __builtin_amdgcn_cvt_pk_fp8_f32(v[2], v[3], t0, true);
                        t1 = __builtin_amdgcn_cvt_pk_fp8_f32(v[4], v[5], t1, false); t1 = __builtin_amdgcn_cvt_pk_fp8_f32(v[6], v[7], t1, true); w.x = (unsigned)t0; w.y = (unsigned)t1;
                        *(u32x2v*)(rowp + bj * HALF) = w; } } }
    }
};
}

__device__ __forceinline__ void p0_transpose_item(const float* W, int K, int N, bf16* WT, LAS float* scr, int item, int lane) {
    const int nblk = N / 32, kb = item / nblk, nb = item % nblk, k0 = 64 * kb, n0 = 32 * nb;
#pragma unroll 8
    for (int i = 0; i < 32; ++i) { const int kk = 2 * i + (lane >> 5); scr[kk * 33 + (lane & 31)] = W[(size_t)(k0 + kk) * N + n0 + (lane & 31)]; }
    LDS_WAIT(); asm volatile("" ::: "memory");
    const int c = lane & 7;
#pragma unroll
    for (int j = 0; j < 4; ++j) { const int n = (lane >> 3) + 8 * j; const LAS float* s = scr + (8 * c) * 33 + n;
        v4u o; o.x = pk2(s[0 * 33], s[1 * 33]); o.y = pk2(s[2 * 33], s[3 * 33]); o.z = pk2(s[4 * 33], s[5 * 33]); o.w = pk2(s[6 * 33], s[7 * 33]);
        *(GAS v4u*)(WT + (size_t)(n0 + n) * K + k0 + 8 * c) = o; }
    LDS_WAIT(); asm volatile("" ::: "memory");
}
__device__ __forceinline__ void p0_convert(const float* src, bf16* dst, size_t n8, size_t gtid, size_t gthreads) {
    for (size_t i = gtid; i < n8; i += gthreads) { const f32x4 a = *(const GAS f32x4*)(src + i * 8), b = *(const GAS f32x4*)(src + i * 8 + 4);
        v4u o; o.x = pk2(a.x, a.y); o.y = pk2(a.z, a.w); o.z = pk2(b.x, b.y); o.w = pk2(b.z, b.w); *(GAS v4u*)(dst + i * 8) = o; }
}

namespace att {
using s16x4  = __attribute__((ext_vector_type(4))) short;
using f32x16 = __attribute__((ext_vector_type(16))) float;
using u32x4  = __attribute__((ext_vector_type(4))) unsigned;
constexpr int NW = 8, QBLK = 32, KVBLK = 64, LDP = INW;
constexpr float LOG2E = 1.4426950408889634f, CQK = SCALE * LOG2E, THRL = 11.5f, NEGBIG = -1e30f;
constexpr int SHM_V = 16384, SHM_K = 16384;
constexpr int OFF_V = 0, OFF_K = 2 * SHM_V, OFF_WS = OFF_K + 2 * SHM_K, OFF_LUT = OFF_WS + NW * 64 * 4, OFF_GATE = OFF_LUT + 2176, GATE_W = 33 * 32 * 4, OFF_END = OFF_GATE + NW * GATE_W;
static_assert(OFF_END <= RING_BYTES, "attention LDS");
#define KSWZ(row, colB) ((row) * 256 + ((colB) ^ (((row) & 7) << 4)))
#define SBAR() __builtin_amdgcn_sched_barrier(0)
__device__ __forceinline__ int crow(int r, int hi) { return (r & 3) + 8 * (r >> 2) + 4 * hi; }
__device__ __forceinline__ unsigned cvtpk(float lo, float hi) { unsigned r; asm volatile("v_cvt_pk_bf16_f32 %0, %1, %2" : "=v"(r) : "v"(lo), "v"(hi)); return r; }

__device__ __forceinline__ void bias_far(f32x16& p0, f32x16& p1, float rowoff) {
#pragma unroll
  for (int r = 0; r < 16; ++r) { p0[r] = fmaf(p0[r], CQK, rowoff); p1[r] = fmaf(p1[r], CQK, rowoff); }
}
constexpr int LUT_DMAX = 207, LUT_N = 528;
__device__ __forceinline__ void bias_near(f32x16& p0, f32x16& p1, const LAS float* rl, int dist0  , int hi) {
  const LAS float* b = rl + (LUT_DMAX - dist0 + 4 * hi);
#pragma unroll
  for (int r = 0; r < 16; ++r) { const int c = (r & 3) + 8 * (r >> 2); p0[r] = fmaf(p0[r], CQK, b[c]); p1[r] = fmaf(p1[r], CQK, b[c + 32]); }
}
__device__ __forceinline__ void partialSM(f32x16& p0, f32x16& p1, float& m_reg, float& mn, float& alpha) {
  float pmax = p0[0];
#pragma unroll
  for (int r = 1; r < 16; ++r) pmax = fmaxf(pmax, p0[r]);
#pragma unroll
  for (int r = 0; r < 16; ++r) pmax = fmaxf(pmax, p1[r]);
  { auto rr = __builtin_amdgcn_permlane32_swap(__float_as_uint(pmax), __float_as_uint(pmax), false, false);
    pmax = fmaxf(__uint_as_float(rr[0]), __uint_as_float(rr[1])); }
  if (__builtin_expect(__all(pmax - m_reg <= THRL), 1)) { mn = m_reg; alpha = 1.f; }
  else { mn = fmaxf(m_reg, pmax); alpha = __builtin_amdgcn_exp2f(m_reg - mn); m_reg = mn; }
#pragma unroll
  for (int r = 0; r < 16; ++r) { p0[r] -= mn; p1[r] -= mn; }
#pragma unroll
  for (int r = 0; r < 16; ++r) p0[r] = __builtin_amdgcn_exp2f(p0[r]);
}
__device__ __forceinline__ void finishSM(f32x16& p0, f32x16& p1, float alpha, float& l_reg, bf16x8& pa0, bf16x8& pa1, bf16x8& pa2, bf16x8& pa3) {
#pragma unroll
  for (int r = 0; r < 16; ++r) p1[r] = __builtin_amdgcn_exp2f(p1[r]);
  float ps = 0;
#pragma unroll
  for (int r = 0; r < 16; ++r) ps += p0[r];
#pragma unroll
  for (int r = 0; r < 16; ++r) ps += p1[r];
  { auto rr = __builtin_amdgcn_permlane32_swap(__float_as_uint(ps), __float_as_uint(ps), false, false);
    ps = __uint_as_float(rr[0]) + __uint_as_float(rr[1]); }
  l_reg = l_reg * alpha + ps;
#define PK4(P, BASE, OUT) do { unsigned a0 = cvtpk(P[BASE + 0], P[BASE + 1]), a1 = cvtpk(P[BASE + 2], P[BASE + 3]);   \
    unsigned b0 = cvtpk(P[BASE + 4], P[BASE + 5]), b1 = cvtpk(P[BASE + 6], P[BASE + 7]);                              \
    auto r0 = __builtin_amdgcn_permlane32_swap(a0, b0, false, false); auto r1 = __builtin_amdgcn_permlane32_swap(a1, b1, false, false); \
    u32x4 w = {r0[0], r1[0], r0[1], r1[1]}; OUT = *reinterpret_cast<bf16x8*>(&w); } while (0)
  PK4(p0, 0, pa0); PK4(p0, 8, pa1); PK4(p1, 0, pa2); PK4(p1, 8, pa3);
#undef PK4
}
__device__ __forceinline__ void qkt(f32x16& p0, f32x16& p1, const LAS char* Ks, const bf16x8* qr, int r32, int hi) {
  p0 = f32x16{}; p1 = f32x16{};
#pragma unroll
  for (int d0 = 0; d0 < 8; ++d0) { const int cb = (d0 * 16 + hi * 8) * 2;
    const bf16x8 b0 = *reinterpret_cast<const LAS bf16x8*>(Ks + KSWZ(r32, cb));
    const bf16x8 b1 = *reinterpret_cast<const LAS bf16x8*>(Ks + KSWZ(32 + r32, cb));
    p0 = __builtin_amdgcn_mfma_f32_32x32x16_bf16(b0, qr[d0], p0, 0, 0, 0);
    p1 = __builtin_amdgcn_mfma_f32_32x32x16_bf16(b1, qr[d0], p1, 0, 0, 0); }
}
__device__ __forceinline__ int v_st(int k, int c) { const int kk = (k & ~0xC) | ((k & 4) << 1) | ((k & 8) >> 1); return ((kk >> 3) * 4 + (c >> 5)) * 512 + ((kk & 7) * 32 + (c & 31)) * 2; }
__device__ __forceinline__ int v_rd_base(int lane) { return ((lane & 3) << 3) | (((lane >> 2) & 3) << 6) | (((lane >> 4) & 1) << 5) | (((lane >> 5) & 1) << 8); }
constexpr int v_rd_off(int d0, int ks, int half) { return d0 * 512 + ks * 4096 + half * 2048; }
template <int OFF> __device__ __forceinline__ s16x4 tr_read(int vb) {
  s16x4 r; asm volatile("ds_read_b64_tr_b16 %0, %1 offset:%2" : "=&v"(r) : "v"(vb), "i"(OFF) : "memory"); return r;
}
template <int D0> __device__ __forceinline__ void pv_one(f32x16& od, int vb, bf16x8 pa0, bf16x8 pa1, bf16x8 pa2, bf16x8 pa3) {
  const s16x4 l0 = tr_read<v_rd_off(D0, 0, 0)>(vb), h0 = tr_read<v_rd_off(D0, 0, 1)>(vb), l1 = tr_read<v_rd_off(D0, 1, 0)>(vb), h1 = tr_read<v_rd_off(D0, 1, 1)>(vb);
  const s16x4 l2 = tr_read<v_rd_off(D0, 2, 0)>(vb), h2 = tr_read<v_rd_off(D0, 2, 1)>(vb), l3 = tr_read<v_rd_off(D0, 3, 0)>(vb), h3 = tr_read<v_rd_off(D0, 3, 1)>(vb);
  asm volatile("s_waitcnt lgkmcnt(0)" ::: "memory"); SBAR();
#define PK(L, H) (bf16x8){L[0], L[1], L[2], L[3], H[0], H[1], H[2], H[3]}
  od = __builtin_amdgcn_mfma_f32_32x32x16_bf16(pa0, PK(l0, h0), od, 0, 0, 0);
  od = __builtin_amdgcn_mfma_f32_32x32x16_bf16(pa1, PK(l1, h1), od, 0, 0, 0);
  od = __builtin_amdgcn_mfma_f32_32x32x16_bf16(pa2, PK(l2, h2), od, 0, 0, 0);
  od = __builtin_amdgcn_mfma_f32_32x32x16_bf16(pa3, PK(l3, h3), od, 0, 0, 0);
#undef PK
}
__device__ __forceinline__ void pv_d0(f32x16* o, int vb, bf16x8 pa0, bf16x8 pa1, bf16x8 pa2, bf16x8 pa3) {
  pv_one<0>(o[0], vb, pa0, pa1, pa2, pa3); pv_one<1>(o[1], vb, pa0, pa1, pa2, pa3); pv_one<2>(o[2], vb, pa0, pa1, pa2, pa3); pv_one<3>(o[3], vb, pa0, pa1, pa2, pa3);
}

struct UnitDesc { const bf16* Q; const bf16* K; const bf16* V; bf16* O; int ldo; int qb; int bias_head;
    int nt;
    int kb0;
    const unsigned short* qlist;
    int nrows;
    int part;
    bf16* PO; float* PML; };

__device__ __forceinline__ void attn_unit(const UnitDesc& u, const float* __restrict__ rel_bias, LAS char* lds, const int wave_id) {
  int tid_ = wave_id * 64 + lane_id(); asm volatile("" : "+v"(tid_));
  const int tid = tid_, wid = tid >> 6, lane = tid & 63, r32 = lane & 31, hi = lane >> 5;
  LAS char* V_lds = lds + OFF_V; LAS char* K_lds = lds + OFF_K;
  LAS float* wsl = (LAS float*)(lds + OFF_WS) + wid * 64; LAS float* li_l = wsl; LAS float* al_l = wsl + 32;
  LAS float* lut = (LAS float*)(lds + OFF_LUT);
  const int q0 = u.qb * 256, qw0 = q0 + wid * QBLK;
  int qpos = qw0 + r32, dsti = (qw0 + r32) * 4 + 3;
  if (u.qlist) { const int i = wid * QBLK + r32; const unsigned e = u.qlist[i < u.nrows ? i : u.nrows - 1]; qpos = (int)(e & 8191u); dsti = i < u.nrows ? qpos * 4 + (int)(e >> 13) : -1; }
  __syncthreads();
  for (int i = tid; i < LUT_N; i += 512) { const int d = LUT_DMAX - i; lut[i] = d < 0 ? NEGBIG : rel_bias[t5_bucket(d > 127 ? 127 : d) * 24 + u.bias_head] * LOG2E; }
  LAS int* rowdst = (LAS int*)(lds + OFF_GATE) + wid * 32;
  if (hi == 0) rowdst[r32] = dsti;
  float m_reg = NEGBIG, l_reg = 0; f32x16 o[4] = {}; bf16x8 qr[8];
  const bf16* Qw = u.Q + (size_t)qpos * LDP + hi * 8;
#pragma unroll
  for (int d0 = 0; d0 < 8; ++d0) qr[d0] = *reinterpret_cast<const bf16x8*>(Qw + d0 * 16);
  const bool gathered = u.qlist != nullptr;
  const int sr = tid >> 4, sc = (tid & 15) * 8, vst0 = v_st(sr, sc), vst1 = v_st(32 + sr, sc);
  const int vb0 = (int)(uintptr_t)V_lds + v_rd_base(lane);
  struct { bf16x8 vs0, vs1, ks0, ks1; } sr_[2];
  const bf16* Kh = u.K + (size_t)u.kb0 * LDP; const bf16* Vh = u.V + (size_t)u.kb0 * LDP;
#define SLOAD(i, k0) do { sr_[i].vs0 = *reinterpret_cast<const bf16x8*>(&Vh[(size_t)((k0) + sr) * LDP + sc]); sr_[i].vs1 = *reinterpret_cast<const bf16x8*>(&Vh[(size_t)((k0) + 32 + sr) * LDP + sc]); \
    sr_[i].ks0 = *reinterpret_cast<const bf16x8*>(&Kh[(size_t)((k0) + sr) * LDP + sc]); sr_[i].ks1 = *reinterpret_cast<const bf16x8*>(&Kh[(size_t)((k0) + 32 + sr) * LDP + sc]); } while (0)
#define SWRITE(b, i) do { *(LAS bf16x8*)(V_lds + (b) * SHM_V + vst0) = sr_[i].vs0; *(LAS bf16x8*)(V_lds + (b) * SHM_V + vst1) = sr_[i].vs1; const int kc = sc * 2; \
    *(LAS bf16x8*)(K_lds + (b) * SHM_K + KSWZ(sr, kc)) = sr_[i].ks0; *(LAS bf16x8*)(K_lds + (b) * SHM_K + KSWZ(32 + sr, kc)) = sr_[i].ks1; } while (0)
#define SWAIT() asm volatile("s_waitcnt vmcnt(4)" ::: "memory")
#define RESC(a) do { if (__any((a) < 1.f)) { if (hi == 0) al_l[r32] = (a); asm volatile("s_waitcnt lgkmcnt(0)" ::: "memory"); \
    _Pragma("unroll") for (int d = 0; d < 4; ++d) _Pragma("unroll") for (int r = 0; r < 16; ++r) o[d][r] *= al_l[crow(r, hi)]; } } while (0)
#define BIAS(P0, P1, j) do { const int k0_ = u.kb0 + (j) * KVBLK; \
    if (!gathered && qw0 - k0_ - 63 >= 113) bias_far(P0, P1, b31c); else { const int d_ = qpos - k0_; bias_near(P0, P1, lut, d_ > LUT_DMAX ? LUT_DMAX : d_, hi); } } while (0)
  f32x16 pA0, pA1, pB0, pB1; float mnA, mnB, alA, alB; bf16x8 pa0, pa1, pa2, pa3; const int NT = u.nt;
  constexpr int SE = 0, SO = 1;
  SLOAD(SE, 0); asm volatile("s_waitcnt vmcnt(0)" ::: "memory"); SWRITE(0, SE); __syncthreads();
  const float b31c = lut[LUT_DMAX - 127];
  qkt(pA0, pA1, K_lds, qr, r32, hi); BIAS(pA0, pA1, 0); partialSM(pA0, pA1, m_reg, mnA, alA);
  SLOAD(SO, KVBLK); if (2 < NT) SLOAD(SE, 2 * KVBLK);
  SWAIT(); SWRITE(1, SO); __syncthreads();
  for (int j = 1; j + 1 < NT; j += 2) {
    SBAR(); qkt(pB0, pB1, K_lds + SHM_K, qr, r32, hi);
    finishSM(pA0, pA1, alA, l_reg, pa0, pa1, pa2, pa3); SBAR();
    SLOAD(SO, (j + 2) * KVBLK); SBAR();
    pv_d0(o, vb0, pa0, pa1, pa2, pa3); BIAS(pB0, pB1, j); partialSM(pB0, pB1, m_reg, mnB, alB);
    __syncthreads(); SWAIT(); SWRITE(0, SE);
    RESC(alB); __syncthreads();
    SBAR(); qkt(pA0, pA1, K_lds, qr, r32, hi);
    finishSM(pB0, pB1, alB, l_reg, pa0, pa1, pa2, pa3); SBAR();
    if (j + 3 < NT) SLOAD(SE, (j + 3) * KVBLK); SBAR();
    pv_d0(o, vb0 + SHM_V, pa0, pa1, pa2, pa3); BIAS(pA0, pA1, j + 1); partialSM(pA0, pA1, m_reg, mnA, alA);
    __syncthreads(); SWAIT(); SWRITE(1, SO);
    RESC(alA); __syncthreads();
  }
  SBAR(); qkt(pB0, pB1, K_lds + SHM_K, qr, r32, hi);
  finishSM(pA0, pA1, alA, l_reg, pa0, pa1, pa2, pa3); SBAR();
  pv_d0(o, vb0, pa0, pa1, pa2, pa3); BIAS(pB0, pB1, NT - 1); partialSM(pB0, pB1, m_reg, mnB, alB);
  __syncthreads(); RESC(alB);
  finishSM(pB0, pB1, alB, l_reg, pa0, pa1, pa2, pa3); SBAR();
  pv_d0(o, vb0 + SHM_V, pa0, pa1, pa2, pa3);
  if (u.part) {
    if (hi == 0 && dsti >= 0) { u.PML[(size_t)dsti * 2] = m_reg; u.PML[(size_t)dsti * 2 + 1] = l_reg; }
    asm volatile("s_waitcnt lgkmcnt(0)" ::: "memory");
#pragma unroll
    for (int r = 0; r < 16; ++r) { const int di = rowdst[crow(r, hi)];
      if (di >= 0) { bf16* Ow = u.PO + (size_t)di * 128 + r32;
#pragma unroll
        for (int d0 = 0; d0 < 4; ++d0) Ow[d0 * 32] = (bf16)f2bf(o[d0][r]); } }
  } else {
    if (hi == 0) li_l[r32] = l_reg; asm volatile("s_waitcnt lgkmcnt(0)" ::: "memory");
    float rli[16];
#pragma unroll
    for (int r = 0; r < 16; ++r) rli[r] = __builtin_amdgcn_rcpf(li_l[crow(r, hi)]);
    bf16* Ow = u.O + (size_t)qw0 * u.ldo;
#pragma unroll
    for (int r = 0; r < 16; ++r) { const int orow = crow(r, hi);
#pragma unroll
      for (int d0 = 0; d0 < 4; ++d0) Ow[(size_t)orow * u.ldo + d0 * 32 + r32] = (bf16)f2bf(o[d0][r] * rli[r]); } }
#undef SLOAD
#undef SWRITE
#undef SWAIT
#undef RESC
#undef BIAS
}
constexpr int MX_LUT = RING_BYTES + 512, MX_WS = MX_LUT + 2176, MX_ROW = MX_WS + NW * 256, MX_CNT = MX_ROW + NW * 128, MX_PFX = MX_CNT + 64, MX_END = MX_PFX + 2048 + 64;
static_assert(MX_END <= LDS_BYTES, "MoBA LDS");
struct MobaUnit { const bf16* Q; const bf16* K; const bf16* V; int kb0; int bias_head; const unsigned short* qlist; int cnt; int c_begin, c_end; bf16* PO; float* PML; };
__device__ __forceinline__ void moba_unit(const MobaUnit& u, const float* __restrict__ rel_bias, LAS char* lds, const int wave_id) {
  int tid_ = wave_id * 64 + lane_id(); asm volatile("" : "+v"(tid_));
  const int tid = tid_, wid = tid >> 6, lane = tid & 63, r32 = lane & 31, hi = lane >> 5;
  LAS char* K_lds = lds; LAS char* V_lds = lds + 65536;
  LAS float* lut = (LAS float*)(lds + MX_LUT); LAS float* al_l = (LAS float*)(lds + MX_WS) + wid * 64;
  LAS int* rowdst = (LAS int*)(lds + MX_ROW) + wid * 32; LAS int* ccnt = (LAS int*)(lds + MX_CNT);
  __syncthreads();
  { const int sr = tid >> 4, sc = (tid & 15) * 8; const bf16* Kh = u.K + (size_t)u.kb0 * LDP; const bf16* Vh = u.V + (size_t)u.kb0 * LDP;
    bf16x8 kv[8], vv[8];
#pragma unroll
    for (int t = 0; t < 4; ++t) { kv[2 * t] = *reinterpret_cast<const bf16x8*>(&Kh[(size_t)(64 * t + sr) * LDP + sc]); kv[2 * t + 1] = *reinterpret_cast<const bf16x8*>(&Kh[(size_t)(64 * t + 32 + sr) * LDP + sc]);
                                  vv[2 * t] = *reinterpret_cast<const bf16x8*>(&Vh[(size_t)(64 * t + sr) * LDP + sc]); vv[2 * t + 1] = *reinterpret_cast<const bf16x8*>(&Vh[(size_t)(64 * t + 32 + sr) * LDP + sc]); }
    for (int i = tid; i < LUT_N; i += 512) { const int d = LUT_DMAX - i; lut[i] = d < 0 ? NEGBIG : rel_bias[t5_bucket(d > 127 ? 127 : d) * 24 + u.bias_head] * LOG2E; }
    if (tid == 0) ccnt[0] = u.c_begin;
#pragma unroll
    for (int t = 0; t < 4; ++t) { *(LAS bf16x8*)(K_lds + t * SHM_K + KSWZ(sr, sc * 2)) = kv[2 * t]; *(LAS bf16x8*)(K_lds + t * SHM_K + KSWZ(32 + sr, sc * 2)) = kv[2 * t + 1];
                                  *(LAS bf16x8*)(V_lds + t * SHM_V + v_st(sr, sc)) = vv[2 * t]; *(LAS bf16x8*)(V_lds + t * SHM_V + v_st(32 + sr, sc)) = vv[2 * t + 1]; } }
  __syncthreads();
  const int vb0 = (int)(uintptr_t)V_lds + v_rd_base(lane);
#define MX_TAKE(c_) do { int t_ = 0; if (lane == 0) t_ = __hip_atomic_fetch_add(ccnt, 1, __ATOMIC_RELAXED, __HIP_MEMORY_SCOPE_WORKGROUP); c_ = __builtin_amdgcn_readfirstlane(t_); } while (0)
#define MX_ROWS(c_, qpos_, dst_) do { if ((c_) < 8) { qpos_ = u.kb0 + 32 * (c_) + r32; dst_ = qpos_ * 4 + 3; } \
    else { const int i_ = ((c_) - 8) * 32 + r32; const unsigned e_ = u.qlist[i_ < u.cnt ? i_ : u.cnt - 1]; qpos_ = (int)(e_ & 8191u); dst_ = i_ < u.cnt ? qpos_ * 4 + (int)(e_ >> 13) : -1; } } while (0)
#define MX_QLOAD(dstq, qpos_) do { const bf16* Qw_ = u.Q + (size_t)(qpos_) * LDP + hi * 8; _Pragma("unroll") for (int d0 = 0; d0 < 8; ++d0) dstq[d0] = *reinterpret_cast<const bf16x8*>(Qw_ + d0 * 16); } while (0)
#define MX_RESC(a) do { if (__any((a) < 1.f)) { if (hi == 0) al_l[r32] = (a); asm volatile("s_waitcnt lgkmcnt(0)" ::: "memory"); \
    _Pragma("unroll") for (int d = 0; d < 4; ++d) _Pragma("unroll") for (int r = 0; r < 16; ++r) o[d][r] *= al_l[crow(r, hi)]; } } while (0)
#define MX_BIAS(P0, P1, t) do { const int d_ = qpos - (u.kb0 + (t) * KVBLK); bias_near(P0, P1, lut, d_ > LUT_DMAX ? LUT_DMAX : d_, hi); } while (0)
  int c, cn; MX_TAKE(c);
  if (c >= u.c_end) return;
  int qpos, dsti, qposn = 0, dstn = -1; bf16x8 qr[8], qn[8];
  MX_ROWS(c, qpos, dsti); MX_QLOAD(qr, qpos);
  for (;;) {
    MX_TAKE(cn);
    if (cn < u.c_end) { MX_ROWS(cn, qposn, dstn); MX_QLOAD(qn, qposn); }
    if (hi == 0) rowdst[r32] = dsti;
    float m_reg = NEGBIG, l_reg = 0; f32x16 o[4] = {}; f32x16 pA0, pA1, pB0, pB1; float mnA, mnB, alA, alB; bf16x8 pa0, pa1, pa2, pa3;
    qkt(pA0, pA1, K_lds, qr, r32, hi); MX_BIAS(pA0, pA1, 0); partialSM(pA0, pA1, m_reg, mnA, alA);
    SBAR(); qkt(pB0, pB1, K_lds + SHM_K, qr, r32, hi); finishSM(pA0, pA1, alA, l_reg, pa0, pa1, pa2, pa3); SBAR();
    pv_d0(o, vb0, pa0, pa1, pa2, pa3); MX_BIAS(pB0, pB1, 1); partialSM(pB0, pB1, m_reg, mnB, alB); MX_RESC(alB);
    SBAR(); qkt(pA0, pA1, K_lds + 2 * SHM_K, qr, r32, hi); finishSM(pB0, pB1, alB, l_reg, pa0, pa1, pa2, pa3); SBAR();
    pv_d0(o, vb0 + SHM_V, pa0, pa1, pa2, pa3); MX_BIAS(pA0, pA1, 2); partialSM(pA0, pA1, m_reg, mnA, alA); MX_RESC(alA);
    SBAR(); qkt(pB0, pB1, K_lds + 3 * SHM_K, qr, r32, hi); finishSM(pA0, pA1, alA, l_reg, pa0, pa1, pa2, pa3); SBAR();
    pv_d0(o, vb0 + 2 * SHM_V, pa0, pa1, pa2, pa3); MX_BIAS(pB0, pB1, 3); partialSM(pB0, pB1, m_reg, mnB, alB); MX_RESC(alB);
    finishSM(pB0, pB1, alB, l_reg, pa0, pa1, pa2, pa3); SBAR();
    pv_d0(o, vb0 + 3 * SHM_V, pa0, pa1, pa2, pa3);
    if (hi == 0 && dsti >= 0) { u.PML[(size_t)dsti * 2] = m_reg; u.PML[(size_t)dsti * 2 + 1] = l_reg; }
    asm volatile("s_waitcnt lgkmcnt(0)" ::: "memory");
#pragma unroll
    for (int r = 0; r < 16; ++r) { const int di = rowdst[crow(r, hi)];
      if (di >= 0) { bf16* Ow = u.PO + (size_t)di * 128 + r32;
#pragma unroll
        for (int d0 = 0; d0 < 4; ++d0) Ow[d0 * 32] = (bf16)f2bf(o[d0][r]); } }
    if (cn >= u.c_end) break;
    c = cn; qpos = qposn; dsti = dstn;
#pragma unroll
    for (int d0 = 0; d0 < 8; ++d0) qr[d0] = qn[d0];
  }
#undef MX_TAKE
#undef MX_ROWS
#undef MX_QLOAD
#undef MX_RESC
#undef MX_BIAS
}
constexpr int DX_VB = 32768, DX_KB = 16384, DX_OFF_V = 0, DX_OFF_K = 2 * DX_VB, DX_OFF_WS = DX_OFF_K + 2 * DX_KB, DX_OFF_LUT = DX_OFF_WS + NW * 64 * 4, DX_END = DX_OFF_LUT + 2176;
static_assert(DX_END <= RING_BYTES, "diff attention LDS");
__device__ __forceinline__ void qkt_half(f32x16& p, const LAS char* Ks, int half, const bf16x8* qr, int r32, int hi) {
  p = f32x16{};
#pragma unroll
  for (int d0 = 0; d0 < 8; ++d0) { const int cb = (d0 * 16 + hi * 8) * 2;
    p = __builtin_amdgcn_mfma_f32_32x32x16_bf16(*reinterpret_cast<const LAS bf16x8*>(Ks + KSWZ(32 * half + r32, cb)), qr[d0], p, 0, 0, 0); }
}
__device__ __forceinline__ void bias_far16(f32x16& p, float rowoff) {
#pragma unroll
  for (int r = 0; r < 16; ++r) p[r] = fmaf(p[r], CQK, rowoff);
}
__device__ __forceinline__ void bias_near16(f32x16& p, const LAS float* rl, int dist0  , int hi) {
  const LAS float* b = rl + (LUT_DMAX - dist0 + 4 * hi);
#pragma unroll
  for (int r = 0; r < 16; ++r) p[r] = fmaf(p[r], CQK, b[(r & 3) + 8 * (r >> 2)]);
}
__device__ __forceinline__ float sm16(f32x16& p, float& m_reg, float& l_reg, bf16x8& pa0, bf16x8& pa1) {
  float pmax = p[0];
#pragma unroll
  for (int r = 1; r < 16; ++r) pmax = fmaxf(pmax, p[r]);
  { auto rr = __builtin_amdgcn_permlane32_swap(__float_as_uint(pmax), __float_as_uint(pmax), false, false); pmax = fmaxf(__uint_as_float(rr[0]), __uint_as_float(rr[1])); }
  float mn, alpha;
  if (__builtin_expect(__all(pmax - m_reg <= THRL), 1)) { mn = m_reg; alpha = 1.f; }
  else { mn = fmaxf(m_reg, pmax); alpha = __builtin_amdgcn_exp2f(m_reg - mn); m_reg = mn; }
  float ps = 0.f;
#pragma unroll
  for (int r = 0; r < 16; ++r) { p[r] = __builtin_amdgcn_exp2f(p[r] - mn); ps += p[r]; }
  { auto rr = __builtin_amdgcn_permlane32_swap(__float_as_uint(ps), __float_as_uint(ps), false, false); ps = __uint_as_float(rr[0]) + __uint_as_float(rr[1]); }
  l_reg = l_reg * alpha + ps;
#define PK4(P, BASE, OUT) do { unsigned a0 = cvtpk(P[BASE + 0], P[BASE + 1]), a1 = cvtpk(P[BASE + 2], P[BASE + 3]);   \
    unsigned b0 = cvtpk(P[BASE + 4], P[BASE + 5]), b1 = cvtpk(P[BASE + 6], P[BASE + 7]);                              \
    auto r0 = __builtin_amdgcn_permlane32_swap(a0, b0, false, false); auto r1 = __builtin_amdgcn_permlane32_swap(a1, b1, false, false); \
    u32x4 w = {r0[0], r1[0], r0[1], r1[1]}; OUT = *reinterpret_cast<bf16x8*>(&w); } while (0)
  PK4(p, 0, pa0); PK4(p, 8, pa1);
#undef PK4
  return alpha;
}
template <int D0, int HALF> __device__ __forceinline__ void pv_half8(f32x16& od, int vb, bf16x8 pa0, bf16x8 pa1) {
  constexpr int HB = (D0 >> 2) * 16384, DD = D0 & 3;
  const s16x4 l0 = tr_read<HB + v_rd_off(DD, 2 * HALF, 0)>(vb), h0 = tr_read<HB + v_rd_off(DD, 2 * HALF, 1)>(vb), l1 = tr_read<HB + v_rd_off(DD, 2 * HALF + 1, 0)>(vb), h1 = tr_read<HB + v_rd_off(DD, 2 * HALF + 1, 1)>(vb);
  asm volatile("s_waitcnt lgkmcnt(0)" ::: "memory"); SBAR();
#define PK(L, H) (bf16x8){L[0], L[1], L[2], L[3], H[0], H[1], H[2], H[3]}
  od = __builtin_amdgcn_mfma_f32_32x32x16_bf16(pa0, PK(l0, h0), od, 0, 0, 0);
  od = __builtin_amdgcn_mfma_f32_32x32x16_bf16(pa1, PK(l1, h1), od, 0, 0, 0);
#undef PK
}
struct DiffUnit { const bf16* Q; const bf16* K; const bf16* V; bf16* O; int qb; int bias_head; };
template <int D0> __device__ __forceinline__ void pv_one8(f32x16& od, int vb, bf16x8 pa0, bf16x8 pa1, bf16x8 pa2, bf16x8 pa3) {
  constexpr int HB = (D0 >> 2) * 16384, DD = D0 & 3;
  const s16x4 l0 = tr_read<HB + v_rd_off(DD, 0, 0)>(vb), h0 = tr_read<HB + v_rd_off(DD, 0, 1)>(vb), l1 = tr_read<HB + v_rd_off(DD, 1, 0)>(vb), h1 = tr_read<HB + v_rd_off(DD, 1, 1)>(vb);
  const s16x4 l2 = tr_read<HB + v_rd_off(DD, 2, 0)>(vb), h2 = tr_read<HB + v_rd_off(DD, 2, 1)>(vb), l3 = tr_read<HB + v_rd_off(DD, 3, 0)>(vb), h3 = tr_read<HB + v_rd_off(DD, 3, 1)>(vb);
  asm volatile("s_waitcnt lgkmcnt(0)" ::: "memory"); SBAR();
#define PK(L, H) (bf16x8){L[0], L[1], L[2], L[3], H[0], H[1], H[2], H[3]}
  od = __builtin_amdgcn_mfma_f32_32x32x16_bf16(pa0, PK(l0, h0), od, 0, 0, 0);
  od = __builtin_amdgcn_mfma_f32_32x32x16_bf16(pa1, PK(l1, h1), od, 0, 0, 0);
  od = __builtin_amdgcn_mfma_f32_32x32x16_bf16(pa2, PK(l2, h2), od, 0, 0, 0);
  od = __builtin_amdgcn_mfma_f32_32x32x16_bf16(pa3, PK(l3, h3), od, 0, 0, 0);
#undef PK
}
__device__ __forceinline__ void diff_unit(const DiffUnit& u, const float* __restrict__ rel_bias, LAS char* lds, const int wave_id) {
  int tid_ = wave_id * 64 + lane_id(); asm volatile("" : "+v"(tid_));
  const int tid = tid_, wid = tid >> 6, lane = tid & 63, r32 = lane & 31, hi = lane >> 5;
  LAS char* V_lds = lds + DX_OFF_V; LAS char* K_lds = lds + DX_OFF_K;
  LAS float* wsl = (LAS float*)(lds + DX_OFF_WS) + wid * 64; LAS float* li_l = wsl; LAS float* al_l = wsl + 32;
  LAS float* lut = (LAS float*)(lds + DX_OFF_LUT);
  const int q0 = u.qb * 256, qw0 = q0 + wid * QBLK, qpos = qw0 + r32;
  __syncthreads();
  for (int i = tid; i < LUT_N; i += 512) { const int d = LUT_DMAX - i; lut[i] = d < 0 ? NEGBIG : rel_bias[t5_bucket(d > 127 ? 127 : d) * 24 + u.bias_head] * LOG2E; }
  float m_reg = NEGBIG, l_reg = 0; f32x16 o[8] = {}; bf16x8 qr[8];
  { const bf16* Qw = u.Q + (size_t)qpos * LDP + hi * 8;
#pragma unroll
    for (int d0 = 0; d0 < 8; ++d0) qr[d0] = *reinterpret_cast<const bf16x8*>(Qw + d0 * 16); }
  const int vb0 = (int)(uintptr_t)V_lds + v_rd_base(lane);
  unsigned gk[2], gv[4];
#pragma unroll
  for (int i = 0; i < 2; ++i) { const int L = (wid * 2 + i) * 1024 + lane * 16, row = L >> 8, cB = (L & 255) ^ ((row & 7) << 4); gk[i] = (unsigned)(row * LDP + (cB >> 1)) * 2u; }
#pragma unroll
  for (int i = 0; i < 4; ++i) { const int Lv = (wid * 4 + i) * 1024 + lane * 16, hv = Lv >> 14, L = Lv & 16383, sub = L >> 9, w2 = (L & 511) >> 1, kk = (sub >> 2) * 8 + (w2 >> 5), c = (sub & 3) * 32 + (w2 & 31);
    const int k = (kk & ~0xC) | ((kk & 4) << 1) | ((kk & 8) >> 1); gv[i] = (unsigned)(k * LDP + hv * 128 + c) * 2u; }
#define DLOAD(k0, b) do { const char* kb_ = (const char*)(u.K + (size_t)(k0) * LDP); const char* vb_ = (const char*)(u.V + (size_t)(k0) * LDP); \
    _Pragma("unroll") for (int i_ = 0; i_ < 2; ++i_) __builtin_amdgcn_global_load_lds((const unsigned*)(kb_ + gk[i_]), (LAS unsigned*)(K_lds + (b) * DX_KB + (wid * 2 + i_) * 1024), 16, 0, 0); \
    _Pragma("unroll") for (int i_ = 0; i_ < 4; ++i_) __builtin_amdgcn_global_load_lds((const unsigned*)(vb_ + gv[i_]), (LAS unsigned*)(V_lds + (b) * DX_VB + (wid * 4 + i_) * 1024), 16, 0, 0); } while (0)
  const int NT = 4 * (u.qb + 1);
  DLOAD(0, 0); asm volatile("s_waitcnt vmcnt(0)" ::: "memory"); __syncthreads();
  const float b31c = lut[LUT_DMAX - 127];
#pragma nounroll
  for (int j = 0; j < NT; ++j) {
    const int bsel = j & 1;
    if (j + 1 < NT) DLOAD((j + 1) * KVBLK, bsel ^ 1);
    const int vb = vb0 + bsel * DX_VB;
#define DX_HALF(HF) do { f32x16 p; qkt_half(p, K_lds + bsel * DX_KB, HF, qr, r32, hi); \
      { const int k0_ = j * KVBLK + 32 * (HF); if (qw0 - k0_ - 31 >= 113) bias_far16(p, b31c); else bias_near16(p, lut, qpos - k0_, hi); } \
      bf16x8 pa0, pa1; const float alpha = sm16(p, m_reg, l_reg, pa0, pa1); \
      if (__any(alpha < 1.f)) { if (hi == 0) al_l[r32] = alpha; asm volatile("s_waitcnt lgkmcnt(0)" ::: "memory"); \
        _Pragma("unroll") for (int d = 0; d < 8; ++d) _Pragma("unroll") for (int r = 0; r < 16; ++r) o[d][r] *= al_l[crow(r, hi)]; } \
      SBAR(); \
      pv_half8<0, HF>(o[0], vb, pa0, pa1); pv_half8<1, HF>(o[1], vb, pa0, pa1); pv_half8<2, HF>(o[2], vb, pa0, pa1); pv_half8<3, HF>(o[3], vb, pa0, pa1); \
      pv_half8<4, HF>(o[4], vb, pa0, pa1); pv_half8<5, HF>(o[5], vb, pa0, pa1); pv_half8<6, HF>(o[6], vb, pa0, pa1); pv_half8<7, HF>(o[7], vb, pa0, pa1); } while (0)
    DX_HALF(0); DX_HALF(1);
#undef DX_HALF
    asm volatile("s_waitcnt vmcnt(0)" ::: "memory");
    __syncthreads();
  }
  if (hi == 0) li_l[r32] = l_reg; asm volatile("s_waitcnt lgkmcnt(0)" ::: "memory");
  bf16* Ow = u.O + (size_t)qw0 * 2048;
#pragma unroll
  for (int r = 0; r < 16; ++r) { const int orow = crow(r, hi); const float rl = __builtin_amdgcn_rcpf(li_l[orow]);
#pragma unroll
    for (int d0 = 0; d0 < 8; ++d0) Ow[(size_t)orow * 2048 + d0 * 32 + r32] = (bf16)f2bf(o[d0][r] * rl); }
#undef DLOAD
}
}

__device__ __forceinline__ void p0_transpose_item8(const float* W, int K, int N, unsigned char* WT, float scale, LAS float* scr, int item, int lane) {
    const int nblk = N / 32, kb = item / nblk, nb = item % nblk, k0 = 64 * kb, n0 = 32 * nb;
#pragma unroll 8
    for (int i = 0; i < 32; ++i) { const int kk = 2 * i + (lane >> 5); scr[kk * 33 + (lane & 31)] = W[(size_t)(k0 + kk) * N + n0 + (lane & 31)]; }
    LDS_WAIT(); asm volatile("" ::: "memory");
    const int n = lane >> 1, kh = (lane & 1) * 32; const LAS float* sp = scr + kh * 33 + n;
    v4u o0, o1;
    o0.x = pk4_fp8(sp[0 * 33] * scale, sp[1 * 33] * scale, sp[2 * 33] * scale, sp[3 * 33] * scale); o0.y = pk4_fp8(sp[4 * 33] * scale, sp[5 * 33] * scale, sp[6 * 33] * scale, sp[7 * 33] * scale);
    o0.z = pk4_fp8(sp[8 * 33] * scale, sp[9 * 33] * scale, sp[10 * 33] * scale, sp[11 * 33] * scale); o0.w = pk4_fp8(sp[12 * 33] * scale, sp[13 * 33] * scale, sp[14 * 33] * scale, sp[15 * 33] * scale);
    o1.x = pk4_fp8(sp[16 * 33] * scale, sp[17 * 33] * scale, sp[18 * 33] * scale, sp[19 * 33] * scale); o1.y = pk4_fp8(sp[20 * 33] * scale, sp[21 * 33] * scale, sp[22 * 33] * scale, sp[23 * 33] * scale);
    o1.z = pk4_fp8(sp[24 * 33] * scale, sp[25 * 33] * scale, sp[26 * 33] * scale, sp[27 * 33] * scale); o1.w = pk4_fp8(sp[28 * 33] * scale, sp[29 * 33] * scale, sp[30 * 33] * scale, sp[31 * 33] * scale);
    GAS v4u* dst = (GAS v4u*)(WT + (size_t)(n0 + n) * K + k0 + kh); dst[0] = o0; dst[1] = o1;
    LDS_WAIT(); asm volatile("" ::: "memory");
}
struct TrJob { const float* W; unsigned char* WT; int K, N; float scale; int f8; int item; };
__device__ __forceinline__ void tr_load(const TrJob& j, f32x4 (&v)[16], int lane) {
    const int nblk = j.N / 64, kb = j.item / nblk, nb = j.item % nblk; const float* p = j.W + (size_t)(64 * kb + (lane >> 4)) * j.N + 64 * nb + 4 * (lane & 15);
#pragma unroll
    for (int i = 0; i < 16; ++i) v[i] = *(const GAS f32x4*)(p + (size_t)(4 * i) * j.N);
}
__device__ __forceinline__ void tr_to_lds(const f32x4 (&v)[16], LAS float* scr, int lane) {
#pragma unroll
    for (int i = 0; i < 16; ++i) *(LAS f32x4*)(scr + (4 * i + (lane >> 4)) * 64 + 4 * (lane & 15)) = v[i];
}
__device__ __forceinline__ void tr_finish(const TrJob& j, LAS float* scr, int lane) {
    const int nblk = j.N / 64, kb = j.item / nblk, nb = j.item % nblk, k0 = 64 * kb, n0 = 64 * nb, part = lane & 3;
    LDS_WAIT(); asm volatile("" ::: "memory");
#pragma unroll
    for (int p = 0; p < 4; ++p) { const int n = 16 * p + (lane >> 2); const LAS float* sp = scr + (16 * part) * 64 + n; float x[16];
#pragma unroll
        for (int q = 0; q < 16; ++q) x[q] = sp[q * 64] * j.scale;
        if (j.f8) { v4u o; o.x = pk4_fp8(x[0], x[1], x[2], x[3]); o.y = pk4_fp8(x[4], x[5], x[6], x[7]); o.z = pk4_fp8(x[8], x[9], x[10], x[11]); o.w = pk4_fp8(x[12], x[13], x[14], x[15]);
            *(GAS v4u*)(j.WT + (size_t)(n0 + n) * j.K + k0 + 16 * part) = o; }
        else { v4u o0, o1; o0.x = pk2(x[0], x[1]); o0.y = pk2(x[2], x[3]); o0.z = pk2(x[4], x[5]); o0.w = pk2(x[6], x[7]); o1.x = pk2(x[8], x[9]); o1.y = pk2(x[10], x[11]); o1.z = pk2(x[12], x[13]); o1.w = pk2(x[14], x[15]);
            GAS v4u* d = (GAS v4u*)(j.WT + ((size_t)(n0 + n) * j.K + k0 + 16 * part) * 2); d[0] = o0; d[1] = o1; } }
    LDS_WAIT(); asm volatile("" ::: "memory");
}
__device__ __forceinline__ void p0_convert8(const float* src, unsigned char* dst, float scale, size_t n16, size_t gtid, size_t gthreads) {
    for (size_t i = gtid; i < n16; i += gthreads) { const GAS f32x4* p = (const GAS f32x4*)(src + i * 16); const f32x4 a = p[0] * scale, b = p[1] * scale, c = p[2] * scale, d = p[3] * scale;
        v4u o; o.x = pk4_fp8(a.x, a.y, a.z, a.w); o.y = pk4_fp8(b.x, b.y, b.z, b.w); o.z = pk4_fp8(c.x, c.y, c.z, c.w); o.w = pk4_fp8(d.x, d.y, d.z, d.w); *(GAS v4u*)(dst + i * 16) = o; }
}

namespace rt {
using f32x16 = __attribute__((ext_vector_type(16))) float;
__device__ __forceinline__ void ins16(float (&val)[16], int (&idx)[16], float v, int i) {
#pragma unroll
    for (int s = 0; s < 16; ++s) { const bool gt = v > val[s]; const float tv = gt ? val[s] : v; const int ti = gt ? idx[s] : i; val[s] = gt ? v : val[s]; idx[s] = gt ? i : idx[s]; v = tv; i = ti; }
}
__device__ __forceinline__ void side_top16(const bf16* q, const bf16* keys, int r32, int hi, float (&val)[16], int (&idx)[16]) {
    bf16x8 qf[8];
#pragma unroll
    for (int d0 = 0; d0 < 8; ++d0) qf[d0] = *reinterpret_cast<const bf16x8*>(q + d0 * 16 + hi * 8);
    f32x16 acc[4];
#pragma unroll
    for (int nb = 0; nb < 4; ++nb) { acc[nb] = f32x16{};
#pragma unroll
        for (int d0 = 0; d0 < 8; ++d0) { const bf16x8 kf = *reinterpret_cast<const bf16x8*>(keys + (32 * nb + r32) * 128 + d0 * 16 + hi * 8);
            acc[nb] = __builtin_amdgcn_mfma_f32_32x32x16_bf16(kf, qf[d0], acc[nb], 0, 0, 0); } }
#pragma unroll
    for (int s = 0; s < 16; ++s) { val[s] = -3.0e38f; idx[s] = 0; }
#pragma unroll
    for (int nb = 0; nb < 4; ++nb)
#pragma unroll
        for (int r = 0; r < 16; ++r) ins16(val, idx, acc[nb][r], 32 * nb + (r & 3) + 8 * (r >> 2) + 4 * hi);
    float pv[16]; int pi[16];
#pragma unroll
    for (int s = 0; s < 16; ++s) { pv[s] = __shfl_xor(val[s], 32); pi[s] = __shfl_xor(idx[s], 32); }
#pragma unroll
    for (int s = 0; s < 16; ++s) ins16(val, idx, pv[s], pi[s]);
}
template <int I, int J> struct Cand {
    static __device__ __forceinline__ void run(float (&cv)[16], int (&ci)[16], const float (&v1)[16], const float (&v2)[16], const int (&i1)[16], const int (&i2)[16]) {
        if constexpr ((I + 1) * (J + 1) <= 16) { ins16(cv, ci, v1[I] + v2[J], i1[I] * 128 + i2[J]); Cand<I, J + 1>::run(cv, ci, v1, v2, i1, i2); }
        else if constexpr (I + 1 < 16) Cand<I + 1, 0>::run(cv, ci, v1, v2, i1, i2);
    }
};
template <int I> struct Cand<I, 16> { static __device__ __forceinline__ void run(float (&cv)[16], int (&ci)[16], const float (&v1)[16], const float (&v2)[16], const int (&i1)[16], const int (&i2)[16]) {
        if constexpr (I + 1 < 16) Cand<I + 1, 0>::run(cv, ci, v1, v2, i1, i2); } };
constexpr int OFF_E = 0, OFF_G = 16384;
__device__ __forceinline__ void route_block(int t0, const bf16* PQ, const bf16* KEYSB, unsigned char* GD, int* EIDX, float* GATES, LAS char* lds, const int wave_id) {
    int tid_ = wave_id * 64 + lane_id(); asm volatile("" : "+v"(tid_));
    const int tid = tid_, h = tid >> 6, lane = tid & 63, r32 = lane & 31, hi = lane >> 5;
    LAS int* ent_e = (LAS int*)(lds + OFF_E); LAS float* ent_g = (LAS float*)(lds + OFF_G);
    __syncthreads();
    const bf16* q = PQ + (size_t)(t0 + r32) * 2048 + h * 256;
    float v1[16], v2[16], cv[16]; int i1[16], i2[16], ci[16];
    side_top16(q, KEYSB, r32, hi, v1, i1);
    side_top16(q + 128, KEYSB + 128 * 128, r32, hi, v2, i2);
#pragma unroll
    for (int s = 0; s < 16; ++s) { cv[s] = -3.0e38f; ci[s] = 0; }
    Cand<0, 0>::run(cv, ci, v1, v2, i1, i2);
    const float mx = cv[0]; float sum = 0.f;
#pragma unroll
    for (int s = 0; s < 16; ++s) { cv[s] = __expf(cv[s] - mx); sum += cv[s]; }
    const float inv = 1.0f / sum;
    if (hi == 0) {
#pragma unroll
        for (int s = 0; s < 16; ++s) { ent_e[r32 * 128 + h * 16 + s] = ci[s]; ent_g[r32 * 128 + h * 16 + s] = cv[s] * inv; }
        if (EIDX) {
#pragma unroll
            for (int s = 0; s < 16; ++s) { EIDX[(size_t)(t0 + r32) * 128 + h * 16 + s] = ci[s]; GATES[(size_t)(t0 + r32) * 128 + h * 16 + s] = cv[s] * inv; } }
    }
    __syncthreads();
    { const int tok = tid >> 4, s0 = (tid & 15) * 8;
        for (int k = 0; k < 8; ++k) { const int sidx = s0 + k, e = ent_e[tok * 128 + sidx]; float g = 0.f; bool first = true;
            for (int s2 = 0; s2 < 128; ++s2) { if (ent_e[tok * 128 + s2] == e) { g += ent_g[tok * 128 + s2]; if (s2 < sidx) first = false; } }
            if (first) GD[(size_t)(t0 + tok) * 16384 + e] = (unsigned char)(pk4_fp8(g * 256.f, 0.f, 0.f, 0.f) & 0xffu); } }
}
}

__device__ __forceinline__ float wave_sum(float v) {
#pragma unroll
    for (int o = 1; o < 64; o <<= 1) v += __shfl_xor(v, o);
    return v;
}
__device__ __forceinline__ void ln_row(const float* in, const float* g, const float* b, float* outf, bf16* outb, unsigned char* outq, int lane, float mul = 1.0f) {
    f32x4 v[16]; float s = 0.f;
#pragma unroll
    for (int j = 0; j < 16; ++j) { v[j] = *(const GAS f32x4*)(in + 256 * j + 4 * lane); s += (v[j].x + v[j].y) + (v[j].z + v[j].w); }
    const float mean = wave_sum(s) * (1.0f / DM); float s2 = 0.f;
#pragma unroll
    for (int j = 0; j < 16; ++j) { v[j] = v[j] - mean; s2 += (v[j].x * v[j].x + v[j].y * v[j].y) + (v[j].z * v[j].z + v[j].w * v[j].w); }
    const float rstd = rsqrtf(wave_sum(s2) * (1.0f / DM) + LN_EPS);
#pragma unroll
    for (int j = 0; j < 16; ++j) { const f32x4 gv = *(const GAS f32x4*)(g + 256 * j + 4 * lane), bv = *(const GAS f32x4*)(b + 256 * j + 4 * lane); const f32x4 y = (v[j] * rstd * gv + bv) * mul;
        *(GAS f32x4*)(outf + 256 * j + 4 * lane) = y;
        if (outb) { v2u o; o.x = pk2(y.x, y.y); o.y = pk2(y.z, y.w); *(GAS v2u*)(outb + 256 * j + 4 * lane) = o; }
        if (outq) *(GAS unsigned*)(outq + 256 * j + 4 * lane) = pk4_fp8(y.x, y.y, y.z, y.w); }
}

struct Args { const float* in[21]; float* out; unsigned char* ws; int ph_lo, ph_hi; };
constexpr size_t WS_CTL = 0, WS_KMEANB = 1 * MiB, WS_KEYSB = 1 * MiB + 512 * 1024;
constexpr size_t WS_WINT = 2 * MiB, WS_MERGED = 2 * MiB, WS_X1B = 66 * MiB, WS_PQ = 130 * MiB;
constexpr size_t WS_XB = 162 * MiB, WS_YA = 162 * MiB, WS_YB = 194 * MiB;
constexpr size_t WS_PROJ = 226 * MiB, WS_G = 226 * MiB;
constexpr size_t WS_OP0 = 546 * MiB, WS_OP1 = 578 * MiB, WS_WOA = 610 * MiB, WS_WOB = 626 * MiB, WS_WOUT = 642 * MiB, WS_WQ = 674 * MiB, WS_UB = 690 * MiB, WS_VT = 818 * MiB, WS_X1F = 946 * MiB;
constexpr size_t WS_MLIST = 2 * MiB, WS_PO = 10 * MiB, WS_PML = 138 * MiB;
constexpr int CW_CNT = 8192, CNT_STRIDE = 64, CW_QUEUE = 49152;
constexpr size_t WS_EIDX = 1074 * MiB, WS_GATES = 1078 * MiB, WS_NEED = 1082 * MiB;

__global__ void __launch_bounds__(NWAVES * 64, 2) mega_fwd(Args args) {
    extern __shared__ __attribute__((aligned(16))) unsigned char lds_raw[];
    LAS unsigned char* lds = (LAS unsigned char*)lds_raw;
    volatile LAS unsigned* MISC = (volatile LAS unsigned*)(lds + MISC_OFF);
    const int wave = __builtin_amdgcn_readfirstlane((int)threadIdx.x >> 6);
#define lane (lane_id())
#define tid (wave * 64 + lane_id())
    const int G = gridDim.x; const int vcu = (G % 8 == 0) ? ((int)blockIdx.x % 8) * (G / 8) + (int)blockIdx.x / 8 : (int)blockIdx.x;
    unsigned char* ws = args.ws;
    gu32* ctl = (gu32*)(ws + WS_CTL);
    for (int u = tid; u < (LDS_BYTES - LDSCTL_OFF) / 4; u += NWAVES * 64) ((LAS unsigned*)(lds + LDSCTL_OFF))[u] = 0u;
    __syncthreads();
    XcdBarrier bar = xcd_barrier_post((unsigned*)(ctl + CW_BAR), MISC + 8);
    const int lo = args.ph_lo, hi = args.ph_hi;
#ifdef PROBE_A
#define PR_BEGIN(k) do { if ((k) == PROBE_A && blockIdx.x == 0 && tid == 0) __hip_atomic_store(ctl + 2112, (unsigned)__builtin_amdgcn_s_memrealtime(), RLX_AGENT); } while (0)
#define PR_END(k) do { if ((k) == PROBE_B - 1 && blockIdx.x == 0 && tid == 0) __hip_atomic_store(ctl + 2048, (unsigned)__builtin_amdgcn_s_memrealtime() - __hip_atomic_load(ctl + 2112, RLX_AGENT), RLX_AGENT); } while (0)
#else
#define PR_BEGIN(k)
#define PR_END(k)
#endif
#define IN(k) (lo <= (k) && (k) < hi)
#define BOTH(k) (IN(k) && IN((k) + 1))
#define WINT ((bf16*)(ws + WS_WINT))
#define XB ((bf16*)(ws + WS_XB))
#define PROJ ((bf16*)(ws + WS_PROJ))

#define MERGED ((bf16*)(ws + WS_MERGED))
#define X1B ((bf16*)(ws + WS_X1B))
#define PQ ((bf16*)(ws + WS_PQ))
#define GD ((bf16*)(ws + WS_G))
#define WOA ((bf16*)(ws + WS_WOA))
#define WOB ((bf16*)(ws + WS_WOB))
#define WOUT ((bf16*)(ws + WS_WOUT))
#define WQ ((bf16*)(ws + WS_WQ))
#define UB ((bf16*)(ws + WS_UB))
#define VT ((bf16*)(ws + WS_VT))
#define KEYSB ((bf16*)(ws + WS_KEYSB))
#define X1F ((float*)(ws + WS_X1F))
#define X1Q ((unsigned char*)(ws + WS_OP0))
    if (IN(0)) { PR_BEGIN(0);
        LAS float* scr = (LAS float*)(lds + wave * 16384);
        const int gw = vcu * NWAVES + wave, NGW = G * NWAVES;
        constexpr int I_IN = (DM / 64) * (INW / 64), I_OA = (2048 / 64) * (DM / 64), I_OUT = (DM / 64) * (DM / 64), I_WQ = (DM / 64) * (2048 / 64), I_V = (16384 / 64) * (DM / 64), I_ALL = I_IN + 2 * I_OA + I_OUT + I_WQ + I_V;
#define TR_DECODE(it_, J) do { int r_ = (it_); \
            if (r_ < I_IN) { J.W = args.in[1]; J.WT = (unsigned char*)WINT; J.K = DM; J.N = INW; J.scale = 64.f; J.f8 = 1; } else { r_ -= I_IN; \
            if (r_ < I_OA) { J.W = args.in[9]; J.WT = (unsigned char*)WOA; J.K = 2048; J.N = DM; J.scale = 64.f; J.f8 = 1; } else { r_ -= I_OA; \
            if (r_ < I_OA) { J.W = args.in[10]; J.WT = (unsigned char*)WOB; J.K = 2048; J.N = DM; J.scale = 64.f; J.f8 = 1; } else { r_ -= I_OA; \
            if (r_ < I_OUT) { J.W = args.in[11]; J.WT = (unsigned char*)WOUT; J.K = DM; J.N = DM; J.scale = 64.f; J.f8 = 1; } else { r_ -= I_OUT; \
            if (r_ < I_WQ) { J.W = args.in[14]; J.WT = (unsigned char*)WQ; J.K = DM; J.N = 2048; J.scale = 1.f; J.f8 = 0; } else { r_ -= I_WQ; \
            J.W = args.in[18]; J.WT = (unsigned char*)VT; J.K = 16384; J.N = DM; J.scale = 8.f; J.f8 = 1; } } } } } J.item = r_; } while (0)
        { TrJob jc, jn; f32x4 tv[16]; int it = gw;
          if (it < I_ALL) { TR_DECODE(it, jc); tr_load(jc, tv, lane); }
          while (it < I_ALL) { const int nx = it + NGW; tr_to_lds(tv, scr, lane);
              if (nx < I_ALL) { TR_DECODE(nx, jn); tr_load(jn, tv, lane); }
              tr_finish(jc, scr, lane); jc = jn; it = nx; } }
#undef TR_DECODE
        const size_t gtid = (size_t)blockIdx.x * 512 + tid, gth = (size_t)G * 512;
        p0_convert8(args.in[0], (unsigned char*)XB, 1.0f, (size_t)S * DM / 16, gtid, gth);
        p0_convert8(args.in[17], (unsigned char*)UB, 64.0f, (size_t)16384 * DM / 16, gtid, gth);
        p0_convert(args.in[15], KEYSB, 128 * 128 / 8, gtid, gth);
        p0_convert(args.in[16], KEYSB + 128 * 128, 128 * 128 / 8, gtid, gth);
        PR_END(0); if (BOTH(0)) xcd_barrier(bar);
    }
    if (IN(1)) { PR_BEGIN(1);
        pg8::Gemm g{XB, WINT, XB, WINT, S, INW, DM / 2, (int)(0x01010101u * (127 - 6)), 0}; pg8::StaticOrder So; So.init(S, INW, G, (int)blockIdx.x);
        pg8::EpiStoreBf16 E{PROJ, INW};
        pg8::gemm_phase<pg8::EpiStoreBf16, pg8::StaticOrder, true, false, true>(lds, g, So, E, wave);
        PR_END(1); if (BOTH(1)) xcd_barrier(bar);
    }

#define KMEANB ((bf16*)(ws + WS_KMEANB))
#define YA ((bf16*)(ws + WS_YA))
#define YB ((bf16*)(ws + WS_YB))
#define OP0 ((bf16*)(ws + WS_OP0))
#define OP1 ((bf16*)(ws + WS_OP1))
    if (IN(2)) { PR_BEGIN(2);
        for (int it = vcu * NWAVES + wave; it < 16 * 32; it += G * NWAVES) { const int h = it >> 5, j = it & 31;
            const bf16* kp = PROJ + (size_t)(j * 256) * INW + 2048 + h * 128 + 2 * lane; float s0 = 0.f, s1 = 0.f;
            for (int i = 0; i < 256; ++i) { const unsigned w = *(const unsigned*)(kp + (size_t)i * INW); s0 += bflo(w); s1 += bfhi(w); }
            *(unsigned*)(KMEANB + (size_t)it * 128 + 2 * lane) = pk2(s0 * (1.0f / 256.0f), s1 * (1.0f / 256.0f)); }
        xcd_barrier(bar);
        for (int it8 = vcu; it8 < 16 * 32; it8 += G) { const int h = it8 >> 5, qb = it8 & 31, l_ = lane, r32 = l_ & 31, hi_ = l_ >> 5, q = qb * 256 + wave * 32 + r32;
            LAS int* cntl = (LAS int*)(lds + 4096); LAS int* gbl = cntl + 32;
            __syncthreads();
            if (tid < 32) cntl[tid] = 0;
            __syncthreads();
            int b1i = -1, b2i = -1, b3i = -1, p1 = 0, p2 = 0, p3 = 0;
            if (qb > 0) {
                att::f32x16 g0 = att::f32x16{};
                const bf16* qp = PROJ + (size_t)q * INW + h * 128 + hi_ * 8; const bf16* kp = KMEANB + ((size_t)h * 32 + r32) * 128 + hi_ * 8;
#pragma unroll
                for (int d0 = 0; d0 < 8; ++d0) g0 = __builtin_amdgcn_mfma_f32_32x32x16_bf16(*reinterpret_cast<const bf16x8*>(kp + d0 * 16), *reinterpret_cast<const bf16x8*>(qp + d0 * 16), g0, 0, 0, 0);
                float b1v = -3.0e38f, b2v = -3.0e38f, b3v = -3.0e38f;
#define TOP3_INS(gv, gi) do { const float g_ = (gv); const int j_ = (gi); if (j_ >= 0 && j_ < qb) { \
                    if (g_ > b1v) { b3v = b2v; b3i = b2i; b2v = b1v; b2i = b1i; b1v = g_; b1i = j_; } else if (g_ > b2v) { b3v = b2v; b3i = b2i; b2v = g_; b2i = j_; } else if (g_ > b3v) { b3v = g_; b3i = j_; } } } while (0)
#pragma unroll
                for (int r = 0; r < 16; ++r) TOP3_INS(g0[r], (r & 3) + 8 * (r >> 2) + 4 * hi_);
                { const float x1 = __shfl_xor(b1v, 32), x2 = __shfl_xor(b2v, 32), x3 = __shfl_xor(b3v, 32); const int i1 = __shfl_xor(b1i, 32), i2 = __shfl_xor(b2i, 32), i3 = __shfl_xor(b3i, 32);
                  TOP3_INS(x1, i1); TOP3_INS(x2, i2); TOP3_INS(x3, i3); }
#undef TOP3_INS
                if (hi_ == 0) { if (b1i >= 0) p1 = __hip_atomic_fetch_add(cntl + b1i, 1, __ATOMIC_RELAXED, __HIP_MEMORY_SCOPE_WORKGROUP);
                                if (b2i >= 0) p2 = __hip_atomic_fetch_add(cntl + b2i, 1, __ATOMIC_RELAXED, __HIP_MEMORY_SCOPE_WORKGROUP);
                                if (b3i >= 0) p3 = __hip_atomic_fetch_add(cntl + b3i, 1, __ATOMIC_RELAXED, __HIP_MEMORY_SCOPE_WORKGROUP); }
            }
            __syncthreads();
            if (tid < 32) { const int c = cntl[tid]; gbl[tid] = c > 0 ? (int)__hip_atomic_fetch_add(ctl + CW_CNT + CNT_STRIDE * (h * 32 + tid), (unsigned)c, RLX_AGENT) : 0; }
            __syncthreads();
            if (hi_ == 0) { unsigned short* ML = (unsigned short*)(ws + WS_MLIST) + (size_t)h * 32 * 8192;
                if (b1i >= 0) ML[(size_t)b1i * 8192 + gbl[b1i] + p1] = (unsigned short)(q | (0 << 13));
                if (b2i >= 0) ML[(size_t)b2i * 8192 + gbl[b2i] + p2] = (unsigned short)(q | (1 << 13));
                if (b3i >= 0) ML[(size_t)b3i * 8192 + gbl[b3i] + p3] = (unsigned short)(q | (2 << 13)); }
        }
        PR_END(2); if (BOTH(2)) xcd_barrier(bar);
    }
    if (IN(3)) { PR_BEGIN(3);
#pragma nounroll
        for (int p = (int)blockIdx.x; p < 256; p += G) {
            const int xcd = p & 7, rank = (p >> 3) & 31, t = rank & 15, pm = rank >> 4;
#pragma nounroll
            for (int sub = 0; sub < 2; ++sub) {
                att::DiffUnit u; u.qb = sub == 0 ? 31 - t : t; const int h = xcd;
                u.Q = PROJ + 6144 + h * 256 + pm * 128; u.K = PROJ + 8192 + h * 256 + pm * 128; u.V = PROJ + 10240 + h * 256; u.O = (pm ? OP1 : OP0) + h * 256; u.bias_head = 16 + h;
                att::diff_unit(u, args.in[3], (LAS char*)lds, wave);
            }
        }
        {
            constexpr int MX_CH = 24;
            LAS int* PFX = (LAS int*)(lds + att::MX_PFX); LAS int* QID = PFX + 512;
            __syncthreads();
            { const unsigned c = __hip_atomic_load(ctl + CW_CNT + CNT_STRIDE * tid, RLX_AGENT); PFX[tid] = (int)((8u + ((c + 31u) >> 5) + MX_CH - 1) / MX_CH); }
            __syncthreads();
            int mine = 0; for (int k = 0; k <= tid; ++k) mine += PFX[k];
            __syncthreads();
            PFX[tid] = mine;
            __syncthreads();
            const int total = PFX[511];
#pragma nounroll
            for (;;) {
                if (tid == 0) QID[0] = (int)__hip_atomic_fetch_add(ctl + CW_QUEUE, 1u, RLX_AGENT);
                __syncthreads();
                const int id = __builtin_amdgcn_readfirstlane(QID[0]);
                if (id >= total) break;
                int lo_ = 0, hi2 = 511;
                while (lo_ < hi2) { const int mid = (lo_ + hi2) >> 1; if (PFX[mid] > id) hi2 = mid; else lo_ = mid + 1; }
                const int li = __builtin_amdgcn_readfirstlane(lo_), part = id - (li ? PFX[li - 1] : 0), h = li >> 5;
                att::MobaUnit u; u.cnt = (int)__hip_atomic_load(ctl + CW_CNT + CNT_STRIDE * li, RLX_AGENT); const int nch = 8 + ((u.cnt + 31) >> 5);
                u.c_begin = part * MX_CH; u.c_end = (part + 1) * MX_CH < nch ? (part + 1) * MX_CH : nch; u.kb0 = (li & 31) * 256; u.bias_head = h;
                u.qlist = (const unsigned short*)(ws + WS_MLIST) + (size_t)li * 8192;
                u.Q = PROJ + h * 128; u.K = PROJ + 2048 + h * 128; u.V = PROJ + 4096 + h * 128;
                u.PO = (bf16*)(ws + WS_PO) + (size_t)h * 8192 * 4 * 128; u.PML = (float*)(ws + WS_PML) + (size_t)h * 8192 * 4 * 2;
                att::moba_unit(u, args.in[3], (LAS char*)lds, wave);
            }
        }
        PR_END(3); if (BOTH(3)) xcd_barrier(bar);
    }
    if (IN(4)) { PR_BEGIN(4);
        float a = args.in[4][lane] * args.in[5][lane] + args.in[4][lane + 64] * args.in[5][lane + 64], b = args.in[6][lane] * args.in[7][lane] + args.in[6][lane + 64] * args.in[7][lane + 64];
#pragma unroll
        for (int o = 1; o < 64; o <<= 1) { a += __shfl_xor(a, o); b += __shfl_xor(b, o); }
        const float lam = expf(a) - expf(b) + LAMBDA_INIT;
        const f32x4 gsub = *(const GAS f32x4*)(args.in[8] + 4 * lane);
        for (int it0 = (vcu * NWAVES + wave) * 4; it0 < S * 8; it0 += G * NWAVES * 4) {
            v2u w0[4], w1[4]; size_t off[4];
#pragma unroll
            for (int k = 0; k < 4; ++k) { const int it = it0 + k; off[k] = (size_t)(it >> 3) * 2048 + (it & 7) * 256 + 4 * lane; w0[k] = *(const GAS v2u*)(OP0 + off[k]); w1[k] = *(const GAS v2u*)(OP1 + off[k]); }
#pragma unroll
            for (int k = 0; k < 4; ++k) {
                const float y0 = bflo(w0[k].x) - lam * bflo(w1[k].x), y1 = bfhi(w0[k].x) - lam * bfhi(w1[k].x), y2 = bflo(w0[k].y) - lam * bflo(w1[k].y), y3 = bfhi(w0[k].y) - lam * bfhi(w1[k].y);
                float ss = (y0 * y0 + y1 * y1) + (y2 * y2 + y3 * y3);
#pragma unroll
                for (int o = 1; o < 64; o <<= 1) ss += __shfl_xor(ss, o);
                const float rs = rsqrtf(ss * (1.0f / 256.0f) + LN_EPS) * (1.0f - LAMBDA_INIT);
                *(GAS unsigned*)((unsigned char*)YB + off[k]) = pk4_fp8(8.0f * y0 * rs * gsub.x, 8.0f * y1 * rs * gsub.y, 8.0f * y2 * rs * gsub.z, 8.0f * y3 * rs * gsub.w); } }
        for (int it0 = (vcu * NWAVES + wave) * 4; it0 < S * 16; it0 += G * NWAVES * 4) {
            const int q = it0 >> 4, qb = q >> 8, ns = qb < 3 ? qb : 3;
            float mm[4][4], ll[4][4]; unsigned pw[4][4];
#pragma unroll
            for (int k = 0; k < 4; ++k) { const int h = (it0 & 15) + k; const size_t base = ((size_t)h * 8192 + q) * 4;
                const float* pml = (const float*)(ws + WS_PML) + base * 2; const bf16* po = (const bf16*)(ws + WS_PO) + base * 128 + 2 * lane;
#pragma unroll
                for (int sl = 0; sl < 4; ++sl) { const bool on = sl == 3 || sl < ns; mm[k][sl] = on ? pml[2 * sl] : -3.0e38f; ll[k][sl] = on ? pml[2 * sl + 1] : 0.f; pw[k][sl] = on ? *(const GAS unsigned*)(po + sl * 128) : 0u; } }
#pragma unroll
            for (int k = 0; k < 4; ++k) { const int h = (it0 & 15) + k;
                const float M = fmaxf(fmaxf(mm[k][0], mm[k][1]), fmaxf(mm[k][2], mm[k][3])); float L = 0.f, a0 = 0.f, a1 = 0.f;
#pragma unroll
                for (int sl = 0; sl < 4; ++sl) { const float w = __builtin_amdgcn_exp2f(mm[k][sl] - M); L += w * ll[k][sl]; a0 += w * bflo(pw[k][sl]); a1 += w * bfhi(pw[k][sl]); }
                const float sc = 64.0f / L;
                *(GAS unsigned short*)((unsigned char*)YA + (size_t)q * 2048 + h * 128 + 2 * lane) = (unsigned short)(pk4_fp8(a0 * sc, a1 * sc, 0.f, 0.f) & 0xffffu); } }
        PR_END(4); if (BOTH(4)) xcd_barrier(bar);
    }

    if (IN(5)) { PR_BEGIN(5);
        pg8::Gemm g{YA, WOA, YB, WOB, S, DM, 2048 / 2, (int)(0x01010101u * (127 - 12)), (int)(0x01010101u * (127 - 9))};
        pg8::DualOrder So; So.init(S, DM, G, (int)blockIdx.x);
        pg8::EpiMerge E{(unsigned char*)MERGED, PROJ, args.in[2]};
        pg8::gemm_phase<pg8::EpiMerge, pg8::DualOrder, true, P5_SP2, true>(lds, g, So, E, wave);
        PR_END(5); if (BOTH(5)) xcd_barrier(bar);
    }
    if (IN(6)) { PR_BEGIN(6);
        pg8::Gemm g{MERGED, WOUT, MERGED, WOUT, S, DM, DM / 2, (int)(0x01010101u * (127 - 10)), 0}; pg8::StaticOrder So; So.init(S, DM, G, (int)blockIdx.x);
        pg8::EpiResF32 E{args.out, args.in[0], ALPHA};
        pg8::gemm_phase<pg8::EpiResF32, pg8::StaticOrder, true, P6_SP2, true>(lds, g, So, E, wave);
        PR_END(6); if (BOTH(6)) xcd_barrier(bar);
    }
    if (IN(7)) { PR_BEGIN(7);
        for (int m = vcu * NWAVES + wave; m < S; m += G * NWAVES) ln_row(args.out + (size_t)m * DM, args.in[12], args.in[13], X1F + (size_t)m * DM, X1B + (size_t)m * DM, X1Q + (size_t)m * DM, lane);
        { GAS v4u* gz = (GAS v4u*)GD; const v4u z = {0u, 0u, 0u, 0u}; for (size_t i = (size_t)blockIdx.x * 512 + tid; i < (size_t)S * 16384 / 16; i += (size_t)G * 512) gz[i] = z; }
        PR_END(7); if (BOTH(7)) xcd_barrier(bar);
    }
    if (IN(8)) { PR_BEGIN(8);
        pg8::Gemm g{X1B, WQ, X1B, WQ, S, 2048, DM, 0, 0}; pg8::StaticOrder So; So.init(S, 2048, G, (int)blockIdx.x);
        pg8::EpiStoreBf16 E{PQ, 2048};
        pg8::gemm_phase<pg8::EpiStoreBf16, pg8::StaticOrder, true, true>(lds, g, So, E, wave);
        PR_END(8); if (BOTH(8)) xcd_barrier(bar);
    }
    if (IN(9)) { PR_BEGIN(9);
#pragma nounroll
        for (int b = (int)blockIdx.x; b < S / 32; b += G) rt::route_block(b * 32, PQ, KEYSB, (unsigned char*)GD, nullptr, nullptr, (LAS char*)lds, wave);
        PR_END(9); if (BOTH(9)) xcd_barrier(bar);
    }
    if (IN(10)) { PR_BEGIN(10);
        pg8::Gemm g{(const bf16*)X1Q, UB, (const bf16*)X1Q, UB, S, 16384, DM / 2, (int)(0x01010101u * (127 - 6)), 0}; pg8::StaticOrder So; So.init(S, 16384, G, (int)blockIdx.x);
        pg8::EpiPeerAct E{(unsigned char*)GD};
        pg8::gemm_phase<pg8::EpiPeerAct, pg8::StaticOrder, true, true, true>(lds, g, So, E, wave);
        PR_END(10); if (BOTH(10)) xcd_barrier(bar);
    }
    if (IN(11)) { PR_BEGIN(11);
        pg8::Gemm g{GD, VT, GD, VT, S, DM, 16384 / 2, (int)(0x01010101u * (127 - 9)), 0}; pg8::StaticOrder So; So.init(S, DM, G, (int)blockIdx.x);
        pg8::EpiResF32 E{args.out, X1F, ALPHA};
        pg8::gemm_phase<pg8::EpiResF32, pg8::StaticOrder, true, true, true>(lds, g, So, E, wave);
        PR_END(11); if (BOTH(11)) xcd_barrier(bar);
    }
    if (IN(12)) {
#ifdef PROBE_A
        const float pr_mul = 1.0f + 1e-5f * (float)__hip_atomic_load(ctl + 2048, RLX_AGENT);
#else
        const float pr_mul = 1.0f;
#endif
        for (int m = vcu * NWAVES + wave; m < S; m += G * NWAVES) ln_row(args.out + (size_t)m * DM, args.in[19], args.in[20], args.out + (size_t)m * DM, nullptr, nullptr, lane, pr_mul);
    }
#undef IN
#undef BOTH
#undef lane
#undef tid
#undef WINT
#undef XB
#undef PROJ
#undef MERGED
#undef X1B
#undef PQ
#undef GD
#undef WOA
#undef WOB
#undef WOUT
#undef WQ
#undef UB
#undef VT
#undef KEYSB
#undef X1F
#undef X1Q
#undef KMEANB
#undef YA
#undef YB
#undef OP0
#undef OP1
}

__global__ void shim_proj(const bf16* __restrict__ PROJ, float* __restrict__ ws) {
    const size_t U64 = (size_t)S * 2048;
    const size_t i = (size_t)blockIdx.x * blockDim.x + threadIdx.x; const int row = (int)(i / INW), col = (int)(i % INW);
    const float v = bf2f(PROJ[i]);
    if (col < 12288) { const int t = col >> 11, c = col & 2047; ws[(size_t)t * U64 + (size_t)row * 2048 + c] = v; }
    else { const int t = (col - 12288) >> 12, c = (col - 12288) & 4095; ws[(size_t)(6 + 2 * t) * U64 + (size_t)row * 4096 + c] = v; }
}

__global__ void shim_bf16_f32(const bf16* __restrict__ src, float* __restrict__ dst) { const size_t i = (size_t)blockIdx.x * blockDim.x + threadIdx.x; dst[i] = bf2f(src[i]); }
}

extern "C" void kernel_launch(void* const* d_in, const int* in_sizes, int n_in, void* d_out, int out_size, void* d_ws, size_t ws_size, hipStream_t stream) {
    if (ws_size < WS_NEED) return;
    static int grid = 0;
    if (grid == 0) {
        int dev = 0, cus = 0;
        if (hipGetDevice(&dev) != hipSuccess || hipDeviceGetAttribute(&cus, hipDeviceAttributeMultiprocessorCount, dev) != hipSuccess) { grid = -1; return; }
        if (hipFuncSetAttribute((const void*)mega_fwd, hipFuncAttributeMaxDynamicSharedMemorySize, LDS_BYTES) != hipSuccess) { grid = -1; return; }
        grid = cus;
    }
    if (grid < 0) return;
    (void)hipMemsetAsync((char*)d_ws + WS_CTL, 0, CTL_ZERO_BYTES, stream);
    Args a{};
    for (int i = 0; i < 21; ++i) a.in[i] = (const float*)d_in[i];
    a.out = (float*)d_out; a.ws = (unsigned char*)d_ws;
    const int cuts[] = {0, 13};
    for (int li = 0; li + 1 < (int)(sizeof(cuts) / sizeof(int)); ++li) { a.ph_lo = cuts[li]; a.ph_hi = cuts[li + 1];
        hipLaunchKernelGGL(mega_fwd, dim3(grid), dim3(NWAVES * 64), LDS_BYTES, stream, a); }
}
```
